# Optimizing an MI355X kernel written in HIP

```python
import math
import jax
import jax.numpy as jnp
from jax import lax
import numpy as np

D_MODEL = 4096
BATCH = 1
SEQ = 16384
DEPTH = 4

CHUNK = 64
Q_BLOCK = 128
N_MIXERS = 3
N_FOX_LAYERS = (DEPTH + 2) // 3
N_LRU_LAYERS = (DEPTH + 1) // 3
N_MLSTM_LAYERS = DEPTH // 3
RMS_EPS = 1e-6
NEG_INF = -1e30

FOX_HEADS = 32
FOX_HEAD_DIM = D_MODEL // FOX_HEADS
FOX_WIDTH = FOX_HEADS * FOX_HEAD_DIM
FOX_IN = 4 * FOX_WIDTH + FOX_HEADS

LRU_WIDTH = D_MODEL
LRU_BLOCKS = 16
LRU_BLOCK_SIZE = LRU_WIDTH // LRU_BLOCKS
CONV_WIDTH = 4
LRU_C = 8.0
LRU_IN = 2 * LRU_WIDTH

MLSTM_HEADS = 8
MLSTM_V_DIM = D_MODEL // MLSTM_HEADS
MLSTM_QK_DIM = MLSTM_V_DIM // 2
MLSTM_QK_W = MLSTM_HEADS * MLSTM_QK_DIM
MLSTM_V_W = MLSTM_HEADS * MLSTM_V_DIM
MLSTM_IN = 2 * MLSTM_QK_W + 3 * MLSTM_V_W + 2 * MLSTM_HEADS

kernel_name = "fox_rglru_mlstm_interleaved_trunk"


def _rms_norm(x, g):
    xf = x.astype(jnp.float32)
    y = xf * lax.rsqrt(jnp.mean(xf * xf, axis=-1, keepdims=True) + RMS_EPS)
    return (y * g.astype(jnp.float32)).astype(x.dtype)


def _heads(t, n_heads):
    b, s, _ = t.shape
    return t.reshape(b, s, n_heads, -1).transpose(0, 2, 1, 3)


def _merge(t):
    b, h, s, d = t.shape
    return t.transpose(0, 2, 1, 3).reshape(b, s, h * d)


def _fox_attention(q, k, v, logf):
    b, h, s, dh = q.shape
    nb = s // Q_BLOCK
    scale = dh ** -0.5
    F = jnp.cumsum(logf, axis=-1)
    qb = q.reshape(b, h, nb, Q_BLOCK, dh).transpose(2, 0, 1, 3, 4)
    Fb = F.reshape(b, h, nb, Q_BLOCK).transpose(2, 0, 1, 3)
    kpos = jnp.arange(s)

    def one_block(args):
        q_i, F_i, blk = args
        qpos = blk * Q_BLOCK + jnp.arange(Q_BLOCK)
        logits = (jnp.einsum('bhqd,bhkd->bhqk', q_i, k).astype(jnp.float32) * scale
                  + F_i[..., :, None] - F[..., None, :])
        logits = jnp.where(kpos[None, :] <= qpos[:, None], logits, NEG_INF)
        p = jax.nn.softmax(logits, axis=-1)
        return jnp.einsum('bhqk,bhkd->bhqd', p.astype(v.dtype), v)

    out = lax.map(one_block, (qb, Fb, jnp.arange(nb)))
    return out.transpose(1, 2, 0, 3, 4).reshape(b, h, s, dh)


def _fox_branch(u, w_in, b_f, w_out):
    p = u @ w_in
    q, k, v, z, f_pre = jnp.split(
        p, [FOX_WIDTH, 2 * FOX_WIDTH, 3 * FOX_WIDTH, 4 * FOX_WIDTH], axis=-1)
    logf = jax.nn.log_sigmoid((f_pre + b_f).astype(jnp.float32)).transpose(0, 2, 1)
    o = _fox_attention(_heads(q, FOX_HEADS), _heads(k, FOX_HEADS),
                       _heads(v, FOX_HEADS), logf)
    return (_merge(o) * jax.nn.silu(z)) @ w_out


def _causal_conv(x, w, b):
    kw = w.shape[0]
    s = x.shape[1]
    xp = jnp.pad(x, ((0, 0), (kw - 1, 0), (0, 0)))
    return sum(xp[:, j:j + s] * w[j] for j in range(kw)) + b


def _lin_combine(left, right):
    a_l, b_l = left
    a_r, b_r = right
    return a_l * a_r, a_r * b_l + b_r


def _lru_branch(u, w_in, conv_w, conv_b, w_a, b_a, w_x, b_x, lam, w_out):
    bsz, s, _ = u.shape
    p = u @ w_in
    xb, z = jnp.split(p, [LRU_WIDTH], axis=-1)
    xc = _causal_conv(xb, conv_w, conv_b)
    xr = xc.reshape(bsz, s, LRU_BLOCKS, LRU_BLOCK_SIZE)
    r = jax.nn.sigmoid((jnp.einsum('bsnc,ncd->bsnd', xr, w_a) + b_a)
                       .astype(jnp.float32)).reshape(bsz, s, LRU_WIDTH)
    ig = jax.nn.sigmoid((jnp.einsum('bsnc,ncd->bsnd', xr, w_x) + b_x)
                        .astype(jnp.float32)).reshape(bsz, s, LRU_WIDTH)
    log_a = -LRU_C * r * jax.nn.softplus(-lam.astype(jnp.float32))
    a = jnp.exp(log_a)
    inp = jnp.sqrt(-jnp.expm1(2.0 * log_a)) * (ig * xc.astype(jnp.float32))
    _, h = lax.associative_scan(_lin_combine, (a, inp), axis=1)
    return (h.astype(u.dtype) * jax.nn.silu(z)) @ w_out


def _mlstm_chunkwise(q, k, v, i_pre, logf):
    b, h, s, dk = q.shape
    dv = v.shape[-1]
    L = CHUNK
    nc = s // L
    q = q * (dk ** -0.5)

    def to_chunks(t):
        return jnp.moveaxis(t.reshape(b, h, nc, L, *t.shape[3:]), 2, 0)

    xs = (to_chunks(q), to_chunks(k), to_chunks(v), to_chunks(i_pre), to_chunks(logf))
    causal = jnp.tril(jnp.ones((L, L), dtype=bool))

    def step(carry, xs_c):
        C, n, m = carry
        qc, kc, vc, ic, fc = xs_c
        bcum = jnp.cumsum(fc, axis=-1)
        g = bcum[..., -1]
        Dm = jnp.where(causal, bcum[..., :, None] - bcum[..., None, :] + ic[..., None, :], NEG_INF)
        inter = bcum + m[..., None]
        m_row = jnp.maximum(inter, jnp.max(Dm, axis=-1))
        Wts = jnp.exp(Dm - m_row[..., None])
        sc = jnp.einsum('bhtd,bhsd->bhts', qc, kc) * Wts
        inter_w = jnp.exp(inter - m_row)
        num = (jnp.einsum('bhts,bhsv->bhtv', sc, vc)
               + inter_w[..., None] * jnp.einsum('bhvd,bhtd->bhtv', C, qc))
        den = jnp.sum(sc, axis=-1) + inter_w * jnp.einsum('bhd,bhtd->bht', n, qc)
        h_c = num / jnp.maximum(jnp.abs(den), jnp.exp(-m_row))[..., None]
        a_s = g[..., None] - bcum + ic
        m_new = jnp.maximum(g + m, jnp.max(a_s, axis=-1))
        wk = jnp.exp(a_s - m_new[..., None])
        decay = jnp.exp(g + m - m_new)
        C_new = decay[..., None, None] * C + jnp.einsum('bhsv,bhsd->bhvd', vc * wk[..., None], kc)
        n_new = decay[..., None] * n + jnp.einsum('bhs,bhsd->bhd', wk, kc)
        return (C_new, n_new, m_new), h_c

    init = (jnp.zeros((b, h, dv, dk), jnp.float32),
            jnp.zeros((b, h, dk), jnp.float32),
            jnp.zeros((b, h), jnp.float32))
    _, hs = lax.scan(step, init, xs)
    return jnp.moveaxis(hs, 0, 2).reshape(b, h, s, dv)


def _mlstm_branch(u, w_in, b_i, b_f, w_out):
    p = u @ w_in
    o1 = MLSTM_QK_W
    o2 = o1 + MLSTM_QK_W
    o3 = o2 + MLSTM_V_W
    o4 = o3 + MLSTM_V_W
    o5 = o4 + MLSTM_HEADS
    o6 = o5 + MLSTM_HEADS
    q, k, v, o_pre, i_pre, f_pre, z = jnp.split(p, [o1, o2, o3, o4, o5, o6], axis=-1)
    f32 = jnp.float32
    i_g = (i_pre + b_i).astype(f32).transpose(0, 2, 1)
    logf = jax.nn.log_sigmoid((f_pre + b_f).astype(f32)).transpose(0, 2, 1)
    hc = _mlstm_chunkwise(_heads(q, MLSTM_HEADS).astype(f32), _heads(k, MLSTM_HEADS).astype(f32),
                          _heads(v, MLSTM_HEADS).astype(f32), i_g, logf)
    y = jax.nn.sigmoid(o_pre) * _merge(hc).astype(u.dtype) * jax.nn.silu(z)
    return y @ w_out


def setup_inputs(seed: int = 0) -> dict:
    key = jax.random.key(seed)
    ks = jax.random.split(key, 24)
    f32 = jnp.float32
    nrm = lambda k, shape, sc: jax.random.normal(k, shape, f32) * sc
    x = jax.random.normal(ks[0], (BATCH, SEQ, D_MODEL), f32)
    norm_g = 1.0 + nrm(ks[1], (DEPTH, D_MODEL), 0.02)
    fox_w_in = nrm(ks[2], (N_FOX_LAYERS, D_MODEL, FOX_IN), D_MODEL ** -0.5)
    fox_b_f = jnp.linspace(2.0, 8.0, FOX_HEADS, dtype=f32)[None] + nrm(ks[3], (N_FOX_LAYERS, FOX_HEADS), 0.1)
    fox_w_out = nrm(ks[4], (N_FOX_LAYERS, FOX_WIDTH, D_MODEL), FOX_WIDTH ** -0.5)
    lru_w_in = nrm(ks[5], (N_LRU_LAYERS, D_MODEL, LRU_IN), D_MODEL ** -0.5)
    lru_conv_w = nrm(ks[6], (N_LRU_LAYERS, CONV_WIDTH, LRU_WIDTH), CONV_WIDTH ** -0.5)
    lru_conv_b = nrm(ks[7], (N_LRU_LAYERS, LRU_WIDTH), 0.01)
    lru_w_a = nrm(ks[8], (N_LRU_LAYERS, LRU_BLOCKS, LRU_BLOCK_SIZE, LRU_BLOCK_SIZE), LRU_BLOCK_SIZE ** -0.5)
    lru_b_a = nrm(ks[9], (N_LRU_LAYERS, LRU_BLOCKS, LRU_BLOCK_SIZE), 0.01)
    lru_w_x = nrm(ks[10], (N_LRU_LAYERS, LRU_BLOCKS, LRU_BLOCK_SIZE, LRU_BLOCK_SIZE), LRU_BLOCK_SIZE ** -0.5)
    lru_b_x = nrm(ks[11], (N_LRU_LAYERS, LRU_BLOCKS, LRU_BLOCK_SIZE), 0.01)
    a_c = jax.random.uniform(ks[12], (N_LRU_LAYERS, LRU_WIDTH), f32, 0.9, 0.999)
    a0 = a_c ** (1.0 / LRU_C)
    lru_lambda = jnp.log(a0) - jnp.log1p(-a0)
    lru_w_out = nrm(ks[13], (N_LRU_LAYERS, LRU_WIDTH, D_MODEL), LRU_WIDTH ** -0.5)
    mlstm_w_in = nrm(ks[14], (N_MLSTM_LAYERS, D_MODEL, MLSTM_IN), D_MODEL ** -0.5)
    mlstm_b_i = nrm(ks[15], (N_MLSTM_LAYERS, MLSTM_HEADS), 0.1)
    mlstm_b_f = jnp.linspace(3.0, 6.0, MLSTM_HEADS, dtype=f32)[None] + nrm(ks[16], (N_MLSTM_LAYERS, MLSTM_HEADS), 0.1)
    mlstm_w_out = nrm(ks[17], (N_MLSTM_LAYERS, MLSTM_V_W, D_MODEL), MLSTM_V_W ** -0.5)
    final_norm_g = 1.0 + nrm(ks[18], (D_MODEL,), 0.02)
    return {"x": x, "norm_g": norm_g,
            "fox_w_in": fox_w_in, "fox_b_f": fox_b_f, "fox_w_out": fox_w_out,
            "lru_w_in": lru_w_in, "lru_conv_w": lru_conv_w, "lru_conv_b": lru_conv_b,
            "lru_w_a": lru_w_a, "lru_b_a": lru_b_a, "lru_w_x": lru_w_x, "lru_b_x": lru_b_x,
            "lru_lambda": lru_lambda, "lru_w_out": lru_w_out,
            "mlstm_w_in": mlstm_w_in, "mlstm_b_i": mlstm_b_i, "mlstm_b_f": mlstm_b_f,
            "mlstm_w_out": mlstm_w_out, "final_norm_g": final_norm_g}


def reference(x, norm_g, fox_w_in, fox_b_f, fox_w_out,
              lru_w_in, lru_conv_w, lru_conv_b, lru_w_a, lru_b_a, lru_w_x, lru_b_x,
              lru_lambda, lru_w_out,
              mlstm_w_in, mlstm_b_i, mlstm_b_f, mlstm_w_out, final_norm_g):
    h = x
    for i in range(DEPTH):
        j = i // N_MIXERS
        u = _rms_norm(h, norm_g[i])
        kind = i % N_MIXERS
        if kind == 0:
            y = _fox_branch(u, fox_w_in[j], fox_b_f[j], fox_w_out[j])
        elif kind == 1:
            y = _lru_branch(u, lru_w_in[j], lru_conv_w[j], lru_conv_b[j], lru_w_a[j],
                            lru_b_a[j], lru_w_x[j], lru_b_x[j], lru_lambda[j], lru_w_out[j])
        else:
            y = _mlstm_branch(u, mlstm_w_in[j], mlstm_b_i[j], mlstm_b_f[j], mlstm_w_out[j])
        h = h + y.astype(h.dtype)
    return _rms_norm(h, final_norm_g)
```

```cpp
#include <hip/hip_runtime.h>
#include <cstdio>
#include <cstdint>
namespace pg8 {
#define PG8_LAS __attribute__((address_space(3)))
typedef unsigned short bf16_t;
typedef short bf16x8 __attribute__((ext_vector_type(8)));
typedef float f32x4 __attribute__((ext_vector_type(4)));
typedef unsigned u32x4 __attribute__((ext_vector_type(4)));
constexpr int BM = 256, BK = 64, HALF = 128, HTB = HALF * BK * 2  , STAGE_BYTES = 8 * HTB, NXCD = 8, WGM = 8;

__host__ __device__ __forceinline__ int lds_byte(int r, int c) { const int st = (r >> 4) * 2 + (c >> 5), rr = r & 15, cc = c & 31, ob = rr * 64 + cc * 2; return st * 1024 + (ob ^ (((ob >> 9) & 1) << 5)); }
__host__ __device__ __forceinline__ void stage_rc(int b, int& R, int& C) { const int st = b / 1024, sb = b % 1024, swz = sb ^ (((sb >> 9) & 1) << 5); R = (st >> 1) * 16 + swz / 64; C = (st & 1) * 32 + (swz % 64) / 2; }
__host__ __device__ __forceinline__ int perm32(int rho) { const int n = rho >> 4, i = rho & 15; return 8 * (i >> 2) + 4 * n + (i & 3); }

struct Unit { int pm, pn; };
struct Gemm { const bf16_t* A; const bf16_t* Bt; int M, N, K; };

struct StaticOrder {
    int nM, nN, nwg, G, c;
    __host__ __device__ void init(int M, int N, int G_, int c_) { nM = M / BM; nN = N / BM; nwg = nM * nN; G = G_; c = c_; }
    __host__ __device__ bool next(int i, Unit& u) const {
        const long L = (long)i * G + c; if (L >= nwg) return false;
        int wgid = (int)L; { const int q = nwg / NXCD, r = nwg % NXCD, xcd = wgid % NXCD, off = wgid / NXCD; wgid = (xcd < r ? xcd * (q + 1) : r * (q + 1) + (xcd - r) * q) + off; }
        const int nig = WGM * nN, gid = wgid / nig, fm = gid * WGM, gsz = (nM - fm) < WGM ? (nM - fm) : WGM;
        u.pm = fm + ((wgid % nig) % gsz); u.pn = (wgid % nig) / gsz; return true;
    }
    __device__ __forceinline__ void a_ready(const Unit&) const {}
    __device__ __forceinline__ void done(const Unit&) const {}
};

__device__ __forceinline__ unsigned cvt_pk_bf16(float lo, float hi) { unsigned r; asm volatile("v_cvt_pk_bf16_f32 %0, %1, %2" : "=v"(r) : "v"(lo), "v"(hi)); return r; }

template <bool NORMS> struct EpiIn {
    static constexpr bool PERM = true, AFTER_DRAIN = false;
    bf16_t* O; size_t tstride; const unsigned long long* rowss;
    unsigned* nrm;
    __device__ __forceinline__ void operator()(const f32x4 (&acc)[2][2][4][2], const Unit& u, int wr, int wc, int fr, int fq) const {
        const int row0 = u.pm * BM + wr * 64 + fr; int colt = u.pn * BM;
        const int tens = colt >> 12;
        bf16_t* base = O + (size_t)tens * tstride; colt &= 4095;
        const int col0 = colt + wc * 32 + 8 * fq;
        unsigned long long sq[8];
#pragma unroll
        for (int g = 0; g < 8; ++g) sq[g] = rowss[row0 + (g >> 2) * HALF + (g & 3) * 16];
        float nmax[2] = {0.f, 0.f};
#pragma unroll
        for (int ai = 0; ai < 2; ++ai)
#pragma unroll
            for (int m = 0; m < 4; ++m) { const int row = row0 + ai * HALF + m * 16; const float rs = rsqrtf((float)sq[ai * 4 + m] * (1.0f / (1048576.0f * 4096.0f)) + 1e-6f);
                bf16_t* rowp = base + (size_t)row * 4096 + col0;
#pragma unroll
                for (int bj = 0; bj < 2; ++bj) { const f32x4 v0 = acc[ai][bj][m][0] * rs, v1 = acc[ai][bj][m][1] * rs;
                    u32x4 w; w.x = cvt_pk_bf16(v0[0], v0[1]); w.y = cvt_pk_bf16(v0[2], v0[3]); w.z = cvt_pk_bf16(v1[0], v1[1]); w.w = cvt_pk_bf16(v1[2], v1[3]);
                    *(u32x4*)(rowp + bj * HALF) = w;
                    if (NORMS && tens < 2) { float s = ((v0[0] * v0[0] + v0[1] * v0[1]) + (v0[2] * v0[2] + v0[3] * v0[3])) + ((v1[0] * v1[0] + v1[1] * v1[1]) + (v1[2] * v1[2] + v1[3] * v1[3]));
                        s += __shfl_xor(s, 16); s += __shfl_xor(s, 32); nmax[bj] = fmaxf(nmax[bj], s); } } }
        if (NORMS && tens < 2) {
#pragma unroll
            for (int bj = 0; bj < 2; ++bj) { float s = nmax[bj]; s = fmaxf(s, __shfl_xor(s, 1)); s = fmaxf(s, __shfl_xor(s, 2)); s = fmaxf(s, __shfl_xor(s, 4)); s = fmaxf(s, __shfl_xor(s, 8));
                if (fr == 0 && fq == 0) __hip_atomic_fetch_max(nrm + ((tens * 32 + (colt >> 7) + bj) * 4 + wc), __float_as_uint(s), __ATOMIC_RELAXED, __HIP_MEMORY_SCOPE_AGENT); } }
    }
};
struct EpiOut {
    static constexpr bool PERM = true, AFTER_DRAIN = false;
    bf16_t* hb; unsigned long long* ss_next;
    __device__ __forceinline__ void operator()(const f32x4 (&acc)[2][2][4][2], const Unit& u, int wr, int wc, int fr, int fq) const {
        const int row0 = u.pm * BM + wr * 64 + fr, col0 = u.pn * BM + wc * 32 + 8 * fq;
        float ssr[8]; u32x4 cur[2], nxt[2];
#pragma unroll
        for (int bj = 0; bj < 2; ++bj) cur[bj] = *(const u32x4*)(hb + (size_t)row0 * 4096 + col0 + bj * HALF);
#pragma unroll
        for (int g = 0; g < 8; ++g) { const int ai = g >> 2, m = g & 3; bf16_t* rowp = hb + (size_t)(row0 + ai * HALF + m * 16) * 4096 + col0;
            if (g < 7) { const bf16_t* rown = hb + (size_t)(row0 + ((g + 1) >> 2) * HALF + ((g + 1) & 3) * 16) * 4096 + col0;
#pragma unroll
                for (int bj = 0; bj < 2; ++bj) nxt[bj] = *(const u32x4*)(rown + bj * HALF); }
            float ss = 0.f;
#pragma unroll
            for (int bj = 0; bj < 2; ++bj) { const u32x4 c = cur[bj];
                f32x4 o0, o1;
                o0[0] = __uint_as_float(c.x << 16) + acc[ai][bj][m][0][0]; o0[1] = __uint_as_float(c.x & 0xffff0000u) + acc[ai][bj][m][0][1];
                o0[2] = __uint_as_float(c.y << 16) + acc[ai][bj][m][0][2]; o0[3] = __uint_as_float(c.y & 0xffff0000u) + acc[ai][bj][m][0][3];
                o1[0] = __uint_as_float(c.z << 16) + acc[ai][bj][m][1][0]; o1[1] = __uint_as_float(c.z & 0xffff0000u) + acc[ai][bj][m][1][1];
                o1[2] = __uint_as_float(c.w << 16) + acc[ai][bj][m][1][2]; o1[3] = __uint_as_float(c.w & 0xffff0000u) + acc[ai][bj][m][1][3];
                u32x4 w; w.x = cvt_pk_bf16(o0[0], o0[1]); w.y = cvt_pk_bf16(o0[2], o0[3]); w.z = cvt_pk_bf16(o1[0], o1[1]); w.w = cvt_pk_bf16(o1[2], o1[3]);
                *(u32x4*)(rowp + bj * HALF) = w;
                const float r0 = __uint_as_float(w.x << 16), r1 = __uint_as_float(w.x & 0xffff0000u), r2 = __uint_as_float(w.y << 16), r3 = __uint_as_float(w.y & 0xffff0000u);
                const float r4 = __uint_as_float(w.z << 16), r5 = __uint_as_float(w.z & 0xffff0000u), r6 = __uint_as_float(w.w << 16), r7 = __uint_as_float(w.w & 0xffff0000u);
                ss += ((r0 * r0 + r1 * r1) + (r2 * r2 + r3 * r3)) + ((r4 * r4 + r5 * r5) + (r6 * r6 + r7 * r7)); }
            ss += __shfl_xor(ss, 16); ss += __shfl_xor(ss, 32); ssr[g] = ss;
#pragma unroll
            for (int bj = 0; bj < 2; ++bj) cur[bj] = nxt[bj];
            asm volatile("" ::: "memory"); }
        if (fq == 0) {
#pragma unroll
            for (int g = 0; g < 8; ++g) __hip_atomic_fetch_add(ss_next + row0 + (g >> 2) * HALF + (g & 3) * 16, (unsigned long long)(ssr[g] * 1048576.0f + 0.5f), __ATOMIC_RELAXED, __HIP_MEMORY_SCOPE_AGENT); }
    }
};

template <class Epi, class Sched, bool ALIGN_EPI = false, bool SP2 = false>
__device__ __forceinline__ void gemm_phase(PG8_LAS unsigned char* lds, const Gemm g, const Sched& S, const Epi& E) {
    const int tid = threadIdx.x, wid = __builtin_amdgcn_readfirstlane(tid >> 6), lane = tid & 63, wr = wid >> 2, wc = wid & 3, fr = lane & 15, fq = lane >> 4;
    const int K = g.K, nt = K / BK;
    unsigned voffA[2], voffB[2];
#pragma unroll
    for (int i = 0; i < 2; ++i) { int R, C; stage_rc(tid * 16 + i * 8192, R, C); const int Rb = Epi::PERM ? ((R & ~31) + perm32(R & 31)) : R;
        voffA[i] = (unsigned)(R * K + C) * 2u; voffB[i] = (unsigned)(Rb * K + C) * 2u; }
    const size_t kstep = (size_t)(BK * 2);
    const size_t hstep = (size_t)HALF * K * 2;
    const size_t tstep = 2 * hstep;
    const unsigned ldsw = (unsigned)wid * 1024u;
    const int aoff = lds_byte(wr * 64 + fr, fq * 8), boff = lds_byte(wc * 32 + fr, fq * 8);
#define PG8_SA(b, h) (((b) * 2 + (h)) * HTB)
#define PG8_SB(b, h) ((4 + (b) * 2 + (h)) * HTB)
#define PG8_STAGE(bufoff, gbase, voff) do { _Pragma("unroll") for (int _i = 0; _i < 2; ++_i) \
        __builtin_amdgcn_global_load_lds((const unsigned*)((const char*)(gbase) + (voff)[_i]), (PG8_LAS unsigned*)(lds + (bufoff) + ldsw + _i * 8192), 16, 0, 0); } while (0)
#define PG8_LDA(dst, b, h) do { _Pragma("unroll") for (int m = 0; m < 4; ++m) _Pragma("unroll") for (int k = 0; k < 2; ++k) dst[m][k] = *(const PG8_LAS bf16x8*)(lds + PG8_SA(b, h) + aoff + m * 2048 + k * 1024); } while (0)
#define PG8_LDB(dst, b, h) do { _Pragma("unroll") for (int n = 0; n < 2; ++n) _Pragma("unroll") for (int k = 0; k < 2; ++k) dst[n][k] = *(const PG8_LAS bf16x8*)(lds + PG8_SB(b, h) + boff + n * 2048 + k * 1024); } while (0)
#define PG8_MMA(ai, bj, At, Bt) do { __builtin_amdgcn_s_setprio(1); _Pragma("unroll") for (int m = 0; m < 4; ++m) _Pragma("unroll") for (int n = 0; n < 2; ++n) _Pragma("unroll") for (int k = 0; k < 2; ++k) \
        acc[ai][bj][m][n] = __builtin_amdgcn_mfma_f32_16x16x32_bf16(Bt[n][k], At[m][k], acc[ai][bj][m][n], 0, 0, 0); __builtin_amdgcn_s_setprio(0); } while (0)
#define PG8_WAIT_V(n) asm volatile("s_waitcnt vmcnt(" #n ")" ::: "memory")
#define PG8_WAIT_L(n) asm volatile("s_waitcnt lgkmcnt(" #n ")" ::: "memory")
#define PG8_BAR __builtin_amdgcn_s_barrier()
#define PG8_SCHED __builtin_amdgcn_sched_barrier(0)
    Unit cur, nxt; int ui = 0;
    if (!S.next(0, cur)) return;
    f32x4 acc[2][2][4][2];
#pragma unroll
    for (int a = 0; a < 2; ++a)
#pragma unroll
        for (int b = 0; b < 2; ++b)
#pragma unroll
            for (int m = 0; m < 4; ++m)
#pragma unroll
                for (int n = 0; n < 2; ++n) acc[a][b][m][n] = (f32x4){0.f, 0.f, 0.f, 0.f};
    bf16x8 At[4][2], B0[2][2], B1[2][2];
    const char* cA = (const char*)g.A + (size_t)cur.pm * tstep; const char* cB = (const char*)g.Bt + (size_t)cur.pn * tstep;
    S.a_ready(cur);
    if constexpr (SP2) {
        PG8_STAGE(PG8_SB(0, 0), cB, voffB); PG8_STAGE(PG8_SB(0, 1), cB + hstep, voffB); PG8_STAGE(PG8_SA(0, 0), cA, voffA); PG8_STAGE(PG8_SA(0, 1), cA + hstep, voffA);
        if (wr == 1) PG8_BAR;
        PG8_WAIT_V(2); PG8_BAR;
        PG8_STAGE(PG8_SB(1, 0), cB + kstep, voffB); PG8_STAGE(PG8_SA(1, 0), cA + kstep, voffA); PG8_STAGE(PG8_SB(1, 1), cB + hstep + kstep, voffB);
        PG8_WAIT_V(6); PG8_BAR;
    } else {
        PG8_STAGE(PG8_SB(0, 0), cB, voffB); PG8_STAGE(PG8_SA(0, 0), cA, voffA); PG8_STAGE(PG8_SB(0, 1), cB + hstep, voffB); PG8_STAGE(PG8_SA(0, 1), cA + hstep, voffA);
        if (wr == 1) PG8_BAR;
        PG8_WAIT_V(4); PG8_BAR;
        PG8_STAGE(PG8_SB(1, 0), cB + kstep, voffB); PG8_STAGE(PG8_SA(1, 0), cA + kstep, voffA); PG8_STAGE(PG8_SB(1, 1), cB + hstep + kstep, voffB);
        PG8_WAIT_V(6); PG8_BAR;
    }
    for (;;) {
        const bool has_next = S.next(ui + 1, nxt);
        const char* nA = has_next ? (const char*)g.A + (size_t)nxt.pm * tstep : cA; const char* nB = has_next ? (const char*)g.Bt + (size_t)nxt.pn * tstep : cB;
        for (int t = 0; t < nt; t += 2) {
            const bool last = (t == nt - 2);
            const char* a1 = cA + (size_t)(t + 1) * kstep;
            const char* a2 = last ? nA : cA + (size_t)(t + 2) * kstep; const char* b2 = last ? nB : cB + (size_t)(t + 2) * kstep;
            const char* a3 = a2 + kstep; const char* b3 = b2 + kstep;
            if (last && has_next) S.a_ready(nxt);
            if constexpr (SP2) {
            PG8_LDB(B0, 0, 0); PG8_LDB(B1, 0, 1); PG8_SCHED; PG8_LDA(At, 0, 0); PG8_STAGE(PG8_SA(1, 1), a1 + hstep, voffA);
            PG8_WAIT_V(8); PG8_WAIT_L(0); PG8_BAR; PG8_MMA(0, 0, At, B0); PG8_MMA(0, 1, At, B1); PG8_BAR; PG8_SCHED;
            PG8_LDA(At, 0, 1); PG8_STAGE(PG8_SB(0, 0), b2, voffB); PG8_STAGE(PG8_SB(0, 1), b2 + hstep, voffB); PG8_STAGE(PG8_SA(0, 0), a2, voffA);
            PG8_WAIT_V(8); PG8_WAIT_L(0); PG8_BAR; PG8_MMA(1, 0, At, B0); PG8_MMA(1, 1, At, B1); PG8_BAR; PG8_SCHED;
            PG8_LDB(B0, 1, 0); PG8_LDB(B1, 1, 1); PG8_SCHED; PG8_LDA(At, 1, 0); PG8_STAGE(PG8_SA(0, 1), a2 + hstep, voffA);
            PG8_WAIT_V(8); PG8_WAIT_L(0); PG8_BAR; PG8_MMA(0, 0, At, B0); PG8_MMA(0, 1, At, B1); PG8_BAR; PG8_SCHED;
            PG8_LDA(At, 1, 1); PG8_STAGE(PG8_SB(1, 0), b3, voffB); PG8_STAGE(PG8_SB(1, 1), b3 + hstep, voffB); PG8_STAGE(PG8_SA(1, 0), a3, voffA);
            PG8_WAIT_V(8); PG8_WAIT_L(0); PG8_BAR; PG8_MMA(1, 0, At, B0); PG8_MMA(1, 1, At, B1); PG8_BAR; PG8_SCHED;
            } else {
            PG8_LDB(B0, 0, 0); PG8_SCHED; PG8_LDA(At, 0, 0); PG8_STAGE(PG8_SA(1, 1), a1 + hstep, voffA);
            PG8_WAIT_L(8); PG8_BAR; PG8_WAIT_L(0); PG8_MMA(0, 0, At, B0); PG8_BAR; PG8_SCHED;
            PG8_LDB(B1, 0, 1); PG8_STAGE(PG8_SB(0, 0), b2, voffB);
            PG8_BAR; PG8_WAIT_L(0); PG8_MMA(0, 1, At, B1); PG8_BAR;
            PG8_LDA(At, 0, 1); PG8_STAGE(PG8_SA(0, 0), a2, voffA);
            PG8_BAR; PG8_WAIT_L(0); PG8_MMA(1, 0, At, B0); PG8_BAR; PG8_SCHED;
            PG8_STAGE(PG8_SB(0, 1), b2 + hstep, voffB);
            PG8_WAIT_V(6); PG8_BAR; PG8_MMA(1, 1, At, B1); PG8_BAR;
            PG8_LDB(B0, 1, 0); PG8_SCHED; PG8_LDA(At, 1, 0); PG8_STAGE(PG8_SA(0, 1), a2 + hstep, voffA);
            PG8_WAIT_L(8); PG8_BAR; PG8_WAIT_L(0); PG8_MMA(0, 0, At, B0); PG8_BAR; PG8_SCHED;
            PG8_LDB(B1, 1, 1); PG8_STAGE(PG8_SB(1, 0), b3, voffB);
            PG8_BAR; PG8_WAIT_L(0); PG8_MMA(0, 1, At, B1); PG8_BAR;
            PG8_LDA(At, 1, 1); PG8_STAGE(PG8_SA(1, 0), a3, voffA);
            PG8_BAR; PG8_WAIT_L(0); PG8_MMA(1, 0, At, B0); PG8_BAR; PG8_SCHED;
            PG8_STAGE(PG8_SB(1, 1), b3 + hstep, voffB);
            PG8_WAIT_V(6); PG8_BAR; PG8_MMA(1, 1, At, B1); PG8_BAR;
            }
        }
        if constexpr (ALIGN_EPI) { if (wr == 0) PG8_BAR; }
        if constexpr (!Epi::AFTER_DRAIN) { E(acc, cur, wr, wc, fr, fq); S.done(cur); }
        if (!has_next) break;
#pragma unroll
        for (int a = 0; a < 2; ++a)
#pragma unroll
            for (int b = 0; b < 2; ++b)
#pragma unroll
                for (int m = 0; m < 4; ++m)
#pragma unroll
                    for (int n = 0; n < 2; ++n) acc[a][b][m][n] = (f32x4){0.f, 0.f, 0.f, 0.f};
        cur = nxt; cA = nA; cB = nB; ++ui;
        if constexpr (ALIGN_EPI) { if (wr == 1) PG8_BAR; }
    }
    PG8_WAIT_V(0);
    if constexpr (!ALIGN_EPI) { if (wr == 0) PG8_BAR; }
    PG8_BAR;
    if constexpr (Epi::AFTER_DRAIN) { E.fused(acc, cur, wr, wc, fr, fq, lds, wid, lane); S.done(cur); }
#undef PG8_SA
#undef PG8_SB
#undef PG8_STAGE
#undef PG8_LDA
#undef PG8_LDB
#undef PG8_MMA
#undef PG8_WAIT_V
#undef PG8_WAIT_L
#undef PG8_BAR
#undef PG8_SCHED
}
}
namespace fa {

constexpr int D = 128, LD = 4096;
constexpr float SCALE = 0.08838834764831845f;
constexpr float INV_SCALE = 11.313708498984761f;
constexpr float THR = 8.f;
constexpr bool WSKIP = false;
constexpr int NW = 8, QBLK = 32, KVBLK = 64, QB = NW * QBLK;
constexpr int SHM_V = KVBLK * D * 2, SHM_K = KVBLK * D * 2;
constexpr int LDS_BODY = 2 * SHM_V + 2 * SHM_K + NW * 64 * 4;
using bf16 = unsigned short;
typedef short bf16x8 __attribute__((ext_vector_type(8)));
typedef short s16x4 __attribute__((ext_vector_type(4)));
typedef float f32x16 __attribute__((ext_vector_type(16)));
typedef float f32x4 __attribute__((ext_vector_type(4)));
typedef unsigned u32x4 __attribute__((ext_vector_type(4)));
template <class A, class Bt> struct same_t { static constexpr bool v = false; };
template <class A> struct same_t<A, A> { static constexpr bool v = true; };

#define KSWZ(row, colB) ((row) * 256 + ((colB) ^ (((row) & 7) << 4)))
#define SBAR() __builtin_amdgcn_sched_barrier(0)
__device__ __forceinline__ int v_st(int k, int c) { const int kk = (k & ~0xC) | ((k & 4) << 1) | ((k & 8) >> 1); return ((kk >> 3) * 4 + (c >> 5)) * 512 + ((kk & 7) * 32 + (c & 31)) * 2; }
__device__ __forceinline__ int v_rd_base(int lane) { return ((lane & 3) << 3) | (((lane >> 2) & 3) << 6) | (((lane >> 4) & 1) << 5) | (((lane >> 5) & 1) << 8); }
constexpr int v_rd_off(int d0, int ks, int half) { return d0 * 512 + ks * 4096 + half * 2048; }
__device__ __forceinline__ int crow(int r, int hi) { return (r & 3) + 8 * (r >> 2) + 4 * hi; }
__device__ __forceinline__ unsigned cvtpk(float lo, float hi) {
    unsigned r; asm volatile("v_cvt_pk_bf16_f32 %0, %1, %2" : "=v"(r) : "v"(lo), "v"(hi)); return r;
}
__device__ __forceinline__ bf16x8 pack8(f32x4 a, f32x4 b) {
    u32x4 w = {cvtpk(a[0], a[1]), cvtpk(a[2], a[3]), cvtpk(b[0], b[1]), cvtpk(b[2], b[3])};
    return *reinterpret_cast<bf16x8*>(&w);
}
template <class T> __device__ __forceinline__ bf16x8 load8(const T* p) {
    if constexpr (same_t<T, float>::v) { return pack8(*(const f32x4*)p, *(const f32x4*)(p + 4)); }
    else { return *reinterpret_cast<const bf16x8*>(p); }
}
__device__ __forceinline__ void mask_tile(f32x16& p0, f32x16& p1, int dq, unsigned W) {
    const float NEG = -__builtin_inff();
#pragma unroll
    for (int r = 0; r < 16; ++r) {
        const int c = (r & 3) + 8 * (r >> 2);
        if ((unsigned)(dq - c) >= W) p0[r] = NEG;
        if ((unsigned)(dq - c - 32) >= W) p1[r] = NEG;
    }
}
__device__ __forceinline__ void partialSM(f32x16& p0, f32x16& p1, float& m_reg, float& mn, float& alpha) {
    float pmax = p0[0]; for (int r = 1; r < 16; ++r) pmax = fmaxf(pmax, p0[r]); for (int r = 0; r < 16; ++r) pmax = fmaxf(pmax, p1[r]);
    { auto rr = __builtin_amdgcn_permlane32_swap(__float_as_uint(pmax), __float_as_uint(pmax), false, false);
      pmax = fmaxf(__uint_as_float(rr[0]), __uint_as_float(rr[1])); }
    constexpr float C2 = 1.4426950408889634f * SCALE;
    if (__builtin_expect(__all((pmax - m_reg) * SCALE <= THR), 1)) { mn = m_reg; alpha = 1.f; }
    else { mn = fmaxf(m_reg, pmax); alpha = __builtin_amdgcn_exp2f((m_reg - mn) * C2); m_reg = mn; }
    const float mnL = -mn * C2;
    for (int r = 0; r < 16; ++r) p0[r] = fmaf(p0[r], C2, mnL); for (int r = 0; r < 16; ++r) p1[r] = fmaf(p1[r], C2, mnL);
    for (int r = 0; r < 16; ++r) p0[r] = __builtin_amdgcn_exp2f(p0[r]);
}
__device__ __forceinline__ void finishSM(f32x16& p0, f32x16& p1, float alpha, float& l_reg, bf16x8& pa0, bf16x8& pa1, bf16x8& pa2, bf16x8& pa3) {
    for (int r = 0; r < 16; ++r) p1[r] = __builtin_amdgcn_exp2f(p1[r]);
    float ps = 0; for (int r = 0; r < 16; ++r) ps += p0[r]; for (int r = 0; r < 16; ++r) ps += p1[r];
    { auto rr = __builtin_amdgcn_permlane32_swap(__float_as_uint(ps), __float_as_uint(ps), false, false);
      ps = __uint_as_float(rr[0]) + __uint_as_float(rr[1]); }
    l_reg = l_reg * alpha + ps;
#define PK4(P, B_, OUT) do { unsigned a0 = cvtpk(P[B_+0], P[B_+1]), a1 = cvtpk(P[B_+2], P[B_+3]);                          \
        unsigned b0 = cvtpk(P[B_+4], P[B_+5]), b1 = cvtpk(P[B_+6], P[B_+7]);                                             \
        auto r0 = __builtin_amdgcn_permlane32_swap(a0, b0, false, false); auto r1 = __builtin_amdgcn_permlane32_swap(a1, b1, false, false); \
        u32x4 w = {r0[0], r1[0], r0[1], r1[1]}; OUT = *reinterpret_cast<bf16x8*>(&w); } while (0)
    PK4(p0, 0, pa0); PK4(p0, 8, pa1); PK4(p1, 0, pa2); PK4(p1, 8, pa3);
#undef PK4
}
template <int KB, bool SK>
__device__ __forceinline__ void qkt(f32x16& p0, f32x16& p1, const char* K_lds, int r32, int hi, const bf16x8* qr, bool act, const __attribute__((address_space(3))) float* fk, float ft) {
    if (SK && !act) { const float NEG = -__builtin_inff();
#pragma unroll
        for (int r = 0; r < 16; ++r) { p0[r] = NEG; p1[r] = NEG; } return; }
#pragma unroll
    for (int g = 0; g < 4; ++g) { const f32x4 a = *(const __attribute__((address_space(3))) f32x4*)(fk + 8 * g), b = *(const __attribute__((address_space(3))) f32x4*)(fk + 32 + 8 * g);
#pragma unroll
        for (int i = 0; i < 4; ++i) { p0[4 * g + i] = ft - a[i]; p1[4 * g + i] = ft - b[i]; } }
    const char* kb[4];
#pragma unroll
    for (int dd = 0; dd < 4; ++dd) kb[dd] = K_lds + KB * SHM_K + KSWZ(r32, (dd * 16 + hi * 8) * 2);
#pragma unroll
    for (int d0 = 0; d0 < 8; ++d0) { const char* a = kb[d0 & 3] + (d0 >> 2) * 128;
        bf16x8 b0 = *reinterpret_cast<const bf16x8*>(a);
        bf16x8 b1 = *reinterpret_cast<const bf16x8*>(a + 32 * 256);
        p0 = __builtin_amdgcn_mfma_f32_32x32x16_bf16(b0, qr[d0], p0, 0, 0, 0);
        p1 = __builtin_amdgcn_mfma_f32_32x32x16_bf16(b1, qr[d0], p1, 0, 0, 0); }
}
template <int VB, bool SK>
__device__ __forceinline__ void pv_tile(f32x16* o, int vb0, bf16x8 pa0, bf16x8 pa1, bf16x8 pa2, bf16x8 pa3, bool act) {
    if (SK && !act) return;
#define TRRD(dst, off) asm volatile("ds_read_b64_tr_b16 %0, %1 offset:%2" : "=&v"(dst) : "v"(vb0), "i"(off) : "memory")
#define PV_D0(d0) do { s16x4 l0, l1, l2, l3, h0, h1, h2, h3; constexpr int b_ = VB * SHM_V + v_rd_off(d0, 0, 0);     \
        TRRD(l0, b_); TRRD(h0, b_ + 2048); TRRD(l1, b_ + 4096); TRRD(h1, b_ + 6144); TRRD(l2, b_ + 8192); TRRD(h2, b_ + 10240); TRRD(l3, b_ + 12288); TRRD(h3, b_ + 14336); \
        asm volatile("s_waitcnt lgkmcnt(0)" ::: "memory"); SBAR();                 \
        o[d0] = __builtin_amdgcn_mfma_f32_32x32x16_bf16(pa0, (bf16x8){l0[0], l0[1], l0[2], l0[3], h0[0], h0[1], h0[2], h0[3]}, o[d0], 0, 0, 0);   \
        o[d0] = __builtin_amdgcn_mfma_f32_32x32x16_bf16(pa1, (bf16x8){l1[0], l1[1], l1[2], l1[3], h1[0], h1[1], h1[2], h1[3]}, o[d0], 0, 0, 0);   \
        o[d0] = __builtin_amdgcn_mfma_f32_32x32x16_bf16(pa2, (bf16x8){l2[0], l2[1], l2[2], l2[3], h2[0], h2[1], h2[2], h2[3]}, o[d0], 0, 0, 0);   \
        o[d0] = __builtin_amdgcn_mfma_f32_32x32x16_bf16(pa3, (bf16x8){l3[0], l3[1], l3[2], l3[3], h3[0], h3[1], h3[2], h3[3]}, o[d0], 0, 0, 0); } while (0)
    PV_D0(0); PV_D0(1); PV_D0(2); PV_D0(3);
#undef PV_D0
#undef TRRD
}

constexpr size_t V_OFF = (size_t)16384 * 4096, Z_OFF = 3 * V_OFF, O_OFF = 4 * V_OFF;
template <class TIn, class TOut> struct BlockRef { const TIn* Q; const TIn* K; int P0; int JLO; };
template <class TIn> struct Seam {
    bf16x8 qr[8];
    bf16x8 st_v0, st_v1, st_k0, st_k1; f32x4 sf0, sf1, sf2, sf3;
    f32x4 tq[16];
};
__device__ __forceinline__ int swa_jlo(int P0, int W) { const int lowk = P0 - W + 1; return lowk > 0 ? lowk / KVBLK : 0; }
#define ROW(p, k0, rr) ((p) + (size_t)((k0) + (rr)) * LD + sc)
#define VMW() asm volatile("s_waitcnt vmcnt(0)" ::: "memory")
#define VMWN(n) asm volatile("s_waitcnt vmcnt(%0)" :: "i"(n) : "memory")
#define SLOAD_H(Kp, Vp, k0) do { S.st_v0 = load8<TIn>(ROW(Vp, k0, sr)); S.st_v1 = load8<TIn>(ROW(Vp, k0, 32 + sr));              \
                         S.st_k0 = load8<TIn>(ROW(Kp, k0, sr)); S.st_k1 = load8<TIn>(ROW(Kp, k0, 32 + sr)); } while (0)
#define SWRITE_HK(bf) do { *(bf16x8*)(K_lds + (bf) * SHM_K + kws) = S.st_k0; *(bf16x8*)(K_lds + (bf) * SHM_K + kws + 32 * 256) = S.st_k1; } while (0)
#define SWRITE_HV(bf) do { *(bf16x8*)(V_lds + (bf) * SHM_V + vst0) = S.st_v0; *(bf16x8*)(V_lds + (bf) * SHM_V + vst1) = S.st_v1; } while (0)
#define SWRITE_H(bf) do { SWRITE_HV(bf); SWRITE_HK(bf); } while (0)
#define SLOAD_F(p, k0) do { S.sf0 = *(const f32x4*)ROW(p, k0, sr); S.sf1 = *(const f32x4*)(ROW(p, k0, sr) + 4);                \
                            S.sf2 = *(const f32x4*)ROW(p, k0, 32 + sr); S.sf3 = *(const f32x4*)(ROW(p, k0, 32 + sr) + 4); } while (0)
#define SWRITE_KF(bf) do { *(bf16x8*)(K_lds + (bf) * SHM_K + kws) = pack8(S.sf0, S.sf1); *(bf16x8*)(K_lds + (bf) * SHM_K + kws + 32 * 256) = pack8(S.sf2, S.sf3); } while (0)
#define SWRITE_VF(bf) do { *(bf16x8*)(V_lds + (bf) * SHM_V + vst0) = pack8(S.sf0, S.sf1); *(bf16x8*)(V_lds + (bf) * SHM_V + vst1) = pack8(S.sf2, S.sf3); } while (0)
template <class TIn, class TOut>
__device__ __forceinline__ void causal_swa_prime(const BlockRef<TIn, TOut>& cur, int W, char* lds, Seam<TIn>& S) {
    constexpr bool F32 = same_t<TIn, float>::v;
    const int tid = threadIdx.x, wid = __builtin_amdgcn_readfirstlane(tid >> 6), lane = tid & 63, r32 = lane & 31, hi = lane >> 5;
    const int sr = tid >> 4, sc = (tid & 15) * 8, kws = KSWZ(sr, sc * 2); char* K_lds = lds + 2 * SHM_V;
    const int kb0 = ((cur.P0 + QB - 1) / KVBLK) * KVBLK;
    for (int d0 = 0; d0 < 8; ++d0) S.qr[d0] = load8<TIn>(cur.Q + (size_t)(wid * QBLK + r32) * LD + d0 * 16 + hi * 8);
    if constexpr (F32) { SLOAD_F((const float*)cur.K, kb0); VMW(); SWRITE_KF(0); SBAR(); SLOAD_F((const float*)(cur.K + V_OFF), kb0); }
    else { SLOAD_H(cur.K, (cur.K + V_OFF), kb0); VMW(); SWRITE_HK(0); }
    __syncthreads();
}
template <class TIn, class TOut>
__device__ __forceinline__ void causal_swa_reprime(const BlockRef<TIn, TOut>& cur, char* lds, Seam<TIn>& S) {
    const int tid = threadIdx.x;
    const int sr = tid >> 4, sc = (tid & 15) * 8, kws = KSWZ(sr, sc * 2); char* K_lds = lds + 2 * SHM_V;
    const int kb0 = ((cur.P0 + QB - 1) / KVBLK) * KVBLK;
    SLOAD_H(cur.K, (cur.K + V_OFF), kb0); VMW(); SWRITE_HK(0);
    __syncthreads();
}
template <class TIn, class TOut>
__device__ __forceinline__ void causal_swa_block(const BlockRef<TIn, TOut>& cur, const BlockRef<TIn, TOut>& nxt, int skv, int W, char* lds, Seam<TIn>& S, const __attribute__((address_space(3))) float* fabs_l) {
    constexpr bool F32 = same_t<TIn, float>::v;
    const int tid = threadIdx.x, wid = __builtin_amdgcn_readfirstlane(tid >> 6), lane = tid & 63, r32 = lane & 31, hi = lane >> 5;
    const int j_lo = cur.JLO;
    int j_hi = (cur.P0 + QB - 1) / KVBLK + 1; if (j_hi > skv / KVBLK) j_hi = skv / KVBLK;
    const int NT = j_hi - j_lo;
    const int kbn = ((nxt.P0 + QB - 1) / KVBLK) * KVBLK;
    const int qlo = cur.P0 + wid * QBLK, qm = qlo + r32 - 4 * hi;
    const float ft = __int_as_float(__builtin_amdgcn_readfirstlane(__float_as_int(fabs_l[qlo])));
#define FK(t) (fabs_l + KBASE(t) + 4 * hi)
    char* V_lds = lds; char* K_lds = lds + 2 * SHM_V;
    float* ws = (float*)(lds + 2 * SHM_V + 2 * SHM_K) + wid * 64; float* li_l = ws, * al_l = ws + 32;
    float m_reg = -1e30f, l_reg = 0; f32x16 o[4] = {};
    if (wid >= 4) __builtin_amdgcn_s_setprio(1);
    const int sr = tid >> 4, sc = (tid & 15) * 8, vst0 = v_st(sr, sc), vst1 = v_st(32 + sr, sc), kws = KSWZ(sr, sc * 2);
    const int vb0 = (int)(uintptr_t)V_lds + v_rd_base(lane);
    const TIn* Kh = cur.K; const TIn* Vh = (cur.K + V_OFF);
#define RESC(a) do { if (__any((a) < 1.f)) { if (hi == 0) al_l[r32] = (a); asm volatile("s_waitcnt lgkmcnt(0)" ::: "memory");              \
                     for (int d_ = 0; d_ < 4; ++d_) for (int r = 0; r < 16; ++r) o[d_][r] *= al_l[crow(r, hi)]; } } while (0)
#define KBASE(t) ((j_hi - 1 - (t)) * KVBLK)
#define ACT(t) (KBASE(t) <= qlo + QBLK - 1 && KBASE(t) + KVBLK - 1 >= qlo - W + 1)
#define MASKT(P0_, P1_, t) do { const int kb_ = KBASE(t); if ((!SK || ACT(t)) && (kb_ + KVBLK - 1 > qlo || kb_ <= qlo + QBLK - 1 - W)) mask_tile(P0_, P1_, qm - kb_, (unsigned)W); } while (0)
    constexpr int NQL = F32 ? 16 : 8;
    constexpr bool SK = WSKIP && !F32;
#define SEAM_K0() do { VMWN(NQL); if constexpr (F32) { SWRITE_KF(0); SBAR(); SLOAD_F((const float*)(nxt.K + V_OFF), kbn); } else { SWRITE_HK(0); } SBAR(); } while (0)
    f32x16 pA0, pA1, pB0, pB1; float mnA, mnB, alA, alB; bf16x8 pa0, pa1, pa2, pa3;
    if constexpr (F32) { VMW(); SWRITE_VF(0); SBAR(); } else { SWRITE_HV(0); SBAR(); }
    if (NT > 1) { if constexpr (F32) SLOAD_F((const float*)Kh, KBASE(1)); else SLOAD_H(Kh, Vh, KBASE(1)); }
    SBAR(); qkt<0, SK>(pA0, pA1, K_lds, r32, hi, S.qr, ACT(0), FK(0), ft);
    if constexpr (F32) { if (NT > 1) { VMW(); SWRITE_KF(1); SBAR(); SLOAD_F((const float*)Vh, KBASE(1)); } }
    MASKT(pA0, pA1, 0); partialSM(pA0, pA1, m_reg, mnA, alA);
    if (NT > 1) { VMW(); if constexpr (F32) { SWRITE_VF(1); SBAR(); if (NT > 2) SLOAD_F((const float*)Kh, KBASE(2)); } else SWRITE_H(1); }
    __syncthreads();
#define HALF_STEP(PX0, PX1, mnX, alX, PY0, PY1, alY, t, KB, VB, SB) do {                                                      \
        SBAR(); qkt<KB, SK>(PX0, PX1, K_lds, r32, hi, S.qr, ACT(t), FK(t), ft);                                             \
        finishSM(PY0, PY1, alY, l_reg, pa0, pa1, pa2, pa3); SBAR();                                                           \
        if ((t) + 1 < NT) { if constexpr (F32) { VMW(); SWRITE_KF(SB); SBAR(); SLOAD_F((const float*)Vh, KBASE((t) + 1)); }  \
                            else { SLOAD_H(Kh, Vh, KBASE((t) + 1)); } SBAR(); }                                               \
        pv_tile<VB, SK>(o, vb0, pa0, pa1, pa2, pa3, ACT((t) - 1)); MASKT(PX0, PX1, (t)); partialSM(PX0, PX1, m_reg, mnX, alX);                                        \
        __syncthreads();                                                                                                      \
        if ((t) + 1 < NT) { VMW(); if constexpr (F32) { SWRITE_VF(SB); SBAR(); if ((t) + 2 < NT) SLOAD_F((const float*)Kh, KBASE((t) + 2)); } \
                            else { SWRITE_H(SB); } }                                                                          \
        RESC(alX); __syncthreads(); } while (0)
    for (int t = 1; t + 1 < NT; t += 2) {
        HALF_STEP(pB0, pB1, mnB, alB, pA0, pA1, alA, t, 1, 0, 0);
        HALF_STEP(pA0, pA1, mnA, alA, pB0, pB1, alB, t + 1, 0, 1, 1);
    }
    const bool even = (NT & 1) == 0;
    if (even) { SBAR(); qkt<1, SK>(pB0, pB1, K_lds, r32, hi, S.qr, ACT(NT - 1), FK(NT - 1), ft); SBAR(); }
#define QROW(e) (nxt.Q + (size_t)(wid * QBLK + r32) * D + ((e) >> 1) * 16 + hi * 8 + ((e) & 1) * 4)
    if constexpr (F32) { SLOAD_F((const float*)nxt.K, kbn); SBAR();
#pragma unroll
        for (int e = 0; e < 8; ++e) S.tq[e] = *(const f32x4*)QROW(e); }
    else { SLOAD_H(nxt.K, (nxt.K + V_OFF), kbn); SBAR();
#pragma unroll
        for (int d0 = 0; d0 < 8; ++d0) S.qr[d0] = load8<TIn>(nxt.Q + (size_t)(wid * QBLK + r32) * LD + d0 * 16 + hi * 8); }
    SBAR();
    finishSM(pA0, pA1, alA, l_reg, pa0, pa1, pa2, pa3); SBAR();
    if constexpr (F32) {
#pragma unroll
        for (int e = 8; e < 16; ++e) S.tq[e] = *(const f32x4*)QROW(e); SBAR(); }
#undef QROW
    pv_tile<0, SK>(o, vb0, pa0, pa1, pa2, pa3, ACT(even ? NT - 2 : NT - 1));
    if (even) { MASKT(pB0, pB1, NT - 1); partialSM(pB0, pB1, m_reg, mnB, alB); __syncthreads(); RESC(alB);
        finishSM(pB0, pB1, alB, l_reg, pa0, pa1, pa2, pa3); SBAR(); pv_tile<1, SK>(o, vb0, pa0, pa1, pa2, pa3, ACT(NT - 1)); }
    SBAR(); SEAM_K0();
    if (hi == 0) li_l[r32] = l_reg; asm volatile("s_waitcnt lgkmcnt(0)" ::: "memory");
    float rli[16];
#pragma unroll
    for (int r = 0; r < 16; ++r) rli[r] = __builtin_amdgcn_rcpf(li_l[crow(r, hi)]);
    unsigned loff = (unsigned)((4 * hi) * LD + r32) * 2u; asm volatile("" : "+v"(loff));
    char* Ow = (char*)((TOut*)cur.Q + O_OFF + (size_t)(wid * QBLK) * LD); const char* Zw = (const char*)(cur.Q + Z_OFF + (size_t)(wid * QBLK) * LD);
    unsigned yw[16][4];
#pragma unroll
    for (int r = 0; r < 16; ++r) { const size_t roff = (size_t)((r & 3) + 8 * (r >> 2)) * LD * 2;
#pragma unroll
        for (int d0 = 0; d0 < 4; ++d0) yw[r][d0] = *(const unsigned short*)(Zw + roff + d0 * 64 + loff); }
#pragma unroll
    for (int r = 0; r < 16; ++r) {
#pragma unroll
        for (int d0 = 0; d0 < 4; ++d0) { const float z = __uint_as_float(yw[r][d0] << 16);
            const float y = o[d0][r] * rli[r] * z * __builtin_amdgcn_rcpf(1.f + __expf(-z));
            const float yn = __shfl_xor(y, 1);
            yw[r][d0] = cvtpk(y, yn); } }
    if ((r32 & 1) == 0) {
#pragma unroll
        for (int r = 0; r < 16; ++r) { const size_t roff = (size_t)((r & 3) + 8 * (r >> 2)) * LD * 2;
#pragma unroll
            for (int d0 = 0; d0 < 4; ++d0) *(unsigned*)(Ow + roff + d0 * 64 + loff) = yw[r][d0]; } }
    if constexpr (F32) {
#pragma unroll
        for (int d0 = 0; d0 < 8; ++d0) S.qr[d0] = pack8(S.tq[2 * d0], S.tq[2 * d0 + 1]); }
    if (wid >= 4) __builtin_amdgcn_s_setprio(0);
    __syncthreads();
#undef RESC
#undef FK
#undef KBASE
#undef ACT
#undef MASKT
#undef SEAM_K0
#undef HALF_STEP
}
#undef ROW
#undef VMW
#undef VMWN
#undef SLOAD_H
#undef SWRITE_HK
#undef SWRITE_HV
#undef SWRITE_H
#undef SLOAD_F
#undef SWRITE_KF
#undef SWRITE_VF


}

#define GAS __attribute__((address_space(1)))
#define LAS __attribute__((address_space(3)))
typedef unsigned short bf16;
typedef unsigned v4u __attribute__((ext_vector_type(4)));
typedef unsigned v2u __attribute__((ext_vector_type(2)));
typedef float f32x4 __attribute__((ext_vector_type(4)));
typedef short bf16x8 __attribute__((ext_vector_type(8)));
typedef unsigned short u16x4 __attribute__((ext_vector_type(4)));
typedef float f32x2v __attribute__((ext_vector_type(2)));

constexpr int SEQ = 16384, DM = 4096;
constexpr int NLAYERS = 4;
constexpr int NWAVES = 8, NTHR = 512;
constexpr int LDS_BYTES = 147456;
constexpr int LDS_CTL = LDS_BYTES - 256;

constexpr size_t MiB = 1u << 20;
constexpr size_t WS_CTL = 0, CTL_ZERO_BYTES = 2 * MiB;
constexpr size_t WS_NRM = 1 * MiB;
constexpr size_t WS_QCNT = 1 * MiB + 65536;
constexpr size_t WS_ROWSS = 65536;
constexpr size_t WS_WFI0 = 2 * MiB, WS_WFI1 = 130 * MiB, WS_WFO0 = 258 * MiB, WS_WFO1 = 290 * MiB;
constexpr size_t WS_WLI = 322 * MiB, WS_WLO = 386 * MiB, WS_WMI = 418 * MiB, WS_WMO = 546 * MiB;
constexpr size_t WS_WFF0 = 578 * MiB, WS_WFF1 = WS_WFF0 + 256 * 1024, WS_WMG = WS_WFF0 + 512 * 1024, WS_WLA = 579 * MiB, WS_WLX = 581 * MiB;
constexpr size_t WS_HB = 584 * MiB;
constexpr size_t WS_P0 = 712 * MiB, WS_PSTRIDE = 128 * MiB;
constexpr size_t WS_Y = 1224 * MiB;
constexpr size_t WS_QP = 1352 * MiB, WS_KT = 1416 * MiB, WS_VT = 1480 * MiB, WS_NINT = 1608 * MiB;
constexpr size_t WS_FLOC = 1736 * MiB, WS_FTOT = 1738 * MiB, WS_CA = 1739 * MiB, WS_CB = WS_CA + 256 * 1024;
constexpr size_t WS_IG = 1740 * MiB, WS_LF = WS_IG + 512 * 1024, WS_W1 = 1741 * MiB, WS_W2 = WS_W1 + 512 * 1024, WS_WK = 1742 * MiB, WS_EROW = WS_WK + 512 * 1024;
constexpr size_t WS_BC = 1743 * MiB, WS_IGB = WS_BC + 512 * 1024, WS_DMAX = 1744 * MiB, WS_DENI = WS_DMAX + 512 * 1024, WS_DEC = 1745 * MiB;
constexpr size_t WS_END = 1746 * MiB;

__device__ __forceinline__ float bf2f(unsigned short b) { return __uint_as_float((unsigned)b << 16); }
__device__ __forceinline__ unsigned pk2(float lo, float hi) { return pg8::cvt_pk_bf16(lo, hi); }
__device__ __forceinline__ float sigmoidf_(float x) { return __builtin_amdgcn_rcpf(1.f + __expf(-x)); }
__device__ __forceinline__ float logsigmoidf_(float x) { return fminf(x, 0.f) - log1pf(__expf(-fabsf(x))); }
#define LDS_WAIT() asm volatile("s_waitcnt lgkmcnt(0)" ::: "memory")
#define VM_WAIT() asm volatile("s_waitcnt vmcnt(0)" ::: "memory")
#define MFMA16(a, b, c) __builtin_amdgcn_mfma_f32_16x16x32_bf16(a, b, c, 0, 0, 0)

#define XB_TMO      128
#define XB_XCNT(j)  (256  + 64 * (j))
#define XB_XSUB(j)  (1280 + 64 * (j))
#define XB_XGEN(j)  (2304 + 64 * (j))
#define XB_TOP      3328
#define XB_TOPGEN   3392
#define XCD_BAR_WORDS 3456
#define XB_SPIN_CAP (1u << 18)

__device__ __forceinline__ unsigned xb_ld(unsigned* p)              { return __hip_atomic_load(p, __ATOMIC_RELAXED, __HIP_MEMORY_SCOPE_AGENT); }
__device__ __forceinline__ unsigned xb_add(unsigned* p, unsigned v) { return __hip_atomic_fetch_add(p, v, __ATOMIC_RELAXED, __HIP_MEMORY_SCOPE_AGENT); }
__device__ __forceinline__ unsigned xb_xcc_id() { return (unsigned)__builtin_amdgcn_s_getreg((3 << 11) | 20) & 0xFu; }
#define XB_SPIN(cond, bar) do { unsigned _sp = 0; while (cond) { __builtin_amdgcn_s_sleep(1); \
    if ((++_sp & 255u) == 0u) { if (xb_ld(&(bar)[XB_TMO])) break; if (_sp > XB_SPIN_CAP) { atomicAdd(&(bar)[XB_TMO], 1u); break; } } } } while (0)

struct XcdBarrier {
    unsigned* bar; unsigned x;
    volatile LAS unsigned* st;
};
__device__ __forceinline__ XcdBarrier xcd_barrier_post(unsigned* bar, volatile LAS unsigned* st) {
    XcdBarrier b; b.bar = bar; b.x = xb_xcc_id(); b.st = st;
    if (threadIdx.x == 0) (void)xb_add(&bar[XB_XCNT(b.x)], 1u);
    return b;
}
__device__ __forceinline__ void xcd_barrier_complete(unsigned* bar, unsigned x, unsigned& nloc, unsigned& nx) {
    const unsigned G = gridDim.x * gridDim.y * gridDim.z;
    unsigned sum, cnt, mine, sp = 0u;
    for (;;) {
        sum = 0u; cnt = 0u; mine = 0u;
#pragma unroll
        for (unsigned j = 0; j < 16; ++j) { const unsigned c = xb_ld(&bar[XB_XCNT(j)]); sum += c; cnt += (c > 0u) ? 1u : 0u; mine = (j == x) ? c : mine; }
        if (sum == G) break;
        __builtin_amdgcn_s_sleep(1);
        if ((++sp & 255u) == 0u) { if (xb_ld(&bar[XB_TMO])) break; if (sp > XB_SPIN_CAP) { atomicAdd(&bar[XB_TMO], 1u); break; } }
    }
    nloc = mine > 0u ? mine : 1u; nx = cnt > 0u ? cnt : 1u;
}
__device__ __forceinline__ void xcd_barrier(const XcdBarrier& b) {
    asm volatile("s_waitcnt vmcnt(0)" ::: "memory");
    __syncthreads();
    if (threadIdx.x == 0) {
        unsigned* bar = b.bar;
        __builtin_amdgcn_s_waitcnt(0);
        unsigned nloc = b.st[0], nx = b.st[1];
        if (nloc == 0u) { xcd_barrier_complete(bar, b.x, nloc, nx); b.st[0] = nloc; b.st[1] = nx; }
        const unsigned old = xb_add(&bar[XB_XSUB(b.x)], 1u);
        const unsigned gen = old / nloc;
        if (old + 1u == (gen + 1u) * nloc) {
            __builtin_amdgcn_fence(__ATOMIC_RELEASE, "agent");
            asm volatile("s_waitcnt vmcnt(0)" ::: "memory");
            const unsigned og = xb_add(&bar[XB_TOP], 1u);
            const unsigned tg = og / nx;
            if (og + 1u == (tg + 1u) * nx) xb_add(&bar[XB_TOPGEN], 1u);
            else XB_SPIN(xb_ld(&bar[XB_TOPGEN]) == tg, bar);
            __builtin_amdgcn_fence(__ATOMIC_ACQUIRE, "agent");
            xb_add(&bar[XB_XGEN(b.x)], 1u);
            asm volatile("s_waitcnt vmcnt(0)" ::: "memory");
        } else {
            XB_SPIN(xb_ld(&bar[XB_XGEN(b.x)]) == gen, bar);
            __builtin_amdgcn_fence(__ATOMIC_ACQUIRE, "agent");
            asm volatile("s_waitcnt vmcnt(0)" ::: "memory");
        }
    }
    __syncthreads();
}

struct Params { const float* in[19]; float* out; unsigned char* ws; int ph_lo, ph_hi; };
#define CAS __attribute__((address_space(4)))
__device__ __forceinline__ const float* late_in(int k) { const CAS char* ka = (const CAS char*)__builtin_amdgcn_kernarg_segment_ptr(); asm volatile("" : "+s"(ka));
    return *(const float* const CAS*)(ka + 8 * k); }
__device__ __forceinline__ float* late_out() { const CAS char* ka = (const CAS char*)__builtin_amdgcn_kernarg_segment_ptr(); asm volatile("" : "+s"(ka));
    return *(float* const CAS*)(ka + 8 * 19); }

struct TrSeg { const float* W; int ldn, col0, ncb; bf16* WT; int K; const LAS float* gain; };
__device__ __forceinline__ void tr_load(const TrSeg& s, int item, int lane, float (&v)[32]) {
    const int kb = item / s.ncb, nb = item - kb * s.ncb, k0 = 64 * kb, n0 = 32 * nb;
    const float* src = s.W + (size_t)(k0 + (lane >> 5)) * s.ldn + s.col0 + n0 + (lane & 31);
#pragma unroll
    for (int i = 0; i < 32; ++i) v[i] = src[(size_t)(2 * i) * s.ldn];
}
__device__ __forceinline__ void tr_store(const TrSeg& s, int item, int lane, const float (&v)[32], LAS float* scr) {
    const int kb = item / s.ncb, nb = item - kb * s.ncb, k0 = 64 * kb, n0 = 32 * nb;
#pragma unroll
    for (int i = 0; i < 32; ++i) { const int kk = 2 * i + (lane >> 5); const float g = s.gain ? s.gain[k0 + kk] : 1.f; scr[kk * 33 + (lane & 31)] = v[i] * g; }
    LDS_WAIT(); asm volatile("" ::: "memory");
    const int c = lane & 7;
#pragma unroll
    for (int j = 0; j < 4; ++j) { const int n = (lane >> 3) + 8 * j; const LAS float* p = scr + (8 * c) * 33 + n;
        v4u o; o.x = pk2(p[0 * 33], p[1 * 33]); o.y = pk2(p[2 * 33], p[3 * 33]); o.z = pk2(p[4 * 33], p[5 * 33]); o.w = pk2(p[6 * 33], p[7 * 33]);
        *(v4u*)(s.WT + (size_t)(n0 + n) * s.K + k0 + 8 * c) = o; }
    LDS_WAIT(); asm volatile("" ::: "memory");
}
__device__ __forceinline__ float wave_sum(float v) {
#pragma unroll
    for (int o = 1; o < 64; o <<= 1) v += __shfl_xor(v, o);
    return v;
}
__device__ __forceinline__ void p0_prologue(const Params& p, LAS unsigned char* lds, int tid) {
    const int lane = tid & 63, wave = __builtin_amdgcn_readfirstlane(tid >> 6);
    LAS float* scr = (LAS float*)(lds + wave * 8448);
    LAS float* GL = (LAS float*)(lds + 69632);
    for (int i = tid; i < 4 * 4096; i += NTHR) GL[i] = p.in[1][i];
    __syncthreads();
    const int gw = blockIdx.x * NWAVES + wave, NGW = gridDim.x * NWAVES;
    unsigned char* ws = p.ws;
    const LAS float* ng = GL;
    int rot_ = 0;
#define SEG(Wp, ldn_, col0_, ncols, dst, K_, gain_) do { TrSeg sg_; sg_.W = (Wp); sg_.ldn = (ldn_); sg_.col0 = (col0_); sg_.ncb = (ncols) / 32; sg_.WT = (dst); sg_.K = (K_); sg_.gain = (gain_); \
        const int nit_ = ((K_) / 64) * sg_.ncb; float va_[32], vb_[32]; int it = gw - rot_; if (it < 0) it += NGW; rot_ = (rot_ + nit_) % NGW;     \
        if (it < nit_) tr_load(sg_, it, lane, va_); \
        for (; it < nit_; it += 2 * NGW) { const bool nx_ = it + NGW < nit_, nx2_ = it + 2 * NGW < nit_; \
            if (nx_) tr_load(sg_, it + NGW, lane, vb_); \
            tr_store(sg_, it, lane, va_, scr); \
            if (nx2_) tr_load(sg_, it + 2 * NGW, lane, va_); \
            if (nx_) tr_store(sg_, it + NGW, lane, vb_, scr); } } while (0)
    SEG(p.in[2], 16416, 16384, 32, (bf16*)(ws + WS_WFF0), 4096, ng + 0 * 4096);
    SEG(p.in[2] + (size_t)4096 * 16416, 16416, 0, 16384, (bf16*)(ws + WS_WFI1), 4096, ng + 3 * 4096);
    SEG(p.in[2] + (size_t)4096 * 16416, 16416, 16384, 32, (bf16*)(ws + WS_WFF1), 4096, ng + 3 * 4096);
    SEG(p.in[4], 4096, 0, 4096, (bf16*)(ws + WS_WFO0), 4096, (const LAS float*)nullptr);
    SEG(p.in[4] + (size_t)4096 * 4096, 4096, 0, 4096, (bf16*)(ws + WS_WFO1), 4096, (const LAS float*)nullptr);
    SEG(p.in[5], 8192, 0, 8192, (bf16*)(ws + WS_WLI), 4096, ng + 1 * 4096);
    SEG(p.in[13], 4096, 0, 4096, (bf16*)(ws + WS_WLO), 4096, (const LAS float*)nullptr);
    for (int n = 0; n < 16; ++n) {
        SEG(p.in[8] + (size_t)n * 65536, 256, 0, 256, (bf16*)(ws + WS_WLA) + (size_t)n * 65536, 256, (const LAS float*)nullptr);
        SEG(p.in[10] + (size_t)n * 65536, 256, 0, 256, (bf16*)(ws + WS_WLX) + (size_t)n * 65536, 256, (const LAS float*)nullptr);
    }
    SEG(p.in[14], 16400, 0, 12288, (bf16*)(ws + WS_WMI), 4096, ng + 2 * 4096);
    SEG(p.in[14], 16400, 12288, 32, (bf16*)(ws + WS_WMG), 4096, ng + 2 * 4096);
    SEG(p.in[14], 16400, 12304, 4096, (bf16*)(ws + WS_WMI) + (size_t)12288 * 4096, 4096, ng + 2 * 4096);
    SEG(p.in[17], 4096, 0, 4096, (bf16*)(ws + WS_WMO), 4096, (const LAS float*)nullptr);
    SEG(p.in[2], 16416, 0, 16384, (bf16*)(ws + WS_WFI0), 4096, ng + 0 * 4096);
#undef SEG
    const float* x = p.in[0]; bf16* hb = (bf16*)(ws + WS_HB); unsigned long long* ss0 = (unsigned long long*)(ws + WS_ROWSS);
    for (int m = gw; m < SEQ; m += NGW) {
        const f32x4* xr = (const f32x4*)(x + (size_t)m * DM) + lane; unsigned long long* o8 = (unsigned long long*)(hb + (size_t)m * DM) + lane; float s = 0.f;
#pragma unroll
        for (int j = 0; j < 16; ++j) { const f32x4 v = xr[64 * j]; const unsigned w0 = pk2(v.x, v.y), w1 = pk2(v.z, v.w);
            const float r0 = __uint_as_float(w0 << 16), r1 = __uint_as_float(w0 & 0xffff0000u), r2 = __uint_as_float(w1 << 16), r3 = __uint_as_float(w1 & 0xffff0000u);
            s += (r0 * r0 + r1 * r1) + (r2 * r2 + r3 * r3);
            o8[64 * j] = (unsigned long long)w0 | ((unsigned long long)w1 << 32); }
        s = wave_sum(s);
        if (lane == 0) ss0[m] = (unsigned long long)(s * 1048576.0f + 0.5f);
    }
}

template <int NT>
__device__ __forceinline__ void side_gate_tile(const bf16* hb, const bf16* Wg, int row0, int lane, f32x4 (&acc)[NT]) {
    const int fr = lane & 15, fq = lane >> 4;
    const bf16* ap = hb + (size_t)(row0 + fr) * DM + 8 * fq;
    const bf16* bp = Wg + (size_t)fr * DM + 8 * fq;
#pragma unroll
    for (int nt = 0; nt < NT; ++nt) acc[nt] = (f32x4){0.f, 0.f, 0.f, 0.f};
    bf16x8 a0[4], b0[NT][4], a1[4], b1[NT][4];
#define SG_LOAD(a, b, k0_) do { _Pragma("unroll") for (int j = 0; j < 4; ++j) a[j] = *(const bf16x8*)(ap + (k0_) + 32 * j); \
        _Pragma("unroll") for (int nt = 0; nt < NT; ++nt) _Pragma("unroll") for (int j = 0; j < 4; ++j) b[nt][j] = *(const bf16x8*)(bp + (size_t)nt * 16 * DM + (k0_) + 32 * j); } while (0)
#define SG_MMA(a, b) do { _Pragma("unroll") for (int j = 0; j < 4; ++j) _Pragma("unroll") for (int nt = 0; nt < NT; ++nt) acc[nt] = MFMA16(a[j], b[nt][j], acc[nt]); } while (0)
    SG_LOAD(a0, b0, 0);
#pragma unroll 1
    for (int k0 = 0; k0 < DM; k0 += 256) { SG_LOAD(a1, b1, k0 + 128); SG_MMA(a0, b0); SG_LOAD(a0, b0, (k0 + 256) & (DM - 1)); SG_MMA(a1, b1); }
#undef SG_LOAD
#undef SG_MMA
}
__device__ __forceinline__ void fox_gates(const bf16* hb, const bf16* Wf, const unsigned long long* rowss, const float* b_f, float* FLOC, float* FTOT, int tid) {
    const int lane = tid & 63, wave = tid >> 6, fr = lane & 15, fq = lane >> 4;
    if (wave >= 4) return;
    for (int tile = blockIdx.x * 4 + wave; tile < SEQ / 16; tile += gridDim.x * 4) {
        const int row0 = tile * 16;
        f32x4 acc[2]; side_gate_tile<2>(hb, Wf, row0, lane, acc);
        float rs[4];
#pragma unroll
        for (int j = 0; j < 4; ++j) rs[j] = rsqrtf((float)rowss[row0 + 4 * fq + j] * (1.0f / (1048576.0f * 4096.0f)) + 1e-6f);
#pragma unroll
        for (int nt = 0; nt < 2; ++nt) { const int h = 16 * nt + fr; const float bb = b_f[h];
            float c[4]; float run = 0.f;
#pragma unroll
            for (int j = 0; j < 4; ++j) { run += logsigmoidf_(acc[nt][j] * rs[j] + bb); c[j] = run; }
            float inc = run; float u = __shfl_up(inc, 16); if (fq >= 1) inc += u; u = __shfl_up(inc, 32); if (fq >= 2) inc += u;
            const float exc = inc - run;
#pragma unroll
            for (int j = 0; j < 4; ++j) FLOC[(size_t)h * SEQ + row0 + 4 * fq + j] = exc + c[j];
            if (fq == 3) FTOT[h * 1024 + tile] = inc; }
    }
}
__device__ __forceinline__ void mlstm_gates(const bf16* hb, const bf16* Wg, const unsigned long long* rowss, const float* b_i, const float* b_f, float* IG, float* LF, int tid) {
    const int lane = tid & 63, wave = tid >> 6, fr = lane & 15, fq = lane >> 4;
    if (wave >= 4) return;
    for (int tile = blockIdx.x * 4 + wave; tile < SEQ / 16; tile += gridDim.x * 4) {
        const int row0 = tile * 16;
        f32x4 acc[1]; side_gate_tile<1>(hb, Wg, row0, lane, acc);
        const int h = fr & 7; const float bb = (fr < 8) ? b_i[h] : b_f[h];
#pragma unroll
        for (int j = 0; j < 4; ++j) { const int row = row0 + 4 * fq + j; const float rs = rsqrtf((float)rowss[row] * (1.0f / (1048576.0f * 4096.0f)) + 1e-6f);
            const float v = acc[0][j] * rs + bb;
            if (fr < 8) IG[(size_t)h * SEQ + row] = v; else LF[(size_t)h * SEQ + row] = logsigmoidf_(v); }
    }
}

__device__ __forceinline__ float fox_setup_fabs(char* lds, const float* FLOC, const float* FTOT, const unsigned* nrm, int h, int tid) {
    float* PH = (float*)(lds + fa::LDS_BODY); float* FABS = PH + 1024;
    asm volatile("" : "+v"(tid));
    const int lane = tid & 63;
    if (tid < 64) {
        const f32x4* src = (const f32x4*)(FTOT + h * 1024 + lane * 16);
        const f32x4 a = src[0], b = src[1], c = src[2], d = src[3];
        const float v[16] = {a[0], a[1], a[2], a[3], b[0], b[1], b[2], b[3], c[0], c[1], c[2], c[3], d[0], d[1], d[2], d[3]};
        float ex[16]; float run = 0.f;
#pragma unroll
        for (int i = 0; i < 16; ++i) { ex[i] = run; run += v[i]; }
        float inc = run;
#pragma unroll
        for (int o = 1; o < 64; o <<= 1) { const float u = __shfl_up(inc, o); if (lane >= o) inc += u; }
        const float base = inc - run;
#pragma unroll
        for (int i = 0; i < 16; ++i) PH[lane * 16 + i] = base + ex[i];
    }
    __syncthreads();
#pragma unroll
    for (int k = 0; k < SEQ / 4 / NTHR; ++k) { const int i = tid + NTHR * k; const f32x4 f = ((const f32x4*)(FLOC + (size_t)h * SEQ))[i]; const float ph = PH[i >> 2];
        ((f32x4*)FABS)[i] = (f + ph) * fa::INV_SCALE; }
    __syncthreads();
    float B = 0.f;
#pragma unroll
    for (int c = 0; c < 4; ++c) B += sqrtf(__uint_as_float(nrm[h * 4 + c])) * sqrtf(__uint_as_float(nrm[(32 + h) * 4 + c]));
    B *= 1.02f * fa::SCALE;
    return (105.0f + 2.0f * B) * fa::INV_SCALE;
}
__device__ __forceinline__ int fox_jlo(const float* FABS, int P0, float thp, int lane) {
    asm volatile("" : "+v"(lane));
    const float f0 = FABS[P0]; int cnt = 0;
#pragma unroll
    for (int c = 0; c < 4; ++c) { const int s = 64 * (64 * c + lane) + 63; const bool skip = (s < P0) && (FABS[s] - f0 >= thp); cnt += __popcll(__ballot(skip)); }
    return cnt;
}
__device__ __forceinline__ int fox_grab(unsigned* qcnt, volatile LAS unsigned* slot, int tid) {
    if (tid == 0) { const unsigned i = __hip_atomic_fetch_add(qcnt, 1u, __ATOMIC_RELAXED, __HIP_MEMORY_SCOPE_AGENT); *slot = i < 1024u ? i : 0xffffffffu; }
    __syncthreads();
    const int r = (int)*slot;
    __syncthreads();
    return r;
}
__device__ __forceinline__ void fox_attn_phase(char* lds, const bf16* Q, const bf16* K, const float* FLOC, const float* FTOT, const unsigned* nrm, unsigned* qcnt, int tid) {
    static_assert(WS_PSTRIDE / 2 == fa::V_OFF && (WS_Y - WS_P0) / 2 == fa::O_OFF, "attention tensor offsets");
    const int lane = tid & 63;
    volatile LAS unsigned* slot = (volatile LAS unsigned*)((LAS unsigned char*)lds + LDS_CTL) + 8;
    const float* FABS = (const float*)(lds + fa::LDS_BODY) + 1024;
    typedef fa::BlockRef<bf16, bf16> Ref;
#define FOX_REF(r, h_, qb_, jlo_) do { r.Q = Q + (size_t)(qb_) * fa::QB * fa::LD + (size_t)(h_) * fa::D; r.K = K + (size_t)(h_) * fa::D; r.P0 = (qb_) * fa::QB; r.JLO = (jlo_); } while (0)
#define FOX_ITEM(it_, h_, x_) do { h_ = 31 - ((it_) >> 5); x_ = 31 - ((it_) & 31); } while (0)
    int it = fox_grab(qcnt, slot, tid); if (it < 0) return;
    fa::Seam<bf16> S;
    int h, x, pass = 0, jl1; bool fresh = true; FOX_ITEM(it, h, x);
    float thp = fox_setup_fabs(lds, FLOC, FTOT, nrm, h, tid);
    Ref cur; FOX_REF(cur, h, x, fox_jlo(FABS, x * fa::QB, thp, lane)); jl1 = fox_jlo(FABS, (63 - x) * fa::QB, thp, lane);
    for (;;) {
        if (fresh) { fa::causal_swa_prime<bf16, bf16>(cur, SEQ, lds, S); fresh = false; }
        Ref nxt; if (pass == 0) { FOX_REF(nxt, h, 63 - x, jl1); } else nxt = cur;
        fa::causal_swa_block<bf16, bf16>(cur, nxt, SEQ, SEQ, lds, S, (const LAS float*)FABS);
        if (pass == 0) { pass = 1; cur = nxt; continue; }
        it = fox_grab(qcnt, slot, tid); if (it < 0) break;
        int hn, xn; FOX_ITEM(it, hn, xn);
        if (hn != h) thp = fox_setup_fabs(lds, FLOC, FTOT, nrm, hn, tid);
        h = hn; x = xn; pass = 0; fresh = true;
        FOX_REF(cur, h, x, fox_jlo(FABS, x * fa::QB, thp, lane)); jl1 = fox_jlo(FABS, (63 - x) * fa::QB, thp, lane);
    }
#undef FOX_REF
#undef FOX_ITEM
}

__device__ __forceinline__ void lru_scan_phase(char* ldsg, const Params& p, int tid) {
    unsigned char* ws = p.ws;
    const bf16* XB = (const bf16*)(ws + WS_P0); const bf16* Zt = (const bf16*)(ws + WS_P0 + WS_PSTRIDE);
    bf16* HZ = (bf16*)(ws + WS_P0 + 2 * WS_PSTRIDE); bf16* PZ = (bf16*)(ws + WS_P0 + 3 * WS_PSTRIDE);
    const bf16* WLA = (const bf16*)(ws + WS_WLA); const bf16* WLX = (const bf16*)(ws + WS_WLX);
    float* CA = (float*)(ws + WS_CA); float* CB = (float*)(ws + WS_CB);
    const float* conv_w = late_in(6); const float* conv_b = late_in(7); const float* b_a = late_in(9); const float* b_x = late_in(11); const float* lam = late_in(12);
    constexpr int XS = 264;
    bf16* XC = (bf16*)ldsg; bf16* PT = XC + 128 * XS; float* CW = (float*)(ldsg + 2 * 128 * XS * 2); float* CBs = CW + 1024;
    const int lane = tid & 63, wid = __builtin_amdgcn_readfirstlane(tid >> 6), fr = lane & 15, fq = lane >> 4;
    for (int u = blockIdx.x; u < 256; u += gridDim.x) {
        const int n = u & 15, sc = u >> 4;
        for (int i = tid; i < 1024; i += NTHR) CW[i] = conv_w[(i >> 8) * 4096 + n * 256 + (i & 255)];
        if (tid < 256) CBs[tid] = conv_b[n * 256 + tid];
        float ba[2], bx[2], nl[2], hc[2], pc[2];
#pragma unroll
        for (int nt = 0; nt < 2; ++nt) { const int c = n * 256 + 32 * wid + 16 * nt + fr; ba[nt] = b_a[c]; bx[nt] = b_x[c]; nl[nt] = -8.0f * log1pf(__expf(-lam[c])); hc[nt] = 0.f; pc[nt] = 1.f; }
        __syncthreads();
        for (int tile = 0; tile < 8; ++tile) {
            const int T0 = sc * 1024 + tile * 128;
            int tidq = tid; asm volatile("" : "+v"(tidq));
            { const int c0 = (tidq & 31) * 8, tq = tidq >> 5;
                float wv[4][8], bv[8];
#pragma unroll
                for (int e = 0; e < 8; ++e) bv[e] = CBs[c0 + e];
#pragma unroll
                for (int j = 0; j < 4; ++j)
#pragma unroll
                    for (int e = 0; e < 8; ++e) wv[j][e] = CW[j * 256 + c0 + e];
                const bf16* xrow = XB + (size_t)T0 * DM + n * 256 + c0;
                bf16x8 xv[8][4];
#pragma unroll
                for (int i = 0; i < 8; ++i)
#pragma unroll
                    for (int j = 0; j < 4; ++j) { const int dt = tq + 16 * i - 3 + j;
                        if (i == 0) { const bool neg = T0 + dt < 0; xv[i][j] = *(const bf16x8*)(xrow + (ptrdiff_t)(neg ? -T0 : dt) * DM); }
                        else xv[i][j] = *(const bf16x8*)(xrow + (ptrdiff_t)dt * DM); }
                __builtin_amdgcn_sched_barrier(0);
#pragma unroll
                for (int i = 0; i < 8; ++i) { const int t = tq + 16 * i;
                    if (i == 0) {
#pragma unroll
                        for (int j = 0; j < 3; ++j) if (T0 + t - 3 + j < 0) xv[0][j] = (bf16x8){0, 0, 0, 0, 0, 0, 0, 0}; }
                    float a[8];
#pragma unroll
                    for (int e = 0; e < 8; ++e) a[e] = bv[e];
#pragma unroll
                    for (int j = 0; j < 4; ++j)
#pragma unroll
                        for (int e = 0; e < 8; ++e) a[e] = __builtin_fmaf(wv[j][e], bf2f((unsigned short)xv[i][j][e]), a[e]);
                    v4u o; o.x = pk2(a[0], a[1]); o.y = pk2(a[2], a[3]); o.z = pk2(a[4], a[5]); o.w = pk2(a[6], a[7]);
                    *(v4u*)(XC + t * XS + c0) = o; } }
            __syncthreads();
            f32x4 acc[2][8][2];
#pragma unroll
            for (int g = 0; g < 2; ++g)
#pragma unroll
                for (int rt = 0; rt < 8; ++rt)
#pragma unroll
                    for (int nt = 0; nt < 2; ++nt) acc[g][rt][nt] = (f32x4){0.f, 0.f, 0.f, 0.f};
#pragma unroll 2
            for (int kk = 0; kk < 8; ++kk) {
                bf16x8 bfr[2][2];
#pragma unroll
                for (int nt = 0; nt < 2; ++nt) { const size_t wo = (size_t)n * 65536 + (size_t)(32 * wid + 16 * nt + fr) * 256 + 32 * kk + 8 * fq;
                    bfr[0][nt] = *(const bf16x8*)(WLA + wo); bfr[1][nt] = *(const bf16x8*)(WLX + wo); }
#pragma unroll
                for (int rt = 0; rt < 8; ++rt) { const bf16x8 a = *(const bf16x8*)(XC + (16 * rt + fr) * XS + 32 * kk + 8 * fq);
#pragma unroll
                    for (int g = 0; g < 2; ++g)
#pragma unroll
                        for (int nt = 0; nt < 2; ++nt) acc[g][rt][nt] = MFMA16(a, bfr[g][nt], acc[g][rt][nt]); }
            }
            __syncthreads();
            LAS bf16* xcb = (LAS bf16*)XC + (4 * fq) * XS + 32 * wid + fr; LAS bf16* ptb = xcb + 128 * XS; asm volatile("" : "+v"(xcb), "+v"(ptb));
#pragma unroll
            for (int nt = 0; nt < 2; ++nt) {
#pragma unroll
                for (int rt = 0; rt < 8; ++rt) {
                    float A[4], B[4];
#pragma unroll
                    for (int j = 0; j < 4; ++j) {
                        const float r = sigmoidf_(acc[0][rt][nt][j] + ba[nt]), ig = sigmoidf_(acc[1][rt][nt][j] + bx[nt]);
                        const float la = r * nl[nt], av = __expf(la), x2 = 2.0f * la;
                        const float es = -x2 * (1.0f + x2 * 0.5f * (1.0f + x2 * (1.0f / 3.0f) * (1.0f + x2 * 0.25f))), ed = 1.0f - av * av;
                        const float em = (x2 > -0.0625f) ? es : ed;
                        const float mult = __builtin_amdgcn_sqrtf(em);
                        const float xcv = bf2f(xcb[(16 * rt + j) * XS + 16 * nt]);
                        A[j] = av; B[j] = mult * ig * xcv; }
#pragma unroll
                    for (int j = 1; j < 4; ++j) { B[j] = B[j - 1] * A[j] + B[j]; A[j] = A[j - 1] * A[j]; }
                    float At = A[3], Bt = B[3];
                    { const float Au = __shfl_up(At, 16), Bu = __shfl_up(Bt, 16); if (fq >= 1) { Bt = At * Bu + Bt; At = At * Au; } }
                    { const float Au = __shfl_up(At, 32), Bu = __shfl_up(Bt, 32); if (fq >= 2) { Bt = At * Bu + Bt; At = At * Au; } }
                    float Ae = __shfl_up(At, 16), Be = __shfl_up(Bt, 16); if (fq == 0) { Ae = 1.f; Be = 0.f; }
                    const float At3 = __shfl(At, 48 + fr), Bt3 = __shfl(Bt, 48 + fr);
                    const float h0 = Ae * hc[nt] + Be, P0 = Ae * pc[nt];
#pragma unroll
                    for (int j = 0; j < 4; ++j) {
                        const float hj = A[j] * h0 + B[j], Pj = A[j] * P0;
                        xcb[(16 * rt + j) * XS + 16 * nt] = (bf16)(pk2(hj, 0.f) & 0xffffu); ptb[(16 * rt + j) * XS + 16 * nt] = (bf16)(pk2(Pj, 0.f) & 0xffffu); }
                    hc[nt] = At3 * hc[nt] + Bt3; pc[nt] = At3 * pc[nt];
                }
            }
            __syncthreads();
            int tidp = tid; asm volatile("" : "+v"(tidp));
            bf16x8 zq[8];
#pragma unroll
            for (int i = 0; i < 8; ++i) { const int task = tidp + NTHR * i; zq[i] = *(const bf16x8*)(Zt + (size_t)(T0 + (task >> 5)) * DM + n * 256 + (task & 31) * 8); }
#pragma unroll
            for (int i = 0; i < 8; ++i) { const int task = tidp + NTHR * i, t = task >> 5, c0 = (task & 31) * 8; const size_t go = (size_t)(T0 + t) * DM + n * 256 + c0;
                const bf16x8 z8 = zq[i], h8 = *(const bf16x8*)(XC + t * XS + c0), p8 = *(const bf16x8*)(PT + t * XS + c0);
                float hz[8], pz[8];
#pragma unroll
                for (int e = 0; e < 8; ++e) { const float z = bf2f((unsigned short)z8[e]), sz = z * sigmoidf_(z); hz[e] = bf2f((unsigned short)h8[e]) * sz; pz[e] = bf2f((unsigned short)p8[e]) * sz; }
                v4u w; w.x = pk2(hz[0], hz[1]); w.y = pk2(hz[2], hz[3]); w.z = pk2(hz[4], hz[5]); w.w = pk2(hz[6], hz[7]); *(v4u*)(HZ + go) = w;
                w.x = pk2(pz[0], pz[1]); w.y = pk2(pz[2], pz[3]); w.z = pk2(pz[4], pz[5]); w.w = pk2(pz[6], pz[7]); *(v4u*)(PZ + go) = w; }
            __syncthreads();
        }
        if (fq == 0) {
#pragma unroll
            for (int nt = 0; nt < 2; ++nt) { const size_t c = (size_t)sc * DM + n * 256 + 32 * wid + 16 * nt + fr; CA[c] = pc[nt]; CB[c] = hc[nt]; } }
    }
}
__device__ __forceinline__ void lru_fix_phase(const Params& p, int tid) {
    unsigned char* ws = p.ws;
    const bf16* HZ = (const bf16*)(ws + WS_P0 + 2 * WS_PSTRIDE); const bf16* PZ = (const bf16*)(ws + WS_P0 + 3 * WS_PSTRIDE); bf16* Y = (bf16*)(ws + WS_Y);
    const float* CA = (const float*)(ws + WS_CA); const float* CB = (const float*)(ws + WS_CB);
    const int c0 = tid * 8;
    for (int b = blockIdx.x; b < 256; b += gridDim.x) {
        const int sc = b >> 4;
        float hin[8];
#pragma unroll
        for (int e = 0; e < 8; ++e) hin[e] = 0.f;
#pragma unroll 4
        for (int s = 0; s < sc; ++s) { const f32x4 a0 = *(const f32x4*)(CA + (size_t)s * DM + c0), a1 = *(const f32x4*)(CA + (size_t)s * DM + c0 + 4);
            const f32x4 b0 = *(const f32x4*)(CB + (size_t)s * DM + c0), b1 = *(const f32x4*)(CB + (size_t)s * DM + c0 + 4);
#pragma unroll
            for (int e = 0; e < 4; ++e) { hin[e] = b0[e] + a0[e] * hin[e]; hin[4 + e] = b1[e] + a1[e] * hin[4 + e]; } }
#pragma unroll 8
        for (int r = 0; r < 64; ++r) { const size_t o = (size_t)(b * 64 + r) * DM + c0;
            const bf16x8 hz = *(const bf16x8*)(HZ + o), pz = *(const bf16x8*)(PZ + o);
            float y[8];
#pragma unroll
            for (int e = 0; e < 8; ++e) y[e] = bf2f((unsigned short)hz[e]) + bf2f((unsigned short)pz[e]) * hin[e];
            v4u w; w.x = pk2(y[0], y[1]); w.y = pk2(y[2], y[3]); w.z = pk2(y[4], y[5]); w.w = pk2(y[6], y[7]);
            *(v4u*)(Y + o) = w; }
    }
}

__device__ __forceinline__ void mlstm_scalars_phase(char* ldsg, const Params& p, int tid) {
    if (blockIdx.x >= 8) return;
    unsigned char* ws = p.ws; const int h = blockIdx.x, lane = tid & 63, wid = tid >> 6;
    const float* IG = (const float*)(ws + WS_IG) + (size_t)h * SEQ; const float* LF = (const float*)(ws + WS_LF) + (size_t)h * SEQ;
    float* G = (float*)ldsg; float* AM = G + 256; float* M0 = AM + 256; float* MN = M0 + 256;
    float lfv[32], igv[32];
#pragma unroll
    for (int k = 0; k < 32; ++k) { const int tok = (wid + NWAVES * k) * 64 + lane; lfv[k] = LF[tok]; igv[k] = IG[tok]; }
#pragma unroll
    for (int k = 0; k < 32; ++k) { const int c = wid + NWAVES * k; const float ig = igv[k];
        float bc = lfv[k];
#pragma unroll
        for (int o = 1; o < 64; o <<= 1) { const float u = __shfl_up(bc, o); if (lane >= o) bc += u; }
        lfv[k] = bc;
        const float g = __shfl(bc, 63); float pm = ig - bc;
#pragma unroll
        for (int o = 1; o < 64; o <<= 1) pm = fmaxf(pm, __shfl_xor(pm, o));
        if (lane == 0) { G[c] = g; AM[c] = g + pm; } }
    __syncthreads();
    if (tid < 64) { float* DEC = (float*)(ws + WS_DEC) + h * 256;
        float g[4], am[4];
#pragma unroll
        for (int j = 0; j < 4; ++j) { g[j] = G[4 * lane + j]; am[j] = AM[4 * lane + j]; }
        float A = g[0], B = am[0];
#pragma unroll
        for (int j = 1; j < 4; ++j) { B = fmaxf(B + g[j], am[j]); A += g[j]; }
#pragma unroll
        for (int o = 1; o < 64; o <<= 1) { const float Au = __shfl_up(A, o), Bu = __shfl_up(B, o); if (lane >= o) { B = fmaxf(Bu + A, B); A = Au + A; } }
        float Ae = __shfl_up(A, 1), Be = __shfl_up(B, 1); if (lane == 0) { Ae = 0.f; Be = -__builtin_inff(); }
        float m = fmaxf(Ae, Be);
#pragma unroll
        for (int j = 0; j < 4; ++j) { const int c = 4 * lane + j; M0[c] = m; const float mn = fmaxf(g[j] + m, am[j]); DEC[c] = __expf(g[j] + m - mn); MN[c] = mn; m = mn; } }
    __syncthreads();
    float* W1 = (float*)(ws + WS_W1) + (size_t)h * SEQ; float* W2 = (float*)(ws + WS_W2) + (size_t)h * SEQ; float* WK = (float*)(ws + WS_WK) + (size_t)h * SEQ;
    float* ER = (float*)(ws + WS_EROW) + (size_t)h * SEQ; float* BC = (float*)(ws + WS_BC) + (size_t)h * SEQ; float* IGB = (float*)(ws + WS_IGB) + (size_t)h * SEQ;
    float* DMX = (float*)(ws + WS_DMAX) + (size_t)h * SEQ;
#pragma unroll
    for (int k = 0; k < 32; ++k) { const int c = wid + NWAVES * k, tok = c * 64 + lane; const float ig = igv[k], bc = lfv[k];
        const float g = __shfl(bc, 63); const float xs = ig - bc; float pm = xs;
#pragma unroll
        for (int o = 1; o < 64; o <<= 1) { const float u = __shfl_up(pm, o); if (lane >= o) pm = fmaxf(pm, u); }
        const float dmax = bc + pm, m = M0[c], mrow = fmaxf(bc + m, dmax);
        BC[tok] = bc; IGB[tok] = xs; DMX[tok] = dmax;
        W1[tok] = __expf(dmax - mrow); W2[tok] = __expf(bc + m - mrow) * 0.0625f; ER[tok] = __expf(-mrow); WK[tok] = __expf(g + xs - MN[c]); }
}
__device__ __forceinline__ u16x4 tr_read(unsigned lds_addr) { u16x4 r; asm volatile("ds_read_b64_tr_b16 %0, %1\n\ts_waitcnt lgkmcnt(0)" : "=&v"(r) : "v"(lds_addr) : "memory"); return r; }
__device__ __forceinline__ void mlstm_pre_phase(char* ldsg, const Params& p, int tid) {
    unsigned char* ws = p.ws;
    const bf16* QK = (const bf16*)(ws + WS_P0); const bf16* Vt = (const bf16*)(ws + WS_P0 + WS_PSTRIDE);
    bf16* QP = (bf16*)(ws + WS_QP); bf16* KT = (bf16*)(ws + WS_KT); bf16* VT = (bf16*)(ws + WS_VT); bf16* NINT = (bf16*)(ws + WS_NINT);
    constexpr int TS = 264, SS = 72;
    bf16* QL = (bf16*)ldsg; bf16* KL = QL + 64 * TS; bf16* VL = KL + 64 * TS; bf16* SCL = VL + 64 * TS;
    float* W1s = (float*)(SCL + 64 * SS); float* BCs = W1s + 64; float* IGBs = BCs + 64; float* DMs = IGBs + 64; float* DENP = DMs + 64; float* WKs = DENP + 256;
    const int lane = tid & 63, wid = __builtin_amdgcn_readfirstlane(tid >> 6), fr = lane & 15, fq = lane >> 4;
    const unsigned vl_addr = (unsigned)(uintptr_t)VL;
    for (int u = blockIdx.x; u < 2048; u += gridDim.x) {
        const int h = u >> 8, c = u & 255, tok0 = c * 64; const size_t hs = (size_t)h * SEQ + tok0;
        if (tid < 64) { W1s[tid] = ((const float*)(ws + WS_W1))[hs + tid]; BCs[tid] = ((const float*)(ws + WS_BC))[hs + tid]; IGBs[tid] = ((const float*)(ws + WS_IGB))[hs + tid];
            DMs[tid] = ((const float*)(ws + WS_DMAX))[hs + tid]; WKs[tid] = ((const float*)(ws + WS_WK))[hs + tid]; }
#pragma unroll
        for (int i = 0; i < 4; ++i) { const int task = tid + NTHR * i, t = task >> 5, d0 = (task & 31) * 8;
            const bf16x8 q8 = *(const bf16x8*)(QK + (size_t)(tok0 + t) * DM + h * 256 + d0), k8 = *(const bf16x8*)(QK + (size_t)(tok0 + t) * DM + 2048 + h * 256 + d0);
            *(bf16x8*)(QL + t * TS + d0) = q8; *(bf16x8*)(KL + t * TS + d0) = k8;
            const float w2 = ((const float*)(ws + WS_W2))[hs + t];
            v2u lo, hi; lo.x = pk2(bf2f((unsigned short)q8[0]) * w2, bf2f((unsigned short)q8[1]) * w2); lo.y = pk2(bf2f((unsigned short)q8[2]) * w2, bf2f((unsigned short)q8[3]) * w2);
            hi.x = pk2(bf2f((unsigned short)q8[4]) * w2, bf2f((unsigned short)q8[5]) * w2); hi.y = pk2(bf2f((unsigned short)q8[6]) * w2, bf2f((unsigned short)q8[7]) * w2);
            const int r = d0 & 31, g0 = (r >> 2) & 3, dtq = r >> 4;
            bf16* qf = QP + ((((size_t)(h * 256 + c) * 8 + (d0 >> 5)) * 4 + (t >> 4)) * 512) + ((t & 15) + 16 * g0) * 8 + 4 * dtq;
            *(v2u*)qf = lo; *(v2u*)(qf + 128) = hi; }
        __syncthreads();
#pragma unroll
        for (int i = 0; i < 4; ++i) { const int task = tid + NTHR * i, d = task & 255, sg = task >> 8;
            float v[8];
#pragma unroll
            for (int e = 0; e < 8; ++e) v[e] = bf2f(KL[(8 * sg + e) * TS + d]) * WKs[8 * sg + e];
            v4u w; w.x = pk2(v[0], v[1]); w.y = pk2(v[2], v[3]); w.z = pk2(v[4], v[5]); w.w = pk2(v[6], v[7]);
            *(v4u*)(KT + ((((size_t)(h * 256 + c) * 8 + (d >> 5)) * 2 + ((d >> 4) & 1)) * 2 + (sg >> 2)) * 512 + ((d & 15) + 16 * (sg & 3)) * 8) = w; }
        { const int tr = wid >> 1;
#pragma unroll
          for (int tci = 0; tci < 2; ++tci) { const int tc = (wid & 1) * 2 + tci;
            if (tc <= tr) { f32x4 acc = (f32x4){0.f, 0.f, 0.f, 0.f};
#pragma unroll
                for (int kk = 0; kk < 8; ++kk) { const bf16x8 a = *(const bf16x8*)(QL + (16 * tr + fr) * TS + 32 * kk + 8 * fq), b = *(const bf16x8*)(KL + (16 * tc + fr) * TS + 32 * kk + 8 * fq);
                    acc = MFMA16(a, b, acc); }
                const int s = 16 * tc + fr; const float igb = IGBs[s];
#pragma unroll
                for (int j = 0; j < 4; ++j) { const int t = 16 * tr + 4 * fq + j;
                    float val = (s <= t) ? acc[j] * 0.0625f * __expf(BCs[t] + igb - DMs[t]) : 0.f;
                    SCL[t * SS + s] = (bf16)(pk2(val, 0.f) & 0xffffu);
                    val += __shfl_xor(val, 1); val += __shfl_xor(val, 2); val += __shfl_xor(val, 4); val += __shfl_xor(val, 8);
                    if (fr == 0) DENP[tc * 64 + t] = val; } }
            else {
#pragma unroll
                for (int j = 0; j < 4; ++j) { SCL[(16 * tr + 4 * fq + j) * SS + 16 * tc + fr] = (bf16)0; if (fr == 0) DENP[tc * 64 + 16 * tr + 4 * fq + j] = 0.f; } } } }
        __syncthreads();
        for (int vh = 0; vh < 2; ++vh) {
#pragma unroll
            for (int i = 0; i < 4; ++i) { const int task = tid + NTHR * i, s = task >> 5, c0 = (task & 31) * 8;
                *(bf16x8*)(VL + s * TS + c0) = *(const bf16x8*)(Vt + (size_t)(tok0 + s) * DM + h * 512 + 256 * vh + c0); }
            __syncthreads();
#pragma unroll
            for (int i = 0; i < 4; ++i) { const int task = tid + NTHR * i, v = task & 255, sg = task >> 8;
                v4u w; w.x = (unsigned)VL[(8 * sg + 0) * TS + v] | ((unsigned)VL[(8 * sg + 1) * TS + v] << 16); w.y = (unsigned)VL[(8 * sg + 2) * TS + v] | ((unsigned)VL[(8 * sg + 3) * TS + v] << 16);
                w.z = (unsigned)VL[(8 * sg + 4) * TS + v] | ((unsigned)VL[(8 * sg + 5) * TS + v] << 16); w.w = (unsigned)VL[(8 * sg + 6) * TS + v] | ((unsigned)VL[(8 * sg + 7) * TS + v] << 16);
                *(v4u*)(VT + (((size_t)(h * 256 + c) * 32 + ((256 * vh + v) >> 4)) * 2 + (sg >> 2)) * 512 + ((v & 15) + 16 * (sg & 3)) * 8) = w; }
            f32x4 acc[4][2];
#pragma unroll
            for (int tt = 0; tt < 4; ++tt)
#pragma unroll
                for (int nt = 0; nt < 2; ++nt) acc[tt][nt] = (f32x4){0.f, 0.f, 0.f, 0.f};
#pragma unroll
            for (int ks = 0; ks < 2; ++ks) {
                bf16x8 bfr[2];
#pragma unroll
                for (int nt = 0; nt < 2; ++nt) { const unsigned a0 = vl_addr + (unsigned)((32 * ks + 8 * fq + (fr >> 2)) * TS + 16 * (2 * wid + nt) + 4 * (fr & 3)) * 2u;
                    const u16x4 lo = tr_read(a0), hi = tr_read(a0 + 4u * TS * 2u);
                    bfr[nt] = (bf16x8){(short)lo[0], (short)lo[1], (short)lo[2], (short)lo[3], (short)hi[0], (short)hi[1], (short)hi[2], (short)hi[3]}; }
#pragma unroll
                for (int tt = 0; tt < 4; ++tt) { const bf16x8 a = *(const bf16x8*)(SCL + (16 * tt + fr) * SS + 32 * ks + 8 * fq);
#pragma unroll
                    for (int nt = 0; nt < 2; ++nt) acc[tt][nt] = MFMA16(a, bfr[nt], acc[tt][nt]); }
            }
#pragma unroll
            for (int tt = 0; tt < 4; ++tt)
#pragma unroll
                for (int j = 0; j < 4; ++j) { const int t = 16 * tt + 4 * fq + j; const float w1 = W1s[t];
#pragma unroll
                    for (int nt = 0; nt < 2; ++nt) NINT[(size_t)(tok0 + t) * DM + h * 512 + 256 * vh + 16 * (2 * wid + nt) + fr] = (bf16)(pk2(acc[tt][nt][j] * w1, 0.f) & 0xffffu); }
            __syncthreads();
        }
        if (tid < 64) ((float*)(ws + WS_DENI))[hs + tid] = W1s[tid] * (((DENP[tid] + DENP[64 + tid]) + DENP[128 + tid]) + DENP[192 + tid]);
        __syncthreads();
    }
}
template <int VAR>
__device__ __forceinline__ void mlstm_seq_phase(char* ldsg, const Params& p, int tid) {
    unsigned char* ws = p.ws;
    const bf16* QP = (const bf16*)(ws + WS_QP); const bf16* KT = (const bf16*)(ws + WS_KT); const bf16* VT = (const bf16*)(ws + WS_VT); const bf16* NINT = (const bf16*)(ws + WS_NINT);
    const bf16* Ot = (const bf16*)(ws + WS_P0 + 2 * WS_PSTRIDE); const bf16* Zt = (const bf16*)(ws + WS_P0 + 3 * WS_PSTRIDE); bf16* Y = (bf16*)(ws + (VAR ? WS_END : WS_Y));
    const float* DENI = (const float*)(ws + WS_DENI); const float* ER = (const float*)(ws + WS_EROW); const float* DEC = (const float*)(ws + WS_DEC);
    constexpr int PW = 20;
    float* PART = (float*)ldsg;
    unsigned* vtl = (unsigned*)(ldsg + 2 * 8 * 64 * PW * 4);
    const int lane = tid & 63, wid = __builtin_amdgcn_readfirstlane(tid >> 6), fr = lane & 15, fq = lane >> 4;
    const short one = (fr == 0) ? (short)0x3F80 : (short)0;
    const bf16x8 ones = (bf16x8){one, one, one, one, one, one, one, one};
    for (int u = blockIdx.x; u < 256; u += gridDim.x) {
        const int h = u & 7, vs = u >> 3;
        f32x4 st[2][2];
#pragma unroll
        for (int dt = 0; dt < 2; ++dt)
#pragma unroll
            for (int nt = 0; nt < 2; ++nt) st[dt][nt] = (f32x4){0.f, 0.f, 0.f, 0.f};
        const bf16* qp = QP + ((size_t)h * 256 * 8 + wid) * 2048 + lane * 8;
        const bf16* kt = KT + ((size_t)h * 256 * 8 + wid) * 2048 + lane * 8;
        const bf16* vt = VT + ((size_t)h * 256 * 32 + vs) * 1024 + lane * 8;
        const bf16* vtp = VT + ((size_t)h * 256 * 32 + vs) * 1024 + tid * 2;
        const int et = tid >> 3, ev = (tid & 7) * 2; const size_t ecol = (size_t)h * 512 + vs * 16 + ev;
        bf16x8 aQ0[4], aK0[2][2], bV0[2], aQ1[4], aK1[2][2], bV1[2];
        unsigned vp; unsigned ni0, oi0, zi0, ni1, oi1, zi1; float di0, ei0, di1, ei1, dec0, dec1;
#define SEQ_LOAD(c_, aQ, aK, ni, oi, zi, di, ei, dec) do { vp = *(const unsigned*)(vtp + (size_t)(c_) * 32768);     \
            dec = DEC[h * 256 + (c_)]; _Pragma("unroll") for (int tt = 0; tt < 4; ++tt) aQ[tt] = *(const bf16x8*)(qp + (size_t)(c_) * 16384 + tt * 512); \
            _Pragma("unroll") for (int dt = 0; dt < 2; ++dt) _Pragma("unroll") for (int ks = 0; ks < 2; ++ks) aK[dt][ks] = *(const bf16x8*)(kt + (size_t)(c_) * 16384 + (dt * 2 + ks) * 512); \
            { const size_t tok = (size_t)(c_) * 64 + et; \
                ni = *(const unsigned*)(NINT + tok * DM + ecol); oi = *(const unsigned*)(Ot + tok * DM + ecol); zi = *(const unsigned*)(Zt + tok * DM + ecol); di = DENI[(size_t)h * SEQ + tok]; ei = ER[(size_t)h * SEQ + tok]; } } while (0)
#define SEQ_STEP(c_, aQ, aK, bV, bVn, ni, oi, zi, di, ei, dec) do { \
            float* part = PART + ((c_) & 1) * (8 * 64 * PW) + wid * (64 * PW); \
            const float decay = dec; \
            bf16x8 bs[2]; \
            _Pragma("unroll") for (int nt = 0; nt < 2; ++nt) { v4u w; w.x = pk2(st[0][nt][0], st[0][nt][1]); w.y = pk2(st[0][nt][2], st[0][nt][3]); w.z = pk2(st[1][nt][0], st[1][nt][1]); w.w = pk2(st[1][nt][2], st[1][nt][3]); \
                bs[nt] = __builtin_bit_cast(bf16x8, w); } \
            _Pragma("unroll") for (int tt = 0; tt < 4; ++tt) { const f32x4 z4 = (f32x4){0.f, 0.f, 0.f, 0.f}; \
                  \
                const f32x4 p0 = MFMA16(bs[0], aQ[tt], z4), p1 = MFMA16(bs[1], aQ[tt], z4); \
                *(f32x4*)(part + (16 * tt + fr) * PW + 4 * fq) = p0; part[(16 * tt + fr) * PW + 16 + fq] = p1[0]; }     \
              \
            const float nn0 = __uint_as_float(ni << 16), nn1 = __uint_as_float(ni & 0xffff0000u); \
            float gg0, gg1; { const float o0 = __uint_as_float(oi << 16), o1 = __uint_as_float(oi & 0xffff0000u), z0 = __uint_as_float(zi << 16), z1 = __uint_as_float(zi & 0xffff0000u); \
                gg0 = sigmoidf_(o0) * z0 * sigmoidf_(z0); gg1 = sigmoidf_(o1) * z1 * sigmoidf_(z1); } \
            float dd, ee; asm volatile("v_mov_b32 %0, %2\n\tv_mov_b32 %1, %3" : "=&v"(dd), "=&v"(ee) : "v"(di), "v"(ei)); \
            vtl[(((c_) + 1) & 1) * 512 + tid] = vp;     \
            if (VAR != 2) __syncthreads(); \
              \
            const float* pall = PART + ((c_) & 1) * (8 * 64 * PW) + et * PW; \
            f32x2v pv[8]; float dn[8]; \
            if (VAR != 2) { _Pragma("unroll") for (int w = 0; w < 8; ++w) { pv[w] = *(const f32x2v*)(pall + w * (64 * PW) + ev); dn[w] = pall[w * (64 * PW) + 16]; } } \
            _Pragma("unroll") for (int ks = 0; ks < 2; ++ks) bVn[ks] = *(const bf16x8*)((const bf16*)vtl + (((c_) + 1) & 1) * 1024 + ks * 512 + lane * 8);     \
            _Pragma("unroll") for (int dt = 0; dt < 2; ++dt) _Pragma("unroll") for (int nt = 0; nt < 2; ++nt) { st[dt][nt] = st[dt][nt] * decay; \
                    _Pragma("unroll") for (int ks = 0; ks < 2; ++ks) st[dt][nt] = MFMA16(aK[dt][ks], nt == 0 ? bV[ks] : ones, st[dt][nt]); } \
            __builtin_amdgcn_sched_barrier(0); \
            if (VAR != 1) { const int cn_ = (c_) + 2 < 256 ? (c_) + 2 : 255; SEQ_LOAD(cn_, aQ, aK, ni, oi, zi, di, ei, dec); }     \
            __builtin_amdgcn_sched_barrier(0);     \
            if (VAR != 2) { float num0 = nn0, num1 = nn1, den = dd; \
                _Pragma("unroll") for (int w = 0; w < 8; ++w) { num0 += pv[w].x; num1 += pv[w].y; den += dn[w]; } \
                const float rd = __builtin_amdgcn_rcpf(fmaxf(fabsf(den), ee)); \
                const float y0 = num0 * rd * gg0, y1 = num1 * rd * gg1; \
                *(unsigned*)(Y + ((size_t)(c_) * 64 + et) * DM + ecol) = pk2(y0, y1); } } while (0)
        __builtin_amdgcn_sched_barrier(0);
        _Pragma("unroll") for (int ks = 0; ks < 2; ++ks) bV0[ks] = *(const bf16x8*)(vt + ks * 512);
        SEQ_LOAD(0, aQ0, aK0, ni0, oi0, zi0, di0, ei0, dec0);
        __builtin_amdgcn_sched_barrier(0);
        SEQ_LOAD(1, aQ1, aK1, ni1, oi1, zi1, di1, ei1, dec1);
        __builtin_amdgcn_sched_barrier(0);
        for (int c = 0; c < 256; c += 2) {
            SEQ_STEP(c, aQ0, aK0, bV0, bV1, ni0, oi0, zi0, di0, ei0, dec0);
            SEQ_STEP(c + 1, aQ1, aK1, bV1, bV0, ni1, oi1, zi1, di1, ei1, dec1);
        }
#undef SEQ_LOAD
#undef SEQ_STEP
        __syncthreads();
    }
}

__device__ __forceinline__ void final_norm_phase(const bf16* hsrc, const unsigned long long* ss, const float* g, float* out, int tid) {
    const int lane = tid & 63, wave = tid >> 6;
    const int gw = blockIdx.x * NWAVES + wave, NGW = gridDim.x * NWAVES;
    f32x4 gr[8][2];
#pragma unroll
    for (int j = 0; j < 8; ++j) { gr[j][0] = ((const f32x4*)g)[2 * lane + 128 * j]; gr[j][1] = ((const f32x4*)g)[2 * lane + 128 * j + 1]; }
    for (int m = gw; m < SEQ; m += NGW) { const float rs = rsqrtf((float)ss[m] * (1.0f / (1048576.0f * 4096.0f)) + 1e-6f);
        const v4u* xr = (const v4u*)(hsrc + (size_t)m * DM) + lane; f32x4* orow = (f32x4*)(out + (size_t)m * DM) + 2 * lane;
#pragma unroll
        for (int j = 0; j < 8; ++j) { const v4u c = xr[64 * j]; const f32x4 g0 = gr[j][0], g1 = gr[j][1];
            f32x4 a, b; a[0] = __uint_as_float(c.x << 16); a[1] = __uint_as_float(c.x & 0xffff0000u); a[2] = __uint_as_float(c.y << 16); a[3] = __uint_as_float(c.y & 0xffff0000u);
            b[0] = __uint_as_float(c.z << 16); b[1] = __uint_as_float(c.z & 0xffff0000u); b[2] = __uint_as_float(c.w << 16); b[3] = __uint_as_float(c.w & 0xffff0000u);
            orow[128 * j] = a * rs * g0; orow[128 * j + 1] = b * rs * g1; } }
}

constexpr int NPH = 17;
__global__ void __launch_bounds__(NTHR, 2) mk_fwd(Params p) {
    extern __shared__ __attribute__((aligned(16))) unsigned char lds[];
    const int tid = threadIdx.x;
    LAS unsigned char* ldsl = (LAS unsigned char*)lds;
    unsigned char* ws = p.ws;
    if (tid < 64) ((LAS unsigned*)(ldsl + LDS_CTL))[tid] = 0u;
    __syncthreads();
    XcdBarrier bar = xcd_barrier_post((unsigned*)(ws + WS_CTL), (volatile LAS unsigned*)(ldsl + LDS_CTL));
    const int lo = p.ph_lo, hi = p.ph_hi;
#ifdef DBG_ONLY
#define IN(k) ((k) == DBG_ONLY && lo <= (k) && (k) < hi)
#else
#define IN(k) (lo <= (k) && (k) < hi)
#endif
#define SEAM(k) do { if (IN(k) && IN((k) + 1)) xcd_barrier(bar); } while (0)
    unsigned long long* rowss = (unsigned long long*)(ws + WS_ROWSS);
    bf16* HB = (bf16*)(ws + WS_HB); bf16* P0t = (bf16*)(ws + WS_P0); bf16* Yt = (bf16*)(ws + WS_Y);
    const int G = gridDim.x;

    if (IN(0)) { p0_prologue(p, ldsl, tid); } SEAM(0);

    if (NLAYERS > 0) {
    if (IN(1)) { fox_gates(HB, (const bf16*)(ws + WS_WFF0), rowss, late_in(3), (float*)(ws + WS_FLOC), (float*)(ws + WS_FTOT), tid);
        pg8::Gemm g{HB, (const bf16*)(ws + WS_WFI0), SEQ, 16384, DM}; pg8::StaticOrder S; S.init(SEQ, 16384, G, (int)blockIdx.x);
        pg8::EpiIn<true> E{P0t, (size_t)SEQ * DM, rowss, (unsigned*)(ws + WS_NRM)};
        pg8::gemm_phase<pg8::EpiIn<true>, pg8::StaticOrder, true, true>(ldsl, g, S, E); } SEAM(1);
    if (IN(2)) { fox_attn_phase((char*)lds, P0t, P0t + (size_t)SEQ * DM, (const float*)(ws + WS_FLOC), (const float*)(ws + WS_FTOT), (const unsigned*)(ws + WS_NRM), (unsigned*)(ws + WS_QCNT), tid); } SEAM(2);
    if (IN(3)) { pg8::Gemm g{Yt, (const bf16*)(ws + WS_WFO0), SEQ, DM, DM}; pg8::StaticOrder S; S.init(SEQ, DM, G, (int)blockIdx.x);
        pg8::EpiOut E{HB, rowss + SEQ};
        pg8::gemm_phase<pg8::EpiOut, pg8::StaticOrder, true, true>(ldsl, g, S, E); } SEAM(3);
    }
    if (NLAYERS > 1) {
    if (IN(4)) { pg8::Gemm g{HB, (const bf16*)(ws + WS_WLI), SEQ, 8192, DM}; pg8::StaticOrder S; S.init(SEQ, 8192, G, (int)blockIdx.x);
        pg8::EpiIn<false> E{P0t, (size_t)SEQ * DM, rowss + SEQ, (unsigned*)nullptr};
        pg8::gemm_phase<pg8::EpiIn<false>, pg8::StaticOrder, true, true>(ldsl, g, S, E); } SEAM(4);
    if (IN(5)) { lru_scan_phase((char*)lds, p, tid); } SEAM(5);
    if (IN(6)) { lru_fix_phase(p, tid); } SEAM(6);
    if (IN(7)) { pg8::Gemm g{Yt, (const bf16*)(ws + WS_WLO), SEQ, DM, DM}; pg8::StaticOrder S; S.init(SEQ, DM, G, (int)blockIdx.x);
        pg8::EpiOut E{HB, rowss + 2 * SEQ};
        pg8::gemm_phase<pg8::EpiOut, pg8::StaticOrder, true, true>(ldsl, g, S, E); } SEAM(7);
    }
    if (NLAYERS > 2) {
    if (IN(8)) { mlstm_gates(HB, (const bf16*)(ws + WS_WMG), rowss + 2 * SEQ, late_in(15), late_in(16), (float*)(ws + WS_IG), (float*)(ws + WS_LF), tid);
        pg8::Gemm g{HB, (const bf16*)(ws + WS_WMI), SEQ, 16384, DM}; pg8::StaticOrder S; S.init(SEQ, 16384, G, (int)blockIdx.x);
        pg8::EpiIn<false> E{P0t, (size_t)SEQ * DM, rowss + 2 * SEQ, (unsigned*)nullptr};
        pg8::gemm_phase<pg8::EpiIn<false>, pg8::StaticOrder, true, true>(ldsl, g, S, E); } SEAM(8);
    if (IN(9)) { mlstm_scalars_phase((char*)lds, p, tid); } SEAM(9);
    if (IN(10)) { mlstm_pre_phase((char*)lds, p, tid); } SEAM(10);
    if (IN(11)) { mlstm_seq_phase<0>((char*)lds, p, tid); } SEAM(11);
    if (IN(12)) { pg8::Gemm g{Yt, (const bf16*)(ws + WS_WMO), SEQ, DM, DM}; pg8::StaticOrder S; S.init(SEQ, DM, G, (int)blockIdx.x);
        pg8::EpiOut E{HB, rowss + 3 * SEQ};
        pg8::gemm_phase<pg8::EpiOut, pg8::StaticOrder, true, true>(ldsl, g, S, E); } SEAM(12);
    }
    if (NLAYERS > 3) {
    if (IN(13)) { fox_gates(HB, (const bf16*)(ws + WS_WFF1), rowss + 3 * SEQ, late_in(3) + 32, (float*)(ws + WS_FLOC), (float*)(ws + WS_FTOT), tid);
        pg8::Gemm g{HB, (const bf16*)(ws + WS_WFI1), SEQ, 16384, DM}; pg8::StaticOrder S; S.init(SEQ, 16384, G, (int)blockIdx.x);
        pg8::EpiIn<true> E{P0t, (size_t)SEQ * DM, rowss + 3 * SEQ, (unsigned*)(ws + WS_NRM) + 256};
        pg8::gemm_phase<pg8::EpiIn<true>, pg8::StaticOrder, true, true>(ldsl, g, S, E); } SEAM(13);
    if (IN(14)) { fox_attn_phase((char*)lds, P0t, P0t + (size_t)SEQ * DM, (const float*)(ws + WS_FLOC), (const float*)(ws + WS_FTOT), (const unsigned*)(ws + WS_NRM) + 256, (unsigned*)(ws + WS_QCNT) + 512, tid); } SEAM(14);
    if (IN(15)) { pg8::Gemm g{Yt, (const bf16*)(ws + WS_WFO1), SEQ, DM, DM}; pg8::StaticOrder S; S.init(SEQ, DM, G, (int)blockIdx.x);
        pg8::EpiOut E{HB, rowss + 4 * SEQ};
        pg8::gemm_phase<pg8::EpiOut, pg8::StaticOrder, true, true>(ldsl, g, S, E); } SEAM(15);
    }
    if (IN(16)) { final_norm_phase(HB, rowss + NLAYERS * SEQ, late_in(18), late_out(), tid); }
#undef IN
#undef SEAM
}

#ifndef MK_N_LAUNCHES
#define MK_N_LAUNCHES 1
#endif
extern "C" void kernel_launch(void* const* d_in, const int* in_sizes, int n_in, void* d_out, int out_size, void* d_ws, size_t ws_size, hipStream_t stream) {
    static int grid = 0;
    if (grid == 0) {
        if (n_in != 19 || out_size != SEQ * DM || ws_size < WS_END) { fprintf(stderr, "kernel_launch: unexpected shapes (n_in %d out %d ws %zu, need ws >= %zu)\n", n_in, out_size, ws_size, (size_t)WS_END); grid = -1; return; }
        int dev = 0, cus = 0, per_cu = 0;
        if (hipGetDevice(&dev) != hipSuccess || hipDeviceGetAttribute(&cus, hipDeviceAttributeMultiprocessorCount, dev) != hipSuccess) { grid = -1; return; }
        if (hipFuncSetAttribute((const void*)mk_fwd, hipFuncAttributeMaxDynamicSharedMemorySize, LDS_BYTES) != hipSuccess) { fprintf(stderr, "kernel_launch: hipFuncSetAttribute failed\n"); grid = -1; return; }
        if (hipOccupancyMaxActiveBlocksPerMultiprocessor(&per_cu, (const void*)mk_fwd, NTHR, LDS_BYTES) != hipSuccess || per_cu < 1) { fprintf(stderr, "kernel_launch: occupancy query says %d\n", per_cu); }
        (void)hipGetLastError();
        grid = cus;
    }
    if (grid < 0) return;
    (void)hipMemsetAsync((char*)d_ws + WS_CTL, 0, CTL_ZERO_BYTES, stream);
    Params p{};
    for (int i = 0; i < 19; ++i) p.in[i] = (const float*)d_in[i];
    p.out = (float*)d_out; p.ws = (unsigned char*)d_ws;
#if MK_N_LAUNCHES == 1
    p.ph_lo = 0; p.ph_hi = NPH;
    hipLaunchKernelGGL(mk_fwd, dim3(grid), dim3(NTHR), LDS_BYTES, stream, p);
#else
    for (int k = 0; k < NPH; ++k) { p.ph_lo = k; p.ph_hi = k + 1; hipLaunchKernelGGL(mk_fwd, dim3(grid), dim3(NTHR), LDS_BYTES, stream, p); }
#endif
}
```

```cpp
#include <hip/hip_runtime.h>
#include <cstdio>
#include <cstdint>
namespace pg8 {
#define PG8_LAS __attribute__((address_space(3)))
typedef unsigned short bf16_t;
typedef short bf16x8 __attribute__((ext_vector_type(8)));
typedef float f32x4 __attribute__((ext_vector_type(4)));
typedef unsigned u32x4 __attribute__((ext_vector_type(4)));
constexpr int BM = 256, BK = 64, HALF = 128, HTB = HALF * BK * 2  , STAGE_BYTES = 8 * HTB, NXCD = 8, WGM = 8;

__host__ __device__ __forceinline__ int lds_byte(int r, int c) { const int st = (r >> 4) * 2 + (c >> 5), rr = r & 15, cc = c & 31, ob = rr * 64 + cc * 2; return st * 1024 + (ob ^ (((ob >> 9) & 1) << 5)); }
__host__ __device__ __forceinline__ void stage_rc(int b, int& R, int& C) { const int st = b / 1024, sb = b % 1024, swz = sb ^ (((sb >> 9) & 1) << 5); R = (st >> 1) * 16 + swz / 64; C = (st & 1) * 32 + (swz % 64) / 2; }
__host__ __device__ __forceinline__ int perm32(int rho) { const int n = rho >> 4, i = rho & 15; return 8 * (i >> 2) + 4 * n + (i & 3); }

struct Unit { int pm, pn; };
struct Gemm { const bf16_t* A; const bf16_t* Bt; int M, N, K; };

struct StaticOrder {
    int nM, nN, nwg, G, c;
    __host__ __device__ void init(int M, int N, int G_, int c_) { nM = M / BM; nN = N / BM; nwg = nM * nN; G = G_; c = c_; }
    __host__ __device__ bool next(int i, Unit& u) const {
        const long L = (long)i * G + c; if (L >= nwg) return false;
        int wgid = (int)L; { const int q = nwg / NXCD, r = nwg % NXCD, xcd = wgid % NXCD, off = wgid / NXCD; wgid = (xcd < r ? xcd * (q + 1) : r * (q + 1) + (xcd - r) * q) + off; }
        const int nig = WGM * nN, gid = wgid / nig, fm = gid * WGM, gsz = (nM - fm) < WGM ? (nM - fm) : WGM;
        u.pm = fm + ((wgid % nig) % gsz); u.pn = (wgid % nig) / gsz; return true;
    }
    __device__ __forceinline__ void a_ready(const Unit&) const {}
    __device__ __forceinline__ void done(const Unit&) const {}
};

__device__ __forceinline__ unsigned cvt_pk_bf16(float lo, float hi) { unsigned r; asm volatile("v_cvt_pk_bf16_f32 %0, %1, %2" : "=v"(r) : "v"(lo), "v"(hi)); return r; }

template <bool NORMS> struct EpiIn {
    static constexpr bool PERM = true, AFTER_DRAIN = false;
    bf16_t* O; size_t tstride; const unsigned long long* rowss;
    unsigned* nrm;
    __device__ __forceinline__ void operator()(const f32x4 (&acc)[2][2][4][2], const Unit& u, int wr, int wc, int fr, int fq) const {
        const int row0 = u.pm * BM + wr * 64 + fr; int colt = u.pn * BM;
        const int tens = colt >> 12;
        bf16_t* base = O + (size_t)tens * tstride; colt &= 4095;
        const int col0 = colt + wc * 32 + 8 * fq;
        unsigned long long sq[8];
#pragma unroll
        for (int g = 0; g < 8; ++g) sq[g] = rowss[row0 + (g >> 2) * HALF + (g & 3) * 16];
        float nmax[2] = {0.f, 0.f};
#pragma unroll
        for (int ai = 0; ai < 2; ++ai)
#pragma unroll
            for (int m = 0; m < 4; ++m) { const int row = row0 + ai * HALF + m * 16; const float rs = rsqrtf((float)sq[ai * 4 + m] * (1.0f / (1048576.0f * 4096.0f)) + 1e-6f);
                bf16_t* rowp = base + (size_t)row * 4096 + col0;
#pragma unroll
                for (int bj = 0; bj < 2; ++bj) { const f32x4 v0 = acc[ai][bj][m][0] * rs, v1 = acc[ai][bj][m][1] * rs;
                    u32x4 w; w.x = cvt_pk_bf16(v0[0], v0[1]); w.y = cvt_pk_bf16(v0[2], v0[3]); w.z = cvt_pk_bf16(v1[0], v1[1]); w.w = cvt_pk_bf16(v1[2], v1[3]);
                    *(u32x4*)(rowp + bj * HALF) = w;
                    if (NORMS && tens < 2) { float s = ((v0[0] * v0[0] + v0[1] * v0[1]) + (v0[2] * v0[2] + v0[3] * v0[3])) + ((v1[0] * v1[0] + v1[1] * v1[1]) + (v1[2] * v1[2] + v1[3] * v1[3]));
                        s += __shfl_xor(s, 16); s += __shfl_xor(s, 32); nmax[bj] = fmaxf(nmax[bj], s); } } }
        if (NORMS && tens < 2) {
#pragma unroll
            for (int bj = 0; bj < 2; ++bj) { float s = nmax[bj]; s = fmaxf(s, __shfl_xor(s, 1)); s = fmaxf(s, __shfl_xor(s, 2)); s = fmaxf(s, __shfl_xor(s, 4)); s = fmaxf(s, __shfl_xor(s, 8));
                if (fr == 0 && fq == 0) __hip_atomic_fetch_max(nrm + ((tens * 32 + (colt >> 7) + bj) * 4 + wc), __float_as_uint(s), __ATOMIC_RELAXED, __HIP_MEMORY_SCOPE_AGENT); } }
    }
};
struct EpiOut {
    static constexpr bool PERM = true, AFTER_DRAIN = false;
    bf16_t* hb; unsigned long long* ss_next;
    __device__ __forceinline__ void operator()(const f32x4 (&acc)[2][2][4][2], const Unit& u, int wr, int wc, int fr, int fq) const {
        const int row0 = u.pm * BM + wr * 64 + fr, col0 = u.pn * BM + wc * 32 + 8 * fq;
        float ssr[8]; u32x4 cur[2], nxt[2];
#pragma unroll
        for (int bj = 0; bj < 2; ++bj) cur[bj] = *(const u32x4*)(hb + (size_t)row0 * 4096 + col0 + bj * HALF);
#pragma unroll
        for (int g = 0; g < 8; ++g) { const int ai = g >> 2, m = g & 3; bf16_t* rowp = hb + (size_t)(row0 + ai * HALF + m * 16) * 4096 + col0;
            if (g < 7) { const bf16_t* rown = hb + (size_t)(row0 + ((g + 1) >> 2) * HALF + ((g + 1) & 3) * 16) * 4096 + col0;
#pragma unroll
                for (int bj = 0; bj < 2; ++bj) nxt[bj] = *(const u32x4*)(rown + bj * HALF); }
            float ss = 0.f;
#pragma unroll
            for (int bj = 0; bj < 2; ++bj) { const u32x4 c = cur[bj];
                f32x4 o0, o1;
                o0[0] = __uint_as_float(c.x << 16) + acc[ai][bj][m][0][0]; o0[1] = __uint_as_float(c.x & 0xffff0000u) + acc[ai][bj][m][0][1];
                o0[2] = __uint_as_float(c.y << 16) + acc[ai][bj][m][0][2]; o0[3] = __uint_as_float(c.y & 0xffff0000u) + acc[ai][bj][m][0][3];
                o1[0] = __uint_as_float(c.z << 16) + acc[ai][bj][m][1][0]; o1[1] = __uint_as_float(c.z & 0xffff0000u) + acc[ai][bj][m][1][1];
                o1[2] = __uint_as_float(c.w << 16) + acc[ai][bj][m][1][2]; o1[3] = __uint_as_float(c.w & 0xffff0000u) + acc[ai][bj][m][1][3];
                u32x4 w; w.x = cvt_pk_bf16(o0[0], o0[1]); w.y = cvt_pk_bf16(o0[2], o0[3]); w.z = cvt_pk_bf16(o1[0], o1[1]); w.w = cvt_pk_bf16(o1[2], o1[3]);
                *(u32x4*)(rowp + bj * HALF) = w;
                const float r0 = __uint_as_float(w.x << 16), r1 = __uint_as_float(w.x & 0xffff0000u), r2 = __uint_as_float(w.y << 16), r3 = __uint_as_float(w.y & 0xffff0000u);
                const float r4 = __uint_as_float(w.z << 16), r5 = __uint_as_float(w.z & 0xffff0000u), r6 = __uint_as_float(w.w << 16), r7 = __uint_as_float(w.w & 0xffff0000u);
                ss += ((r0 * r0 + r1 * r1) + (r2 * r2 + r3 * r3)) + ((r4 * r4 + r5 * r5) + (r6 * r6 + r7 * r7)); }
            ss += __shfl_xor(ss, 16); ss += __shfl_xor(ss, 32); ssr[g] = ss;
#pragma unroll
            for (int bj = 0; bj < 2; ++bj) cur[bj] = nxt[bj];
            asm volatile("" ::: "memory"); }
        if (fq == 0) {
#pragma unroll
            for (int g = 0; g < 8; ++g) __hip_atomic_fetch_add(ss_next + row0 + (g >> 2) * HALF + (g & 3) * 16, (unsigned long long)(ssr[g] * 1048576.0f + 0.5f), __ATOMIC_RELAXED, __HIP_MEMORY_SCOPE_AGENT); }
    }
};

template <class Epi, class Sched, bool ALIGN_EPI = false, bool SP2 = false>
__device__ __forceinline__ void gemm_phase(PG8_LAS unsigned char* lds, const Gemm g, const Sched& S, const Epi& E) {
    const int tid = threadIdx.x, wid = __builtin_amdgcn_readfirstlane(tid >> 6), lane = tid & 63, wr = wid >> 2, wc = wid & 3, fr = lane & 15, fq = lane >> 4;
    const int K = g.K, nt = K / BK;
    unsigned voffA[2], voffB[2];
#pragma unroll
    for (int i = 0; i < 2; ++i) { int R, C; stage_rc(tid * 16 + i * 8192, R, C); const int Rb = Epi::PERM ? ((R & ~31) + perm32(R & 31)) : R;
        voffA[i] = (unsigned)(R * K + C) * 2u; voffB[i] = (unsigned)(Rb * K + C) * 2u; }
    const size_t kstep = (size_t)(BK * 2);
    const size_t hstep = (size_t)HALF * K * 2;
    const size_t tstep = 2 * hstep;
    const unsigned ldsw = (unsigned)wid * 1024u;
    const int aoff = lds_byte(wr * 64 + fr, fq * 8), boff = lds_byte(wc * 32 + fr, fq * 8);
#define PG8_SA(b, h) (((b) * 2 + (h)) * HTB)
#define PG8_SB(b, h) ((4 + (b) * 2 + (h)) * HTB)
#define PG8_STAGE(bufoff, gbase, voff) do { _Pragma("unroll") for (int _i = 0; _i < 2; ++_i) \
        __builtin_amdgcn_global_load_lds((const unsigned*)((const char*)(gbase) + (voff)[_i]), (PG8_LAS unsigned*)(lds + (bufoff) + ldsw + _i * 8192), 16, 0, 0); } while (0)
#define PG8_LDA(dst, b, h) do { _Pragma("unroll") for (int m = 0; m < 4; ++m) _Pragma("unroll") for (int k = 0; k < 2; ++k) dst[m][k] = *(const PG8_LAS bf16x8*)(lds + PG8_SA(b, h) + aoff + m * 2048 + k * 1024); } while (0)
#define PG8_LDB(dst, b, h) do { _Pragma("unroll") for (int n = 0; n < 2; ++n) _Pragma("unroll") for (int k = 0; k < 2; ++k) dst[n][k] = *(const PG8_LAS bf16x8*)(lds + PG8_SB(b, h) + boff + n * 2048 + k * 1024); } while (0)
#define PG8_MMA(ai, bj, At, Bt) do { __builtin_amdgcn_s_setprio(1); _Pragma("unroll") for (int m = 0; m < 4; ++m) _Pragma("unroll") for (int n = 0; n < 2; ++n) _Pragma("unroll") for (int k = 0; k < 2; ++k) \
        acc[ai][bj][m][n] = __builtin_amdgcn_mfma_f32_16x16x32_bf16(Bt[n][k], At[m][k], acc[ai][bj][m][n], 0, 0, 0); __builtin_amdgcn_s_setprio(0); } while (0)
#define PG8_WAIT_V(n) asm volatile("s_waitcnt vmcnt(" #n ")" ::: "memory")
#define PG8_WAIT_L(n) asm volatile("s_waitcnt lgkmcnt(" #n ")" ::: "memory")
#define PG8_BAR __builtin_amdgcn_s_barrier()
#define PG8_SCHED __builtin_amdgcn_sched_barrier(0)
    Unit cur, nxt; int ui = 0;
    if (!S.next(0, cur)) return;
    f32x4 acc[2][2][4][2];
#pragma unroll
    for (int a = 0; a < 2; ++a)
#pragma unroll
        for (int b = 0; b < 2; ++b)
#pragma unroll
            for (int m = 0; m < 4; ++m)
#pragma unroll
                for (int n = 0; n < 2; ++n) acc[a][b][m][n] = (f32x4){0.f, 0.f, 0.f, 0.f};
    bf16x8 At[4][2], B0[2][2], B1[2][2];
    const char* cA = (const char*)g.A + (size_t)cur.pm * tstep; const char* cB = (const char*)g.Bt + (size_t)cur.pn * tstep;
    S.a_ready(cur);
    if constexpr (SP2) {
        PG8_STAGE(PG8_SB(0, 0), cB, voffB); PG8_STAGE(PG8_SB(0, 1), cB + hstep, voffB); PG8_STAGE(PG8_SA(0, 0), cA, voffA); PG8_STAGE(PG8_SA(0, 1), cA + hstep, voffA);
        if (wr == 1) PG8_BAR;
        PG8_WAIT_V(2); PG8_BAR;
        PG8_STAGE(PG8_SB(1, 0), cB + kstep, voffB); PG8_STAGE(PG8_SA(1, 0), cA + kstep, voffA); PG8_STAGE(PG8_SB(1, 1), cB + hstep + kstep, voffB);
        PG8_WAIT_V(6); PG8_BAR;
    } else {
        PG8_STAGE(PG8_SB(0, 0), cB, voffB); PG8_STAGE(PG8_SA(0, 0), cA, voffA); PG8_STAGE(PG8_SB(0, 1), cB + hstep, voffB); PG8_STAGE(PG8_SA(0, 1), cA + hstep, voffA);
        if (wr == 1) PG8_BAR;
        PG8_WAIT_V(4); PG8_BAR;
        PG8_STAGE(PG8_SB(1, 0), cB + kstep, voffB); PG8_STAGE(PG8_SA(1, 0), cA + kstep, voffA); PG8_STAGE(PG8_SB(1, 1), cB + hstep + kstep, voffB);
        PG8_WAIT_V(6); PG8_BAR;
    }
    for (;;) {
        const bool has_next = S.next(ui + 1, nxt);
        const char* nA = has_next ? (const char*)g.A + (size_t)nxt.pm * tstep : cA; const char* nB = has_next ? (const char*)g.Bt + (size_t)nxt.pn * tstep : cB;
        for (int t = 0; t < nt; t += 2) {
            const bool last = (t == nt - 2);
            const char* a1 = cA + (size_t)(t + 1) * kstep;
            const char* a2 = last ? nA : cA + (size_t)(t + 2) * kstep; const char* b2 = last ? nB : cB + (size_t)(t + 2) * kstep;
            const char* a3 = a2 + kstep; const char* b3 = b2 + kstep;
            if (last && has_next) S.a_ready(nxt);
            if constexpr (SP2) {
            PG8_LDB(B0, 0, 0); PG8_LDB(B1, 0, 1); PG8_SCHED; PG8_LDA(At, 0, 0); PG8_STAGE(PG8_SA(1, 1), a1 + hstep, voffA);
            PG8_WAIT_V(8); PG8_WAIT_L(0); PG8_BAR; PG8_MMA(0, 0, At, B0); PG8_MMA(0, 1, At, B1); PG8_BAR; PG8_SCHED;
            PG8_LDA(At, 0, 1); PG8_STAGE(PG8_SB(0, 0), b2, voffB); PG8_STAGE(PG8_SB(0, 1), b2 + hstep, voffB); PG8_STAGE(PG8_SA(0, 0), a2, voffA);
            PG8_WAIT_V(8); PG8_WAIT_L(0); PG8_BAR; PG8_MMA(1, 0, At, B0); PG8_MMA(1, 1, At, B1); PG8_BAR; PG8_SCHED;
            PG8_LDB(B0, 1, 0); PG8_LDB(B1, 1, 1); PG8_SCHED; PG8_LDA(At, 1, 0); PG8_STAGE(PG8_SA(0, 1), a2 + hstep, voffA);
            PG8_WAIT_V(8); PG8_WAIT_L(0); PG8_BAR; PG8_MMA(0, 0, At, B0); PG8_MMA(0, 1, At, B1); PG8_BAR; PG8_SCHED;
            PG8_LDA(At, 1, 1); PG8_STAGE(PG8_SB(1, 0), b3, voffB); PG8_STAGE(PG8_SB(1, 1), b3 + hstep, voffB); PG8_STAGE(PG8_SA(1, 0), a3, voffA);
            PG8_WAIT_V(8); PG8_WAIT_L(0); PG8_BAR; PG8_MMA(1, 0, At, B0); PG8_MMA(1, 1, At, B1); PG8_BAR; PG8_SCHED;
            } else {
            PG8_LDB(B0, 0, 0); PG8_SCHED; PG8_LDA(At, 0, 0); PG8_STAGE(PG8_SA(1, 1), a1 + hstep, voffA);
            PG8_WAIT_L(8); PG8_BAR; PG8_WAIT_L(0); PG8_MMA(0, 0, At, B0); PG8_BAR; PG8_SCHED;
            PG8_LDB(B1, 0, 1); PG8_STAGE(PG8_SB(0, 0), b2, voffB);
            PG8_BAR; PG8_WAIT_L(0); PG8_MMA(0, 1, At, B1); PG8_BAR;
            PG8_LDA(At, 0, 1); PG8_STAGE(PG8_SA(0, 0), a2, voffA);
            PG8_BAR; PG8_WAIT_L(0); PG8_MMA(1, 0, At, B0); PG8_BAR; PG8_SCHED;
            PG8_STAGE(PG8_SB(0, 1), b2 + hstep, voffB);
            PG8_WAIT_V(6); PG8_BAR; PG8_MMA(1, 1, At, B1); PG8_BAR;
            PG8_LDB(B0, 1, 0); PG8_SCHED; PG8_LDA(At, 1, 0); PG8_STAGE(PG8_SA(0, 1), a2 + hstep, voffA);
            PG8_WAIT_L(8); PG8_BAR; PG8_WAIT_L(0); PG8_MMA(0, 0, At, B0); PG8_BAR; PG8_SCHED;
            PG8_LDB(B1, 1, 1); PG8_STAGE(PG8_SB(1, 0), b3, voffB);
            PG8_BAR; PG8_WAIT_L(0); PG8_MMA(0, 1, At, B1); PG8_BAR;
            PG8_LDA(At, 1, 1); PG8_STAGE(PG8_SA(1, 0), a3, voffA);
            PG8_BAR; PG8_WAIT_L(0); PG8_MMA(1, 0, At, B0); PG8_BAR; PG8_SCHED;
            PG8_STAGE(PG8_SB(1, 1), b3 + hstep, voffB);
            PG8_WAIT_V(6); PG8_BAR; PG8_MMA(1, 1, At, B1); PG8_BAR;
            }
        }
        if constexpr (ALIGN_EPI) { if (wr == 0) PG8_BAR; }
        if constexpr (!Epi::AFTER_DRAIN) { E(acc, cur, wr, wc, fr, fq); S.done(cur); }
        if (!has_next) break;
#pragma unroll
        for (int a = 0; a < 2; ++a)
#pragma unroll
            for (int b = 0; b < 2; ++b)
#pragma unroll
                for (int m = 0; m < 4; ++m)
#pragma unroll
                    for (int n = 0; n < 2; ++n) acc[a][b][m][n] = (f32x4){0.f, 0.f, 0.f, 0.f};
        cur = nxt; cA = nA; cB = nB; ++ui;
        if constexpr (ALIGN_EPI) { if (wr == 1) PG8_BAR; }
    }
    PG8_WAIT_V(0);
    if constexpr (!ALIGN_EPI) { if (wr == 0) PG8_BAR; }
    PG8_BAR;
    if constexpr (Epi::AFTER_DRAIN) { E.fused(acc, cur, wr, wc, fr, fq, lds, wid, lane); S.done(cur); }
#undef PG8_SA
#undef PG8_SB
#undef PG8_STAGE
#undef PG8_LDA
#undef PG8_LDB
#undef PG8_MMA
#undef PG8_WAIT_V
#undef PG8_WAIT_L
#undef PG8_BAR
#undef PG8_SCHED
}
}
namespace fa {

constexpr int D = 128, LD = 4096;
constexpr float SCALE = 0.08838834764831845f;
constexpr float INV_SCALE = 11.313708498984761f;
constexpr float THR = 8.f;
constexpr bool WSKIP = false;
constexpr int NW = 8, QBLK = 32, KVBLK = 64, QB = NW * QBLK;
constexpr int SHM_V = KVBLK * D * 2, SHM_K = KVBLK * D * 2;
constexpr int LDS_BODY = 2 * SHM_V + 2 * SHM_K + NW * 64 * 4;
using bf16 = unsigned short;
typedef short bf16x8 __attribute__((ext_vector_type(8)));
typedef short s16x4 __attribute__((ext_vector_type(4)));
typedef float f32x16 __attribute__((ext_vector_type(16)));
typedef float f32x4 __attribute__((ext_vector_type(4)));
typedef unsigned u32x4 __attribute__((ext_vector_type(4)));
template <class A, class Bt> struct same_t { static constexpr bool v = false; };
template <class A> struct same_t<A, A> { static constexpr bool v = true; };

#define KSWZ(row, colB) ((row) * 256 + ((colB) ^ (((row) & 7) << 4)))
#define SBAR() __builtin_amdgcn_sched_barrier(0)
__device__ __forceinline__ int v_st(int k, int c) { const int kk = (k & ~0xC) | ((k & 4) << 1) | ((k & 8) >> 1); return ((kk >> 3) * 4 + (c >> 5)) * 512 + ((kk & 7) * 32 + (c & 31)) * 2; }
__device__ __forceinline__ int v_rd_base(int lane) { return ((lane & 3) << 3) | (((lane >> 2) & 3) << 6) | (((lane >> 4) & 1) << 5) | (((lane >> 5) & 1) << 8); }
constexpr int v_rd_off(int d0, int ks, int half) { return d0 * 512 + ks * 4096 + half * 2048; }
__device__ __forceinline__ int crow(int r, int hi) { return (r & 3) + 8 * (r >> 2) + 4 * hi; }
__device__ __forceinline__ unsigned cvtpk(float lo, float hi) {
    unsigned r; asm volatile("v_cvt_pk_bf16_f32 %0, %1, %2" : "=v"(r) : "v"(lo), "v"(hi)); return r;
}
__device__ __forceinline__ bf16x8 pack8(f32x4 a, f32x4 b) {
    u32x4 w = {cvtpk(a[0], a[1]), cvtpk(a[2], a[3]), cvtpk(b[0], b[1]), cvtpk(b[2], b[3])};
    return *reinterpret_cast<bf16x8*>(&w);
}
template <class T> __device__ __forceinline__ bf16x8 load8(const T* p) {
    if constexpr (same_t<T, float>::v) { return pack8(*(const f32x4*)p, *(const f32x4*)(p + 4)); }
    else { return *reinterpret_cast<const bf16x8*>(p); }
}
__device__ __forceinline__ void mask_tile(f32x16& p0, f32x16& p1, int dq, unsigned W) {
    const float NEG = -__builtin_inff();
#pragma unroll
    for (int r = 0; r < 16; ++r) {
        const int c = (r & 3) + 8 * (r >> 2);
        if ((unsigned)(dq - c) >= W) p0[r] = NEG;
        if ((unsigned)(dq - c - 32) >= W) p1[r] = NEG;
    }
}
__device__ __forceinline__ void partialSM(f32x16& p0, f32x16& p1, float& m_reg, float& mn, float& alpha) {
    float pmax = p0[0]; for (int r = 1; r < 16; ++r) pmax = fmaxf(pmax, p0[r]); for (int r = 0; r < 16; ++r) pmax = fmaxf(pmax, p1[r]);
    { auto rr = __builtin_amdgcn_permlane32_swap(__float_as_uint(pmax), __float_as_uint(pmax), false, false);
      pmax = fmaxf(__uint_as_float(rr[0]), __uint_as_float(rr[1])); }
    constexpr float C2 = 1.4426950408889634f * SCALE;
    if (__builtin_expect(__all((pmax - m_reg) * SCALE <= THR), 1)) { mn = m_reg; alpha = 1.f; }
    else { mn = fmaxf(m_reg, pmax); alpha = __builtin_amdgcn_exp2f((m_reg - mn) * C2); m_reg = mn; }
    const float mnL = -mn * C2;
    for (int r = 0; r < 16; ++r) p0[r] = fmaf(p0[r], C2, mnL); for (int r = 0; r < 16; ++r) p1[r] = fmaf(p1[r], C2, mnL);
    for (int r = 0; r < 16; ++r) p0[r] = __builtin_amdgcn_exp2f(p0[r]);
}
__device__ __forceinline__ void finishSM(f32x16& p0, f32x16& p1, float alpha, float& l_reg, bf16x8& pa0, bf16x8& pa1, bf16x8& pa2, bf16x8& pa3) {
    for (int r = 0; r < 16; ++r) p1[r] = __builtin_amdgcn_exp2f(p1[r]);
    float ps = 0; for (int r = 0; r < 16; ++r) ps += p0[r]; for (int r = 0; r < 16; ++r) ps += p1[r];
    { auto rr = __builtin_amdgcn_permlane32_swap(__float_as_uint(ps), __float_as_uint(ps), false, false);
      ps = __uint_as_float(rr[0]) + __uint_as_float(rr[1]); }
    l_reg = l_reg * alpha + ps;
#define PK4(P, B_, OUT) do { unsigned a0 = cvtpk(P[B_+0], P[B_+1]), a1 = cvtpk(P[B_+2], P[B_+3]);                          \
        unsigned b0 = cvtpk(P[B_+4], P[B_+5]), b1 = cvtpk(P[B_+6], P[B_+7]);                                             \
        auto r0 = __builtin_amdgcn_permlane32_swap(a0, b0, false, false); auto r1 = __builtin_amdgcn_permlane32_swap(a1, b1, false, false); \
        u32x4 w = {r0[0], r1[0], r0[1], r1[1]}; OUT = *reinterpret_cast<bf16x8*>(&w); } while (0)
    PK4(p0, 0, pa0); PK4(p0, 8, pa1); PK4(p1, 0, pa2); PK4(p1, 8, pa3);
#undef PK4
}
template <int KB, bool SK>
__device__ __forceinline__ void qkt(f32x16& p0, f32x16& p1, const char* K_lds, int r32, int hi, const bf16x8* qr, bool act, const __attribute__((address_space(3))) float* fk, float ft) {
    if (SK && !act) { const float NEG = -__builtin_inff();
#pragma unroll
        for (int r = 0; r < 16; ++r) { p0[r] = NEG; p1[r] = NEG; } return; }
#pragma unroll
    for (int g = 0; g < 4; ++g) { const f32x4 a = *(const __attribute__((address_space(3))) f32x4*)(fk + 8 * g), b = *(const __attribute__((address_space(3))) f32x4*)(fk + 32 + 8 * g);
#pragma unroll
        for (int i = 0; i < 4; ++i) { p0[4 * g + i] = ft - a[i]; p1[4 * g + i] = ft - b[i]; } }
    const char* kb[4];
#pragma unroll
    for (int dd = 0; dd < 4; ++dd) kb[dd] = K_lds + KB * SHM_K + KSWZ(r32, (dd * 16 + hi * 8) * 2);
#pragma unroll
    for (int d0 = 0; d0 < 8; ++d0) { const char* a = kb[d0 & 3] + (d0 >> 2) * 128;
        bf16x8 b0 = *reinterpret_cast<const bf16x8*>(a);
        bf16x8 b1 = *reinterpret_cast<const bf16x8*>(a + 32 * 256);
        p0 = __builtin_amdgcn_mfma_f32_32x32x16_bf16(b0, qr[d0], p0, 0, 0, 0);
        p1 = __builtin_amdgcn_mfma_f32_32x32x16_bf16(b1, qr[d0], p1, 0, 0, 0); }
}
template <int VB, bool SK>
__device__ __forceinline__ void pv_tile(f32x16* o, int vb0, bf16x8 pa0, bf16x8 pa1, bf16x8 pa2, bf16x8 pa3, bool act) {
    if (SK && !act) return;
#define TRRD(dst, off) asm volatile("ds_read_b64_tr_b16 %0, %1 offset:%2" : "=&v"(dst) : "v"(vb0), "i"(off) : "memory")
#define PV_D0(d0) do { s16x4 l0, l1, l2, l3, h0, h1, h2, h3; constexpr int b_ = VB * SHM_V + v_rd_off(d0, 0, 0);     \
        TRRD(l0, b_); TRRD(h0, b_ + 2048); TRRD(l1, b_ + 4096); TRRD(h1, b_ + 6144); TRRD(l2, b_ + 8192); TRRD(h2, b_ + 10240); TRRD(l3, b_ + 12288); TRRD(h3, b_ + 14336); \
        asm volatile("s_waitcnt lgkmcnt(0)" ::: "memory"); SBAR();                 \
        o[d0] = __builtin_amdgcn_mfma_f32_32x32x16_bf16(pa0, (bf16x8){l0[0], l0[1], l0[2], l0[3], h0[0], h0[1], h0[2], h0[3]}, o[d0], 0, 0, 0);   \
        o[d0] = __builtin_amdgcn_mfma_f32_32x32x16_bf16(pa1, (bf16x8){l1[0], l1[1], l1[2], l1[3], h1[0], h1[1], h1[2], h1[3]}, o[d0], 0, 0, 0);   \
        o[d0] = __builtin_amdgcn_mfma_f32_32x32x16_bf16(pa2, (bf16x8){l2[0], l2[1], l2[2], l2[3], h2[0], h2[1], h2[2], h2[3]}, o[d0], 0, 0, 0);   \
        o[d0] = __builtin_amdgcn_mfma_f32_32x32x16_bf16(pa3, (bf16x8){l3[0], l3[1], l3[2], l3[3], h3[0], h3[1], h3[2], h3[3]}, o[d0], 0, 0, 0); } while (0)
    PV_D0(0); PV_D0(1); PV_D0(2); PV_D0(3);
#undef PV_D0
#undef TRRD
}

constexpr size_t V_OFF = (size_t)16384 * 4096, Z_OFF = 3 * V_OFF, O_OFF = 4 * V_OFF;
template <class TIn, class TOut> struct BlockRef { const TIn* Q; const TIn* K; int P0; int JLO; };
template <class TIn> struct Seam {
    bf16x8 qr[8];
    bf16x8 st_v0, st_v1, st_k0, st_k1; f32x4 sf0, sf1, sf2, sf3;
    f32x4 tq[16];
};
__device__ __forceinline__ int swa_jlo(int P0, int W) { const int lowk = P0 - W + 1; return lowk > 0 ? lowk / KVBLK : 0; }
#define ROW(p, k0, rr) ((p) + (size_t)((k0) + (rr)) * LD + sc)
#define VMW() asm volatile("s_waitcnt vmcnt(0)" ::: "memory")
#define VMWN(n) asm volatile("s_waitcnt vmcnt(%0)" :: "i"(n) : "memory")
#define SLOAD_H(Kp, Vp, k0) do { S.st_v0 = load8<TIn>(ROW(Vp, k0, sr)); S.st_v1 = load8<TIn>(ROW(Vp, k0, 32 + sr));              \
                         S.st_k0 = load8<TIn>(ROW(Kp, k0, sr)); S.st_k1 = load8<TIn>(ROW(Kp, k0, 32 + sr)); } while (0)
#define SWRITE_HK(bf) do { *(bf16x8*)(K_lds + (bf) * SHM_K + kws) = S.st_k0; *(bf16x8*)(K_lds + (bf) * SHM_K + kws + 32 * 256) = S.st_k1; } while (0)
#define SWRITE_HV(bf) do { *(bf16x8*)(V_lds + (bf) * SHM_V + vst0) = S.st_v0; *(bf16x8*)(V_lds + (bf) * SHM_V + vst1) = S.st_v1; } while (0)
#define SWRITE_H(bf) do { SWRITE_HV(bf); SWRITE_HK(bf); } while (0)
#define SLOAD_F(p, k0) do { S.sf0 = *(const f32x4*)ROW(p, k0, sr); S.sf1 = *(const f32x4*)(ROW(p, k0, sr) + 4);                \
                            S.sf2 = *(const f32x4*)ROW(p, k0, 32 + sr); S.sf3 = *(const f32x4*)(ROW(p, k0, 32 + sr) + 4); } while (0)
#define SWRITE_KF(bf) do { *(bf16x8*)(K_lds + (bf) * SHM_K + kws) = pack8(S.sf0, S.sf1); *(bf16x8*)(K_lds + (bf) * SHM_K + kws + 32 * 256) = pack8(S.sf2, S.sf3); } while (0)
#define SWRITE_VF(bf) do { *(bf16x8*)(V_lds + (bf) * SHM_V + vst0) = pack8(S.sf0, S.sf1); *(bf16x8*)(V_lds + (bf) * SHM_V + vst1) = pack8(S.sf2, S.sf3); } while (0)
template <class TIn, class TOut>
__device__ __forceinline__ void causal_swa_prime(const BlockRef<TIn, TOut>& cur, int W, char* lds, Seam<TIn>& S) {
    constexpr bool F32 = same_t<TIn, float>::v;
    const int tid = threadIdx.x, wid = __builtin_amdgcn_readfirstlane(tid >> 6), lane = tid & 63, r32 = lane & 31, hi = lane >> 5;
    const int sr = tid >> 4, sc = (tid & 15) * 8, kws = KSWZ(sr, sc * 2); char* K_lds = lds + 2 * SHM_V;
    const int kb0 = ((cur.P0 + QB - 1) / KVBLK) * KVBLK;
    for (int d0 = 0; d0 < 8; ++d0) S.qr[d0] = load8<TIn>(cur.Q + (size_t)(wid * QBLK + r32) * LD + d0 * 16 + hi * 8);
    if constexpr (F32) { SLOAD_F((const float*)cur.K, kb0); VMW(); SWRITE_KF(0); SBAR(); SLOAD_F((const float*)(cur.K + V_OFF), kb0); }
    else { SLOAD_H(cur.K, (cur.K + V_OFF), kb0); VMW(); SWRITE_HK(0); }
    __syncthreads();
}
template <class TIn, class TOut>
__device__ __forceinline__ void causal_swa_reprime(const BlockRef<TIn, TOut>& cur, char* lds, Seam<TIn>& S) {
    const int tid = threadIdx.x;
    const int sr = tid >> 4, sc = (tid & 15) * 8, kws = KSWZ(sr, sc * 2); char* K_lds = lds + 2 * SHM_V;
    const int kb0 = ((cur.P0 + QB - 1) / KVBLK) * KVBLK;
    SLOAD_H(cur.K, (cur.K + V_OFF), kb0); VMW(); SWRITE_HK(0);
    __syncthreads();
}
template <class TIn, class TOut>
__device__ __forceinline__ void causal_swa_block(const BlockRef<TIn, TOut>& cur, const BlockRef<TIn, TOut>& nxt, int skv, int W, char* lds, Seam<TIn>& S, const __attribute__((address_space(3))) float* fabs_l) {
    constexpr bool F32 = same_t<TIn, float>::v;
    const int tid = threadIdx.x, wid = __builtin_amdgcn_readfirstlane(tid >> 6), lane = tid & 63, r32 = lane & 31, hi = lane >> 5;
    const int j_lo = cur.JLO;
    int j_hi = (cur.P0 + QB - 1) / KVBLK + 1; if (j_hi > skv / KVBLK) j_hi = skv / KVBLK;
    const int NT = j_hi - j_lo;
    const int kbn = ((nxt.P0 + QB - 1) / KVBLK) * KVBLK;
    const int qlo = cur.P0 + wid * QBLK, qm = qlo + r32 - 4 * hi;
    const float ft = __int_as_float(__builtin_amdgcn_readfirstlane(__float_as_int(fabs_l[qlo])));
#define FK(t) (fabs_l + KBASE(t) + 4 * hi)
    char* V_lds = lds; char* K_lds = lds + 2 * SHM_V;
    float* ws = (float*)(lds + 2 * SHM_V + 2 * SHM_K) + wid * 64; float* li_l = ws, * al_l = ws + 32;
    float m_reg = -1e30f, l_reg = 0; f32x16 o[4] = {};
    if (wid >= 4) __builtin_amdgcn_s_setprio(1);
    const int sr = tid >> 4, sc = (tid & 15) * 8, vst0 = v_st(sr, sc), vst1 = v_st(32 + sr, sc), kws = KSWZ(sr, sc * 2);
    const int vb0 = (int)(uintptr_t)V_lds + v_rd_base(lane);
    const TIn* Kh = cur.K; const TIn* Vh = (cur.K + V_OFF);
#define RESC(a) do { if (__any((a) < 1.f)) { if (hi == 0) al_l[r32] = (a); asm volatile("s_waitcnt lgkmcnt(0)" ::: "memory");              \
                     for (int d_ = 0; d_ < 4; ++d_) for (int r = 0; r < 16; ++r) o[d_][r] *= al_l[crow(r, hi)]; } } while (0)
#define KBASE(t) ((j_hi - 1 - (t)) * KVBLK)
#define ACT(t) (KBASE(t) <= qlo + QBLK - 1 && KBASE(t) + KVBLK - 1 >= qlo - W + 1)
#define MASKT(P0_, P1_, t) do { const int kb_ = KBASE(t); if ((!SK || ACT(t)) && (kb_ + KVBLK - 1 > qlo || kb_ <= qlo + QBLK - 1 - W)) mask_tile(P0_, P1_, qm - kb_, (unsigned)W); } while (0)
    constexpr int NQL = F32 ? 16 : 8;
    constexpr bool SK = WSKIP && !F32;
#define SEAM_K0() do { VMWN(NQL); if constexpr (F32) { SWRITE_KF(0); SBAR(); SLOAD_F((const float*)(nxt.K + V_OFF), kbn); } else { SWRITE_HK(0); } SBAR(); } while (0)
    f32x16 pA0, pA1, pB0, pB1; float mnA, mnB, alA, alB; bf16x8 pa0, pa1, pa2, pa3;
    if constexpr (F32) { VMW(); SWRITE_VF(0); SBAR(); } else { SWRITE_HV(0); SBAR(); }
    if (NT > 1) { if constexpr (F32) SLOAD_F((const float*)Kh, KBASE(1)); else SLOAD_H(Kh, Vh, KBASE(1)); }
    SBAR(); qkt<0, SK>(pA0, pA1, K_lds, r32, hi, S.qr, ACT(0), FK(0), ft);
    if constexpr (F32) { if (NT > 1) { VMW(); SWRITE_KF(1); SBAR(); SLOAD_F((const float*)Vh, KBASE(1)); } }
    MASKT(pA0, pA1, 0); partialSM(pA0, pA1, m_reg, mnA, alA);
    if (NT > 1) { VMW(); if constexpr (F32) { SWRITE_VF(1); SBAR(); if (NT > 2) SLOAD_F((const float*)Kh, KBASE(2)); } else SWRITE_H(1); }
    __syncthreads();
#define HALF_STEP(PX0, PX1, mnX, alX, PY0, PY1, alY, t, KB, VB, SB) do {                                                      \
        SBAR(); qkt<KB, SK>(PX0, PX1, K_lds, r32, hi, S.qr, ACT(t), FK(t), ft);                                             \
        finishSM(PY0, PY1, alY, l_reg, pa0, pa1, pa2, pa3); SBAR();                                                           \
        if ((t) + 1 < NT) { if constexpr (F32) { VMW(); SWRITE_KF(SB); SBAR(); SLOAD_F((const float*)Vh, KBASE((t) + 1)); }  \
                            else { SLOAD_H(Kh, Vh, KBASE((t) + 1)); } SBAR(); }                                               \
        pv_tile<VB, SK>(o, vb0, pa0, pa1, pa2, pa3, ACT((t) - 1)); MASKT(PX0, PX1, (t)); partialSM(PX0, PX1, m_reg, mnX, alX);                                        \
        __syncthreads();                                                                                                      \
        if ((t) + 1 < NT) { VMW(); if constexpr (F32) { SWRITE_VF(SB); SBAR(); if ((t) + 2 < NT) SLOAD_F((const float*)Kh, KBASE((t) + 2)); } \
                            else { SWRITE_H(SB); } }                                                                          \
        RESC(alX); __syncthreads(); } while (0)
    for (int t = 1; t + 1 < NT; t += 2) {
        HALF_STEP(pB0, pB1, mnB, alB, pA0, pA1, alA, t, 1, 0, 0);
        HALF_STEP(pA0, pA1, mnA, alA, pB0, pB1, alB, t + 1, 0, 1, 1);
    }
    const bool even = (NT & 1) == 0;
    if (even) { SBAR(); qkt<1, SK>(pB0, pB1, K_lds, r32, hi, S.qr, ACT(NT - 1), FK(NT - 1), ft); SBAR(); }
#define QROW(e) (nxt.Q + (size_t)(wid * QBLK + r32) * D + ((e) >> 1) * 16 + hi * 8 + ((e) & 1) * 4)
    if constexpr (F32) { SLOAD_F((const float*)nxt.K, kbn); SBAR();
#pragma unroll
        for (int e = 0; e < 8; ++e) S.tq[e] = *(const f32x4*)QROW(e); }
    else { SLOAD_H(nxt.K, (nxt.K + V_OFF), kbn); SBAR();
#pragma unroll
        for (int d0 = 0; d0 < 8; ++d0) S.qr[d0] = load8<TIn>(nxt.Q + (size_t)(wid * QBLK + r32) * LD + d0 * 16 + hi * 8); }
    SBAR();
    finishSM(pA0, pA1, alA, l_reg, pa0, pa1, pa2, pa3); SBAR();
    if constexpr (F32) {
#pragma unroll
        for (int e = 8; e < 16; ++e) S.tq[e] = *(const f32x4*)QROW(e); SBAR(); }
#undef QROW
    pv_tile<0, SK>(o, vb0, pa0, pa1, pa2, pa3, ACT(even ? NT - 2 : NT - 1));
    if (even) { MASKT(pB0, pB1, NT - 1); partialSM(pB0, pB1, m_reg, mnB, alB); __syncthreads(); RESC(alB);
        finishSM(pB0, pB1, alB, l_reg, pa0, pa1, pa2, pa3); SBAR(); pv_tile<1, SK>(o, vb0, pa0, pa1, pa2, pa3, ACT(NT - 1)); }
    SBAR(); SEAM_K0();
    if (hi == 0) li_l[r32] = l_reg; asm volatile("s_waitcnt lgkmcnt(0)" ::: "memory");
    float rli[16];
#pragma unroll
    for (int r = 0; r < 16; ++r) rli[r] = __builtin_amdgcn_rcpf(li_l[crow(r, hi)]);
    unsigned loff = (unsigned)((4 * hi) * LD + r32) * 2u; asm volatile("" : "+v"(loff));
    char* Ow = (char*)((TOut*)cur.Q + O_OFF + (size_t)(wid * QBLK) * LD); const char* Zw = (const char*)(cur.Q + Z_OFF + (size_t)(wid * QBLK) * LD);
    unsigned yw[16][4];
#pragma unroll
    for (int r = 0; r < 16; ++r) { const size_t roff = (size_t)((r & 3) + 8 * (r >> 2)) * LD * 2;
#pragma unroll
        for (int d0 = 0; d0 < 4; ++d0) yw[r][d0] = *(const unsigned short*)(Zw + roff + d0 * 64 + loff); }
#pragma unroll
    for (int r = 0; r < 16; ++r) {
#pragma unroll
        for (int d0 = 0; d0 < 4; ++d0) { const float z = __uint_as_float(yw[r][d0] << 16);
            const float y = o[d0][r] * rli[r] * z * __builtin_amdgcn_rcpf(1.f + __expf(-z));
            const float yn = __shfl_xor(y, 1);
            yw[r][d0] = cvtpk(y, yn); } }
    if ((r32 & 1) == 0) {
#pragma unroll
        for (int r = 0; r < 16; ++r) { const size_t roff = (size_t)((r & 3) + 8 * (r >> 2)) * LD * 2;
#pragma unroll
            for (int d0 = 0; d0 < 4; ++d0) *(unsigned*)(Ow + roff + d0 * 64 + loff) = yw[r][d0]; } }
    if constexpr (F32) {
#pragma unroll
        for (int d0 = 0; d0 < 8; ++d0) S.qr[d0] = pack8(S.tq[2 * d0], S.tq[2 * d0 + 1]); }
    if (wid >= 4) __builtin_amdgcn_s_setprio(0);
    __syncthreads();
#undef RESC
#undef FK
#undef KBASE
#undef ACT
#undef MASKT
#undef SEAM_K0
#undef HALF_STEP
}
#undef ROW
#undef VMW
#undef VMWN
#undef SLOAD_H
#undef SWRITE_HK
#undef SWRITE_HV
#undef SWRITE_H
#undef SLOAD_F
#undef SWRITE_KF
#undef SWRITE_VF


}

#define GAS __attribute__((address_space(1)))
#define LAS __attribute__((address_space(3)))
typedef unsigned short bf16;
typedef unsigned v4u __attribute__((ext_vector_type(4)));
typedef unsigned v2u __attribute__((ext_vector_type(2)));
typedef float f32x4 __attribute__((ext_vector_type(4)));
typedef short bf16x8 __attribute__((ext_vector_type(8)));
typedef unsigned short u16x4 __attribute__((ext_vector_type(4)));
typedef float f32x2v __attribute__((ext_vector_type(2)));

constexpr int SEQ = 16384, DM = 4096;
constexpr int NLAYERS = 4;
constexpr int NWAVES = 8, NTHR = 512;
constexpr int LDS_BYTES = 147456;
constexpr int LDS_CTL = LDS_BYTES - 256;

constexpr size_t MiB = 1u << 20;
constexpr size_t WS_CTL = 0, CTL_ZERO_BYTES = 2 * MiB;
constexpr size_t WS_NRM = 1 * MiB;
constexpr size_t WS_QCNT = 1 * MiB + 65536;
constexpr size_t WS_ROWSS = 65536;
constexpr size_t WS_WFI0 = 2 * MiB, WS_WFI1 = 130 * MiB, WS_WFO0 = 258 * MiB, WS_WFO1 = 290 * MiB;
constexpr size_t WS_WLI = 322 * MiB, WS_WLO = 386 * MiB, WS_WMI = 418 * MiB, WS_WMO = 546 * MiB;
constexpr size_t WS_WFF0 = 578 * MiB, WS_WFF1 = WS_WFF0 + 256 * 1024, WS_WMG = WS_WFF0 + 512 * 1024, WS_WLA = 579 * MiB, WS_WLX = 581 * MiB;
constexpr size_t WS_HB = 584 * MiB;
constexpr size_t WS_P0 = 712 * MiB, WS_PSTRIDE = 128 * MiB;
constexpr size_t WS_Y = 1224 * MiB;
constexpr size_t WS_QP = 1352 * MiB, WS_KT = 1416 * MiB, WS_VT = 1480 * MiB, WS_NINT = 1608 * MiB;
constexpr size_t WS_FLOC = 1736 * MiB, WS_FTOT = 1738 * MiB, WS_CA = 1739 * MiB, WS_CB = WS_CA + 256 * 1024;
constexpr size_t WS_IG = 1740 * MiB, WS_LF = WS_IG + 512 * 1024, WS_W1 = 1741 * MiB, WS_W2 = WS_W1 + 512 * 1024, WS_WK = 1742 * MiB, WS_EROW = WS_WK + 512 * 1024;
constexpr size_t WS_BC = 1743 * MiB, WS_IGB = WS_BC + 512 * 1024, WS_DMAX = 1744 * MiB, WS_DENI = WS_DMAX + 512 * 1024, WS_DEC = 1745 * MiB;
constexpr size_t WS_END = 1746 * MiB;

__device__ __forceinline__ float bf2f(unsigned short b) { return __uint_as_float((unsigned)b << 16); }
__device__ __forceinline__ unsigned pk2(float lo, float hi) { return pg8::cvt_pk_bf16(lo, hi); }
__device__ __forceinline__ float sigmoidf_(float x) { return __builtin_amdgcn_rcpf(1.f + __expf(-x)); }
__device__ __forceinline__ float logsigmoidf_(float x) { return fminf(x, 0.f) - log1pf(__expf(-fabsf(x))); }
#define LDS_WAIT() asm volatile("s_waitcnt lgkmcnt(0)" ::: "memory")
#define VM_WAIT() asm volatile("s_waitcnt vmcnt(0)" ::: "memory")
#define MFMA16(a, b, c) __builtin_amdgcn_mfma_f32_16x16x32_bf16(a, b, c, 0, 0, 0)

#define XB_TMO      128
#define XB_XCNT(j)  (256  + 64 * (j))
#define XB_XSUB(j)  (1280 + 64 * (j))
#define XB_XGEN(j)  (2304 + 64 * (j))
#define XB_TOP      3328
#define XB_TOPGEN   3392
#define XCD_BAR_WORDS 3456
#define XB_SPIN_CAP (1u << 18)

__device__ __forceinline__ unsigned xb_ld(unsigned* p)              { return __hip_atomic_load(p, __ATOMIC_RELAXED, __HIP_MEMORY_SCOPE_AGENT); }
__device__ __forceinline__ unsigned xb_add(unsigned* p, unsigned v) { return __hip_atomic_fetch_add(p, v, __ATOMIC_RELAXED, __HIP_MEMORY_SCOPE_AGENT); }
__device__ __forceinline__ unsigned xb_xcc_id() { return (unsigned)__builtin_amdgcn_s_getreg((3 << 11) | 20) & 0xFu; }
#define XB_SPIN(cond, bar) do { unsigned _sp = 0; while (cond) { __builtin_amdgcn_s_sleep(1); \
    if ((++_sp & 255u) == 0u) { if (xb_ld(&(bar)[XB_TMO])) break; if (_sp > XB_SPIN_CAP) { atomicAdd(&(bar)[XB_TMO], 1u); break; } } } } while (0)

struct XcdBarrier {
    unsigned* bar; unsigned x;
    volatile LAS unsigned* st;
};
__device__ __forceinline__ XcdBarrier xcd_barrier_post(unsigned* bar, volatile LAS unsigned* st) {
    XcdBarrier b; b.bar = bar; b.x = xb_xcc_id(); b.st = st;
    if (threadIdx.x == 0) (void)xb_add(&bar[XB_XCNT(b.x)], 1u);
    return b;
}
__device__ __forceinline__ void xcd_barrier_complete(unsigned* bar, unsigned x, unsigned& nloc, unsigned& nx) {
    const unsigned G = gridDim.x * gridDim.y * gridDim.z;
    unsigned sum, cnt, mine, sp = 0u;
    for (;;) {
        sum = 0u; cnt = 0u; mine = 0u;
#pragma unroll
        for (unsigned j = 0; j < 16; ++j) { const unsigned c = xb_ld(&bar[XB_XCNT(j)]); sum += c; cnt += (c > 0u) ? 1u : 0u; mine = (j == x) ? c : mine; }
        if (sum == G) break;
        __builtin_amdgcn_s_sleep(1);
        if ((++sp & 255u) == 0u) { if (xb_ld(&bar[XB_TMO])) break; if (sp > XB_SPIN_CAP) { atomicAdd(&bar[XB_TMO], 1u); break; } }
    }
    nloc = mine > 0u ? mine : 1u; nx = cnt > 0u ? cnt : 1u;
}
__device__ __forceinline__ void xcd_barrier(const XcdBarrier& b) {
    asm volatile("s_waitcnt vmcnt(0)" ::: "memory");
    __syncthreads();
    if (threadIdx.x == 0) {
        unsigned* bar = b.bar;
        __builtin_amdgcn_s_waitcnt(0);
        unsigned nloc = b.st[0], nx = b.st[1];
        if (nloc == 0u) { xcd_barrier_complete(bar, b.x, nloc, nx); b.st[0] = nloc; b.st[1] = nx; }
        const unsigned old = xb_add(&bar[XB_XSUB(b.x)], 1u);
        const unsigned gen = old / nloc;
        if (old + 1u == (gen + 1u) * nloc) {
            __builtin_amdgcn_fence(__ATOMIC_RELEASE, "agent");
            asm volatile("s_waitcnt vmcnt(0)" ::: "memory");
            const unsigned og = xb_add(&bar[XB_TOP], 1u);
            const unsigned tg = og / nx;
            if (og + 1u == (tg + 1u) * nx) xb_add(&bar[XB_TOPGEN], 1u);
            else XB_SPIN(xb_ld(&bar[XB_TOPGEN]) == tg, bar);
            __builtin_amdgcn_fence(__ATOMIC_ACQUIRE, "agent");
            xb_add(&bar[XB_XGEN(b.x)], 1u);
            asm volatile("s_waitcnt vmcnt(0)" ::: "memory");
        } else {
            XB_SPIN(xb_ld(&bar[XB_XGEN(b.x)]) == gen, bar);
            __builtin_amdgcn_fence(__ATOMIC_ACQUIRE, "agent");
            asm volatile("s_waitcnt vmcnt(0)" ::: "memory");
        }
    }
    __syncthreads();
}

struct Params { const float* in[19]; float* out; unsigned char* ws; int ph_lo, ph_hi; };
#define CAS __attribute__((address_space(4)))
__device__ __forceinline__ const float* late_in(int k) { const CAS char* ka = (const CAS char*)__builtin_amdgcn_kernarg_segment_ptr(); asm volatile("" : "+s"(ka));
    return *(const float* const CAS*)(ka + 8 * k); }
__device__ __forceinline__ float* late_out() { const CAS char* ka = (const CAS char*)__builtin_amdgcn_kernarg_segment_ptr(); asm volatile("" : "+s"(ka));
    return *(float* const CAS*)(ka + 8 * 19); }

struct TrSeg { const float* W; int ldn, col0, ncb; bf16* WT; int K; const LAS float* gain; };
__device__ __forceinline__ void tr_load(const TrSeg& s, int item, int lane, float (&v)[32]) {
    const int kb = item / s.ncb, nb = item - kb * s.ncb, k0 = 64 * kb, n0 = 32 * nb;
    const float* src = s.W + (size_t)(k0 + (lane >> 5)) * s.ldn + s.col0 + n0 + (lane & 31);
#pragma unroll
    for (int i = 0; i < 32; ++i) v[i] = src[(size_t)(2 * i) * s.ldn];
}
__device__ __forceinline__ void tr_store(const TrSeg& s, int item, int lane, const float (&v)[32], LAS float* scr) {
    const int kb = item / s.ncb, nb = item - kb * s.ncb, k0 = 64 * kb, n0 = 32 * nb;
#pragma unroll
    for (int i = 0; i < 32; ++i) { const int kk = 2 * i + (lane >> 5); const float g = s.gain ? s.gain[k0 + kk] : 1.f; scr[kk * 33 + (lane & 31)] = v[i] * g; }
    LDS_WAIT(); asm volatile("" ::: "memory");
    const int c = lane & 7;
#pragma unroll
    for (int j = 0; j < 4; ++j) { const int n = (lane >> 3) + 8 * j; const LAS float* p = scr + (8 * c) * 33 + n;
        v4u o; o.x = pk2(p[0 * 33], p[1 * 33]); o.y = pk2(p[2 * 33], p[3 * 33]); o.z = pk2(p[4 * 33], p[5 * 33]); o.w = pk2(p[6 * 33], p[7 * 33]);
        *(v4u*)(s.WT + (size_t)(n0 + n) * s.K + k0 + 8 * c) = o; }
    LDS_WAIT(); asm volatile("" ::: "memory");
}
__device__ __forceinline__ float wave_sum(float v) {
#pragma unroll
    for (int o = 1; o < 64; o <<= 1) v += __shfl_xor(v, o);
    return v;
}
__device__ __forceinline__ void p0_prologue(const Params& p, LAS unsigned char* lds, int tid) {
    const int lane = tid & 63, wave = __builtin_amdgcn_readfirstlane(tid >> 6);
    LAS float* scr = (LAS float*)(lds + wave * 8448);
    LAS float* GL = (LAS float*)(lds + 69632);
    for (int i = tid; i < 4 * 4096; i += NTHR) GL[i] = p.in[1][i];
    __syncthreads();
    const int gw = blockIdx.x * NWAVES + wave, NGW = gridDim.x * NWAVES;
    unsigned char* ws = p.ws;
    const LAS float* ng = GL;
    int rot_ = 0;
#define SEG(Wp, ldn_, col0_, ncols, dst, K_, gain_) do { TrSeg sg_; sg_.W = (Wp); sg_.ldn = (ldn_); sg_.col0 = (col0_); sg_.ncb = (ncols) / 32; sg_.WT = (dst); sg_.K = (K_); sg_.gain = (gain_); \
        const int nit_ = ((K_) / 64) * sg_.ncb; float va_[32], vb_[32]; int it = gw - rot_; if (it < 0) it += NGW; rot_ = (rot_ + nit_) % NGW;     \
        if (it < nit_) tr_load(sg_, it, lane, va_); \
        for (; it < nit_; it += 2 * NGW) { const bool nx_ = it + NGW < nit_, nx2_ = it + 2 * NGW < nit_; \
            if (nx_) tr_load(sg_, it + NGW, lane, vb_); \
            tr_store(sg_, it, lane, va_, scr); \
            if (nx2_) tr_load(sg_, it + 2 * NGW, lane, va_); \
            if (nx_) tr_store(sg_, it + NGW, lane, vb_, scr); } } while (0)
    SEG(p.in[2], 16416, 16384, 32, (bf16*)(ws + WS_WFF0), 4096, ng + 0 * 4096);
    SEG(p.in[2] + (size_t)4096 * 16416, 16416, 0, 16384, (bf16*)(ws + WS_WFI1), 4096, ng + 3 * 4096);
    SEG(p.in[2] + (size_t)4096 * 16416, 16416, 16384, 32, (bf16*)(ws + WS_WFF1), 4096, ng + 3 * 4096);
    SEG(p.in[4], 4096, 0, 4096, (bf16*)(ws + WS_WFO0), 4096, (const LAS float*)nullptr);
    SEG(p.in[4] + (size_t)4096 * 4096, 4096, 0, 4096, (bf16*)(ws + WS_WFO1), 4096, (const LAS float*)nullptr);
    SEG(p.in[5], 8192, 0, 8192, (bf16*)(ws + WS_WLI), 4096, ng + 1 * 4096);
    SEG(p.in[13], 4096, 0, 4096, (bf16*)(ws + WS_WLO), 4096, (const LAS float*)nullptr);
    for (int n = 0; n < 16; ++n) {
        SEG(p.in[8] + (size_t)n * 65536, 256, 0, 256, (bf16*)(ws + WS_WLA) + (size_t)n * 65536, 256, (const LAS float*)nullptr);
        SEG(p.in[10] + (size_t)n * 65536, 256, 0, 256, (bf16*)(ws + WS_WLX) + (size_t)n * 65536, 256, (const LAS float*)nullptr);
    }
    SEG(p.in[14], 16400, 0, 12288, (bf16*)(ws + WS_WMI), 4096, ng + 2 * 4096);
    SEG(p.in[14], 16400, 12288, 32, (bf16*)(ws + WS_WMG), 4096, ng + 2 * 4096);
    SEG(p.in[14], 16400, 12304, 4096, (bf16*)(ws + WS_WMI) + (size_t)12288 * 4096, 4096, ng + 2 * 4096);
    SEG(p.in[17], 4096, 0, 4096, (bf16*)(ws + WS_WMO), 4096, (const LAS float*)nullptr);
    SEG(p.in[2], 16416, 0, 16384, (bf16*)(ws + WS_WFI0), 4096, ng + 0 * 4096);
#undef SEG
    const float* x = p.in[0]; bf16* hb = (bf16*)(ws + WS_HB); unsigned long long* ss0 = (unsigned long long*)(ws + WS_ROWSS);
    for (int m = gw; m < SEQ; m += NGW) {
        const f32x4* xr = (const f32x4*)(x + (size_t)m * DM) + lane; unsigned long long* o8 = (unsigned long long*)(hb + (size_t)m * DM) + lane; float s = 0.f;
#pragma unroll
        for (int j = 0; j < 16; ++j) { const f32x4 v = xr[64 * j]; const unsigned w0 = pk2(v.x, v.y), w1 = pk2(v.z, v.w);
            const float r0 = __uint_as_float(w0 << 16), r1 = __uint_as_float(w0 & 0xffff0000u), r2 = __uint_as_float(w1 << 16), r3 = __uint_as_float(w1 & 0xffff0000u);
            s += (r0 * r0 + r1 * r1) + (r2 * r2 + r3 * r3);
            o8[64 * j] = (unsigned long long)w0 | ((unsigned long long)w1 << 32); }
        s = wave_sum(s);
        if (lane == 0) ss0[m] = (unsigned long long)(s * 1048576.0f + 0.5f);
    }
}

template <int NT>
__device__ __forceinline__ void side_gate_tile(const bf16* hb, const bf16* Wg, int row0, int lane, f32x4 (&acc)[NT]) {
    const int fr = lane & 15, fq = lane >> 4;
    const bf16* ap = hb + (size_t)(row0 + fr) * DM + 8 * fq;
    const bf16* bp = Wg + (size_t)fr * DM + 8 * fq;
#pragma unroll
    for (int nt = 0; nt < NT; ++nt) acc[nt] = (f32x4){0.f, 0.f, 0.f, 0.f};
    bf16x8 a0[4], b0[NT][4], a1[4], b1[NT][4];
#define SG_LOAD(a, b, k0_) do { _Pragma("unroll") for (int j = 0; j < 4; ++j) a[j] = *(const bf16x8*)(ap + (k0_) + 32 * j); \
        _Pragma("unroll") for (int nt = 0; nt < NT; ++nt) _Pragma("unroll") for (int j = 0; j < 4; ++j) b[nt][j] = *(const bf16x8*)(bp + (size_t)nt * 16 * DM + (k0_) + 32 * j); } while (0)
#define SG_MMA(a, b) do { _Pragma("unroll") for (int j = 0; j < 4; ++j) _Pragma("unroll") for (int nt = 0; nt < NT; ++nt) acc[nt] = MFMA16(a[j], b[nt][j], acc[nt]); } while (0)
    SG_LOAD(a0, b0, 0);
#pragma unroll 1
    for (int k0 = 0; k0 < DM; k0 += 256) { SG_LOAD(a1, b1, k0 + 128); SG_MMA(a0, b0); SG_LOAD(a0, b0, (k0 + 256) & (DM - 1)); SG_MMA(a1, b1); }
#undef SG_LOAD
#undef SG_MMA
}
__device__ __forceinline__ void fox_gates(const bf16* hb, const bf16* Wf, const unsigned long long* rowss, const float* b_f, float* FLOC, float* FTOT, int tid) {
    const int lane = tid & 63, wave = tid >> 6, fr = lane & 15, fq = lane >> 4;
    if (wave >= 4) return;
    for (int tile = blockIdx.x * 4 + wave; tile < SEQ / 16; tile += gridDim.x * 4) {
        const int row0 = tile * 16;
        f32x4 acc[2]; side_gate_tile<2>(hb, Wf, row0, lane, acc);
        float rs[4];
#pragma unroll
        for (int j = 0; j < 4; ++j) rs[j] = rsqrtf((float)rowss[row0 + 4 * fq + j] * (1.0f / (1048576.0f * 4096.0f)) + 1e-6f);
#pragma unroll
        for (int nt = 0; nt < 2; ++nt) { const int h = 16 * nt + fr; const float bb = b_f[h];
            float c[4]; float run = 0.f;
#pragma unroll
            for (int j = 0; j < 4; ++j) { run += logsigmoidf_(acc[nt][j] * rs[j] + bb); c[j] = run; }
            float inc = run; float u = __shfl_up(inc, 16); if (fq >= 1) inc += u; u = __shfl_up(inc, 32); if (fq >= 2) inc += u;
            const float exc = inc - run;
#pragma unroll
            for (int j = 0; j < 4; ++j) FLOC[(size_t)h * SEQ + row0 + 4 * fq + j] = exc + c[j];
            if (fq == 3) FTOT[h * 1024 + tile] = inc; }
    }
}
__device__ __forceinline__ void mlstm_gates(const bf16* hb, const bf16* Wg, const unsigned long long* rowss, const float* b_i, const float* b_f, float* IG, float* LF, int tid) {
    const int lane = tid & 63, wave = tid >> 6, fr = lane & 15, fq = lane >> 4;
    if (wave >= 4) return;
    for (int tile = blockIdx.x * 4 + wave; tile < SEQ / 16; tile += gridDim.x * 4) {
        const int row0 = tile * 16;
        f32x4 acc[1]; side_gate_tile<1>(hb, Wg, row0, lane, acc);
        const int h = fr & 7; const float bb = (fr < 8) ? b_i[h] : b_f[h];
#pragma unroll
        for (int j = 0; j < 4; ++j) { const int row = row0 + 4 * fq + j; const float rs = rsqrtf((float)rowss[row] * (1.0f / (1048576.0f * 4096.0f)) + 1e-6f);
            const float v = acc[0][j] * rs + bb;
            if (fr < 8) IG[(size_t)h * SEQ + row] = v; else LF[(size_t)h * SEQ + row] = logsigmoidf_(v); }
    }
}

__device__ __forceinline__ float fox_setup_fabs(char* lds, const float* FLOC, const float* FTOT, const unsigned* nrm, int h, int tid) {
    float* PH = (float*)(lds + fa::LDS_BODY); float* FABS = PH + 1024;
    asm volatile("" : "+v"(tid));
    const int lane = tid & 63;
    if (tid < 64) {
        const f32x4* src = (const f32x4*)(FTOT + h * 1024 + lane * 16);
        const f32x4 a = src[0], b = src[1], c = src[2], d = src[3];
        const float v[16] = {a[0], a[1], a[2], a[3], b[0], b[1], b[2], b[3], c[0], c[1], c[2], c[3], d[0], d[1], d[2], d[3]};
        float ex[16]; float run = 0.f;
#pragma unroll
        for (int i = 0; i < 16; ++i) { ex[i] = run; run += v[i]; }
        float inc = run;
#pragma unroll
        for (int o = 1; o < 64; o <<= 1) { const float u = __shfl_up(inc, o); if (lane >= o) inc += u; }
        const float base = inc - run;
#pragma unroll
        for (int i = 0; i < 16; ++i) PH[lane * 16 + i] = base + ex[i];
    }
    __syncthreads();
#pragma unroll
    for (int k = 0; k < SEQ / 4 / NTHR; ++k) { const int i = tid + NTHR * k; const f32x4 f = ((const f32x4*)(FLOC + (size_t)h * SEQ))[i]; const float ph = PH[i >> 2];
        ((f32x4*)FABS)[i] = (f + ph) * fa::INV_SCALE; }
    __syncthreads();
    float B = 0.f;
#pragma unroll
    for (int c = 0; c < 4; ++c) B += sqrtf(__uint_as_float(nrm[h * 4 + c])) * sqrtf(__uint_as_float(nrm[(32 + h) * 4 + c]));
    B *= 1.02f * fa::SCALE;
    return (105.0f + 2.0f * B) * fa::INV_SCALE;
}
__device__ __forceinline__ int fox_jlo(const float* FABS, int P0, float thp, int lane) {
    asm volatile("" : "+v"(lane));
    const float f0 = FABS[P0]; int cnt = 0;
#pragma unroll
    for (int c = 0; c < 4; ++c) { const int s = 64 * (64 * c + lane) + 63; const bool skip = (s < P0) && (FABS[s] - f0 >= thp); cnt += __popcll(__ballot(skip)); }
    return cnt;
}
__device__ __forceinline__ int fox_grab(unsigned* qcnt, volatile LAS unsigned* slot, int tid) {
    if (tid == 0) { const unsigned i = __hip_atomic_fetch_add(qcnt, 1u, __ATOMIC_RELAXED, __HIP_MEMORY_SCOPE_AGENT); *slot = i < 1024u ? i : 0xffffffffu; }
    __syncthreads();
    const int r = (int)*slot;
    __syncthreads();
    return r;
}
__device__ __forceinline__ void fox_attn_phase(char* lds, const bf16* Q, const bf16* K, const float* FLOC, const float* FTOT, const unsigned* nrm, unsigned* qcnt, int tid) {
    static_assert(WS_PSTRIDE / 2 == fa::V_OFF && (WS_Y - WS_P0) / 2 == fa::O_OFF, "attention tensor offsets");
    const int lane = tid & 63;
    volatile LAS unsigned* slot = (volatile LAS unsigned*)((LAS unsigned char*)lds + LDS_CTL) + 8;
    const float* FABS = (const float*)(lds + fa::LDS_BODY) + 1024;
    typedef fa::BlockRef<bf16, bf16> Ref;
#define FOX_REF(r, h_, qb_, jlo_) do { r.Q = Q + (size_t)(qb_) * fa::QB * fa::LD + (size_t)(h_) * fa::D; r.K = K + (size_t)(h_) * fa::D; r.P0 = (qb_) * fa::QB; r.JLO = (jlo_); } while (0)
#define FOX_ITEM(it_, h_, x_) do { h_ = 31 - ((it_) >> 5); x_ = 31 - ((it_) & 31); } while (0)
    int it = fox_grab(qcnt, slot, tid); if (it < 0) return;
    fa::Seam<bf16> S;
    int h, x, pass = 0, jl1; bool fresh = true; FOX_ITEM(it, h, x);
    float thp = fox_setup_fabs(lds, FLOC, FTOT, nrm, h, tid);
    Ref cur; FOX_REF(cur, h, x, fox_jlo(FABS, x * fa::QB, thp, lane)); jl1 = fox_jlo(FABS, (63 - x) * fa::QB, thp, lane);
    for (;;) {
        if (fresh) { fa::causal_swa_prime<bf16, bf16>(cur, SEQ, lds, S); fresh = false; }
        Ref nxt; if (pass == 0) { FOX_REF(nxt, h, 63 - x, jl1); } else nxt = cur;
        fa::causal_swa_block<bf16, bf16>(cur, nxt, SEQ, SEQ, lds, S, (const LAS float*)FABS);
        if (pass == 0) { pass = 1; cur = nxt; continue; }
        it = fox_grab(qcnt, slot, tid); if (it < 0) break;
        int hn, xn; FOX_ITEM(it, hn, xn);
        if (hn != h) thp = fox_setup_fabs(lds, FLOC, FTOT, nrm, hn, tid);
        h = hn; x = xn; pass = 0; fresh = true;
        FOX_REF(cur, h, x, fox_jlo(FABS, x * fa::QB, thp, lane)); jl1 = fox_jlo(FABS, (63 - x) * fa::QB, thp, lane);
    }
#undef FOX_REF
#undef FOX_ITEM
}

__device__ __forceinline__ void lru_scan_phase(char* ldsg, const Params& p, int tid) {
    unsigned char* ws = p.ws;
    const bf16* XB = (const bf16*)(ws + WS_P0); const bf16* Zt = (const bf16*)(ws + WS_P0 + WS_PSTRIDE);
    bf16* HZ = (bf16*)(ws + WS_P0 + 2 * WS_PSTRIDE); bf16* PZ = (bf16*)(ws + WS_P0 + 3 * WS_PSTRIDE);
    const bf16* WLA = (const bf16*)(ws + WS_WLA); const bf16* WLX = (const bf16*)(ws + WS_WLX);
    float* CA = (float*)(ws + WS_CA); float* CB = (float*)(ws + WS_CB);
    const float* conv_w = late_in(6); const float* conv_b = late_in(7); const float* b_a = late_in(9); const float* b_x = late_in(11); const float* lam = late_in(12);
    constexpr int XS = 264;
    bf16* XC = (bf16*)ldsg; bf16* PT = XC + 128 * XS; float* CW = (float*)(ldsg + 2 * 128 * XS * 2); float* CBs = CW + 1024;
    const int lane = tid & 63, wid = __builtin_amdgcn_readfirstlane(tid >> 6), fr = lane & 15, fq = lane >> 4;
    for (int u = blockIdx.x; u < 256; u += gridDim.x) {
        const int n = u & 15, sc = u >> 4;
        for (int i = tid; i < 1024; i += NTHR) CW[i] = conv_w[(i >> 8) * 4096 + n * 256 + (i & 255)];
        if (tid < 256) CBs[tid] = conv_b[n * 256 + tid];
        float ba[2], bx[2], nl[2], hc[2], pc[2];
#pragma unroll
        for (int nt = 0; nt < 2; ++nt) { const int c = n * 256 + 32 * wid + 16 * nt + fr; ba[nt] = b_a[c]; bx[nt] = b_x[c]; nl[nt] = -8.0f * log1pf(__expf(-lam[c])); hc[nt] = 0.f; pc[nt] = 1.f; }
        __syncthreads();
        for (int tile = 0; tile < 8; ++tile) {
            const int T0 = sc * 1024 + tile * 128;
            int tidq = tid; asm volatile("" : "+v"(tidq));
            { const int c0 = (tidq & 31) * 8, tq = tidq >> 5;
                float wv[4][8], bv[8];
#pragma unroll
                for (int e = 0; e < 8; ++e) bv[e] = CBs[c0 + e];
#pragma unroll
                for (int j = 0; j < 4; ++j)
#pragma unroll
                    for (int e = 0; e < 8; ++e) wv[j][e] = CW[j * 256 + c0 + e];
                const bf16* xrow = XB + (size_t)T0 * DM + n * 256 + c0;
                bf16x8 xv[8][4];
#pragma unroll
                for (int i = 0; i < 8; ++i)
#pragma unroll
                    for (int j = 0; j < 4; ++j) { const int dt = tq + 16 * i - 3 + j;
                        if (i == 0) { const bool neg = T0 + dt < 0; xv[i][j] = *(const bf16x8*)(xrow + (ptrdiff_t)(neg ? -T0 : dt) * DM); }
                        else xv[i][j] = *(const bf16x8*)(xrow + (ptrdiff_t)dt * DM); }
                __builtin_amdgcn_sched_barrier(0);
#pragma unroll
                for (int i = 0; i < 8; ++i) { const int t = tq + 16 * i;
                    if (i == 0) {
#pragma unroll
                        for (int j = 0; j < 3; ++j) if (T0 + t - 3 + j < 0) xv[0][j] = (bf16x8){0, 0, 0, 0, 0, 0, 0, 0}; }
                    float a[8];
#pragma unroll
                    for (int e = 0; e < 8; ++e) a[e] = bv[e];
#pragma unroll
                    for (int j = 0; j < 4; ++j)
#pragma unroll
                        for (int e = 0; e < 8; ++e) a[e] = __builtin_fmaf(wv[j][e], bf2f((unsigned short)xv[i][j][e]), a[e]);
                    v4u o; o.x = pk2(a[0], a[1]); o.y = pk2(a[2], a[3]); o.z = pk2(a[4], a[5]); o.w = pk2(a[6], a[7]);
                    *(v4u*)(XC + t * XS + c0) = o; } }
            __syncthreads();
            f32x4 acc[2][8][2];
#pragma unroll
            for (int g = 0; g < 2; ++g)
#pragma unroll
                for (int rt = 0; rt < 8; ++rt)
#pragma unroll
                    for (int nt = 0; nt < 2; ++nt) acc[g][rt][nt] = (f32x4){0.f, 0.f, 0.f, 0.f};
#pragma unroll 2
            for (int kk = 0; kk < 8; ++kk) {
                bf16x8 bfr[2][2];
#pragma unroll
                for (int nt = 0; nt < 2; ++nt) { const size_t wo = (size_t)n * 65536 + (size_t)(32 * wid + 16 * nt + fr) * 256 + 32 * kk + 8 * fq;
                    bfr[0][nt] = *(const bf16x8*)(WLA + wo); bfr[1][nt] = *(const bf16x8*)(WLX + wo); }
#pragma unroll
                for (int rt = 0; rt < 8; ++rt) { const bf16x8 a = *(const bf16x8*)(XC + (16 * rt + fr) * XS + 32 * kk + 8 * fq);
#pragma unroll
                    for (int g = 0; g < 2; ++g)
#pragma unroll
                        for (int nt = 0; nt < 2; ++nt) acc[g][rt][nt] = MFMA16(a, bfr[g][nt], acc[g][rt][nt]); }
            }
            __syncthreads();
            LAS bf16* xcb = (LAS bf16*)XC + (4 * fq) * XS + 32 * wid + fr; LAS bf16* ptb = xcb + 128 * XS; asm volatile("" : "+v"(xcb), "+v"(ptb));
#pragma unroll
            for (int nt = 0; nt < 2; ++nt) {
#pragma unroll
                for (int rt = 0; rt < 8; ++rt) {
                    float A[4], B[4];
#pragma unroll
                    for (int j = 0; j < 4; ++j) {
                        const float r = sigmoidf_(acc[0][rt][nt][j] + ba[nt]), ig = sigmoidf_(acc[1][rt][nt][j] + bx[nt]);
                        const float la = r * nl[nt], av = __expf(la), x2 = 2.0f * la;
                        const float es = -x2 * (1.0f + x2 * 0.5f * (1.0f + x2 * (1.0f / 3.0f) * (1.0f + x2 * 0.25f))), ed = 1.0f - av * av;
                        const float em = (x2 > -0.0625f) ? es : ed;
                        const float mult = __builtin_amdgcn_sqrtf(em);
                        const float xcv = bf2f(xcb[(16 * rt + j) * XS + 16 * nt]);
                        A[j] = av; B[j] = mult * ig * xcv; }
#pragma unroll
                    for (int j = 1; j < 4; ++j) { B[j] = B[j - 1] * A[j] + B[j]; A[j] = A[j - 1] * A[j]; }
                    float At = A[3], Bt = B[3];
                    { const float Au = __shfl_up(At, 16), Bu = __shfl_up(Bt, 16); if (fq >= 1) { Bt = At * Bu + Bt; At = At * Au; } }
                    { const float Au = __shfl_up(At, 32), Bu = __shfl_up(Bt, 32); if (fq >= 2) { Bt = At * Bu + Bt; At = At * Au; } }
                    float Ae = __shfl_up(At, 16), Be = __shfl_up(Bt, 16); if (fq == 0) { Ae = 1.f; Be = 0.f; }
                    const float At3 = __shfl(At, 48 + fr), Bt3 = __shfl(Bt, 48 + fr);
                    const float h0 = Ae * hc[nt] + Be, P0 = Ae * pc[nt];
#pragma unroll
                    for (int j = 0; j < 4; ++j) {
                        const float hj = A[j] * h0 + B[j], Pj = A[j] * P0;
                        xcb[(16 * rt + j) * XS + 16 * nt] = (bf16)(pk2(hj, 0.f) & 0xffffu); ptb[(16 * rt + j) * XS + 16 * nt] = (bf16)(pk2(Pj, 0.f) & 0xffffu); }
                    hc[nt] = At3 * hc[nt] + Bt3; pc[nt] = At3 * pc[nt];
                }
            }
            __syncthreads();
            int tidp = tid; asm volatile("" : "+v"(tidp));
            bf16x8 zq[8];
#pragma unroll
            for (int i = 0; i < 8; ++i) { const int task = tidp + NTHR * i; zq[i] = *(const bf16x8*)(Zt + (size_t)(T0 + (task >> 5)) * DM + n * 256 + (task & 31) * 8); }
#pragma unroll
            for (int i = 0; i < 8; ++i) { const int task = tidp + NTHR * i, t = task >> 5, c0 = (task & 31) * 8; const size_t go = (size_t)(T0 + t) * DM + n * 256 + c0;
                const bf16x8 z8 = zq[i], h8 = *(const bf16x8*)(XC + t * XS + c0), p8 = *(const bf16x8*)(PT + t * XS + c0);
                float hz[8], pz[8];
#pragma unroll
                for (int e = 0; e < 8; ++e) { const float z = bf2f((unsigned short)z8[e]), sz = z * sigmoidf_(z); hz[e] = bf2f((unsigned short)h8[e]) * sz; pz[e] = bf2f((unsigned short)p8[e]) * sz; }
                v4u w; w.x = pk2(hz[0], hz[1]); w.y = pk2(hz[2], hz[3]); w.z = pk2(hz[4], hz[5]); w.w = pk2(hz[6], hz[7]); *(v4u*)(HZ + go) = w;
                w.x = pk2(pz[0], pz[1]); w.y = pk2(pz[2], pz[3]); w.z = pk2(pz[4], pz[5]); w.w = pk2(pz[6], pz[7]); *(v4u*)(PZ + go) = w; }
            __syncthreads();
        }
        if (fq == 0) {
#pragma unroll
            for (int nt = 0; nt < 2; ++nt) { const size_t c = (size_t)sc * DM + n * 256 + 32 * wid + 16 * nt + fr; CA[c] = pc[nt]; CB[c] = hc[nt]; } }
    }
}
__device__ __forceinline__ void lru_fix_phase(const Params& p, int tid) {
    unsigned char* ws = p.ws;
    const bf16* HZ = (const bf16*)(ws + WS_P0 + 2 * WS_PSTRIDE); const bf16* PZ = (const bf16*)(ws + WS_P0 + 3 * WS_PSTRIDE); bf16* Y = (bf16*)(ws + WS_Y);
    const float* CA = (const float*)(ws + WS_CA); const float* CB = (const float*)(ws + WS_CB);
    const int c0 = tid * 8;
    for (int b = blockIdx.x; b < 256; b += gridDim.x) {
        const int sc = b >> 4;
        float hin[8];
#pragma unroll
        for (int e = 0; e < 8; ++e) hin[e] = 0.f;
#pragma unroll 4
        for (int s = 0; s < sc; ++s) { const f32x4 a0 = *(const f32x4*)(CA + (size_t)s * DM + c0), a1 = *(const f32x4*)(CA + (size_t)s * DM + c0 + 4);
            const f32x4 b0 = *(const f32x4*)(CB + (size_t)s * DM + c0), b1 = *(const f32x4*)(CB + (size_t)s * DM + c0 + 4);
#pragma unroll
            for (int e = 0; e < 4; ++e) { hin[e] = b0[e] + a0[e] * hin[e]; hin[4 + e] = b1[e] + a1[e] * hin[4 + e]; } }
#pragma unroll 8
        for (int r = 0; r < 64; ++r) { const size_t o = (size_t)(b * 64 + r) * DM + c0;
            const bf16x8 hz = *(const bf16x8*)(HZ + o), pz = *(const bf16x8*)(PZ + o);
            float y[8];
#pragma unroll
            for (int e = 0; e < 8; ++e) y[e] = bf2f((unsigned short)hz[e]) + bf2f((unsigned short)pz[e]) * hin[e];
            v4u w; w.x = pk2(y[0], y[1]); w.y = pk2(y[2], y[3]); w.z = pk2(y[4], y[5]); w.w = pk2(y[6], y[7]);
            *(v4u*)(Y + o) = w; }
    }
}

__device__ __forceinline__ void mlstm_scalars_phase(char* ldsg, const Params& p, int tid) {
    if (blockIdx.x >= 8) return;
    unsigned char* ws = p.ws; const int h = blockIdx.x, lane = tid & 63, wid = tid >> 6;
    const float* IG = (const float*)(ws + WS_IG) + (size_t)h * SEQ; const float* LF = (const float*)(ws + WS_LF) + (size_t)h * SEQ;
    float* G = (float*)ldsg; float* AM = G + 256; float* M0 = AM + 256; float* MN = M0 + 256;
    float lfv[32], igv[32];
#pragma unroll
    for (int k = 0; k < 32; ++k) { const int tok = (wid + NWAVES * k) * 64 + lane; lfv[k] = LF[tok]; igv[k] = IG[tok]; }
#pragma unroll
    for (int k = 0; k < 32; ++k) { const int c = wid + NWAVES * k; const float ig = igv[k];
        float bc = lfv[k];
#pragma unroll
        for (int o = 1; o < 64; o <<= 1) { const float u = __shfl_up(bc, o); if (lane >= o) bc += u; }
        lfv[k] = bc;
        const float g = __shfl(bc, 63); float pm = ig - bc;
#pragma unroll
        for (int o = 1; o < 64; o <<= 1) pm = fmaxf(pm, __shfl_xor(pm, o));
        if (lane == 0) { G[c] = g; AM[c] = g + pm; } }
    __syncthreads();
    if (tid < 64) { float* DEC = (float*)(ws + WS_DEC) + h * 256;
        float g[4], am[4];
#pragma unroll
        for (int j = 0; j < 4; ++j) { g[j] = G[4 * lane + j]; am[j] = AM[4 * lane + j]; }
        float A = g[0], B = am[0];
#pragma unroll
        for (int j = 1; j < 4; ++j) { B = fmaxf(B + g[j], am[j]); A += g[j]; }
#pragma unroll
        for (int o = 1; o < 64; o <<= 1) { const float Au = __shfl_up(A, o), Bu = __shfl_up(B, o); if (lane >= o) { B = fmaxf(Bu + A, B); A = Au + A; } }
        float Ae = __shfl_up(A, 1), Be = __shfl_up(B, 1); if (lane == 0) { Ae = 0.f; Be = -__builtin_inff(); }
        float m = fmaxf(Ae, Be);
#pragma unroll
        for (int j = 0; j < 4; ++j) { const int c = 4 * lane + j; M0[c] = m; const float mn = fmaxf(g[j] + m, am[j]); DEC[c] = __expf(g[j] + m - mn); MN[c] = mn; m = mn; } }
    __syncthreads();
    float* W1 = (float*)(ws + WS_W1) + (size_t)h * SEQ; float* W2 = (float*)(ws + WS_W2) + (size_t)h * SEQ; float* WK = (float*)(ws + WS_WK) + (size_t)h * SEQ;
    float* ER = (float*)(ws + WS_EROW) + (size_t)h * SEQ; float* BC = (float*)(ws + WS_BC) + (size_t)h * SEQ; float* IGB = (float*)(ws + WS_IGB) + (size_t)h * SEQ;
    float* DMX = (float*)(ws + WS_DMAX) + (size_t)h * SEQ;
#pragma unroll
    for (int k = 0; k < 32; ++k) { const int c = wid + NWAVES * k, tok = c * 64 + lane; const float ig = igv[k], bc = lfv[k];
        const float g = __shfl(bc, 63); const float xs = ig - bc; float pm = xs;
#pragma unroll
        for (int o = 1; o < 64; o <<= 1) { const float u = __shfl_up(pm, o); if (lane >= o) pm = fmaxf(pm, u); }
        const float dmax = bc + pm, m = M0[c], mrow = fmaxf(bc + m, dmax);
        BC[tok] = bc; IGB[tok] = xs; DMX[tok] = dmax;
        W1[tok] = __expf(dmax - mrow); W2[tok] = __expf(bc + m - mrow) * 0.0625f; ER[tok] = __expf(-mrow); WK[tok] = __expf(g + xs - MN[c]); }
}
__device__ __forceinline__ u16x4 tr_read(unsigned lds_addr) { u16x4 r; asm volatile("ds_read_b64_tr_b16 %0, %1\n\ts_waitcnt lgkmcnt(0)" : "=&v"(r) : "v"(lds_addr) : "memory"); return r; }
__device__ __forceinline__ void mlstm_pre_phase(char* ldsg, const Params& p, int tid) {
    unsigned char* ws = p.ws;
    const bf16* QK = (const bf16*)(ws + WS_P0); const bf16* Vt = (const bf16*)(ws + WS_P0 + WS_PSTRIDE);
    bf16* QP = (bf16*)(ws + WS_QP); bf16* KT = (bf16*)(ws + WS_KT); bf16* VT = (bf16*)(ws + WS_VT); bf16* NINT = (bf16*)(ws + WS_NINT);
    constexpr int TS = 264, SS = 72;
    bf16* QL = (bf16*)ldsg; bf16* KL = QL + 64 * TS; bf16* VL = KL + 64 * TS; bf16* SCL = VL + 64 * TS;
    float* W1s = (float*)(SCL + 64 * SS); float* BCs = W1s + 64; float* IGBs = BCs + 64; float* DMs = IGBs + 64; float* DENP = DMs + 64; float* WKs = DENP + 256;
    const int lane = tid & 63, wid = __builtin_amdgcn_readfirstlane(tid >> 6), fr = lane & 15, fq = lane >> 4;
    const unsigned vl_addr = (unsigned)(uintptr_t)VL;
    for (int u = blockIdx.x; u < 2048; u += gridDim.x) {
        const int h = u >> 8, c = u & 255, tok0 = c * 64; const size_t hs = (size_t)h * SEQ + tok0;
        if (tid < 64) { W1s[tid] = ((const float*)(ws + WS_W1))[hs + tid]; BCs[tid] = ((const float*)(ws + WS_BC))[hs + tid]; IGBs[tid] = ((const float*)(ws + WS_IGB))[hs + tid];
            DMs[tid] = ((const float*)(ws + WS_DMAX))[hs + tid]; WKs[tid] = ((const float*)(ws + WS_WK))[hs + tid]; }
#pragma unroll
        for (int i = 0; i < 4; ++i) { const int task = tid + NTHR * i, t = task >> 5, d0 = (task & 31) * 8;
            const bf16x8 q8 = *(const bf16x8*)(QK + (size_t)(tok0 + t) * DM + h * 256 + d0), k8 = *(const bf16x8*)(QK + (size_t)(tok0 + t) * DM + 2048 + h * 256 + d0);
            *(bf16x8*)(QL + t * TS + d0) = q8; *(bf16x8*)(KL + t * TS + d0) = k8;
            const float w2 = ((const float*)(ws + WS_W2))[hs + t];
            v2u lo, hi; lo.x = pk2(bf2f((unsigned short)q8[0]) * w2, bf2f((unsigned short)q8[1]) * w2); lo.y = pk2(bf2f((unsigned short)q8[2]) * w2, bf2f((unsigned short)q8[3]) * w2);
            hi.x = pk2(bf2f((unsigned short)q8[4]) * w2, bf2f((unsigned short)q8[5]) * w2); hi.y = pk2(bf2f((unsigned short)q8[6]) * w2, bf2f((unsigned short)q8[7]) * w2);
            const int r = d0 & 31, g0 = (r >> 2) & 3, dtq = r >> 4;
            bf16* qf = QP + ((((size_t)(h * 256 + c) * 8 + (d0 >> 5)) * 4 + (t >> 4)) * 512) + ((t & 15) + 16 * g0) * 8 + 4 * dtq;
            *(v2u*)qf = lo; *(v2u*)(qf + 128) = hi; }
        __syncthreads();
#pragma unroll
        for (int i = 0; i < 4; ++i) { const int task = tid + NTHR * i, d = task & 255, sg = task >> 8;
            float v[8];
#pragma unroll
            for (int e = 0; e < 8; ++e) v[e] = bf2f(KL[(8 * sg + e) * TS + d]) * WKs[8 * sg + e];
            v4u w; w.x = pk2(v[0], v[1]); w.y = pk2(v[2], v[3]); w.z = pk2(v[4], v[5]); w.w = pk2(v[6], v[7]);
            *(v4u*)(KT + ((((size_t)(h * 256 + c) * 8 + (d >> 5)) * 2 + ((d >> 4) & 1)) * 2 + (sg >> 2)) * 512 + ((d & 15) + 16 * (sg & 3)) * 8) = w; }
        { const int tr = wid >> 1;
#pragma unroll
          for (int tci = 0; tci < 2; ++tci) { const int tc = (wid & 1) * 2 + tci;
            if (tc <= tr) { f32x4 acc = (f32x4){0.f, 0.f, 0.f, 0.f};
#pragma unroll
                for (int kk = 0; kk < 8; ++kk) { const bf16x8 a = *(const bf16x8*)(QL + (16 * tr + fr) * TS + 32 * kk + 8 * fq), b = *(const bf16x8*)(KL + (16 * tc + fr) * TS + 32 * kk + 8 * fq);
                    acc = MFMA16(a, b, acc); }
                const int s = 16 * tc + fr; const float igb = IGBs[s];
#pragma unroll
                for (int j = 0; j < 4; ++j) { const int t = 16 * tr + 4 * fq + j;
                    float val = (s <= t) ? acc[j] * 0.0625f * __expf(BCs[t] + igb - DMs[t]) : 0.f;
                    SCL[t * SS + s] = (bf16)(pk2(val, 0.f) & 0xffffu);
                    val += __shfl_xor(val, 1); val += __shfl_xor(val, 2); val += __shfl_xor(val, 4); val += __shfl_xor(val, 8);
                    if (fr == 0) DENP[tc * 64 + t] = val; } }
            else {
#pragma unroll
                for (int j = 0; j < 4; ++j) { SCL[(16 * tr + 4 * fq + j) * SS + 16 * tc + fr] = (bf16)0; if (fr == 0) DENP[tc * 64 + 16 * tr + 4 * fq + j] = 0.f; } } } }
        __syncthreads();
        for (int vh = 0; vh < 2; ++vh) {
#pragma unroll
            for (int i = 0; i < 4; ++i) { const int task = tid + NTHR * i, s = task >> 5, c0 = (task & 31) * 8;
                *(bf16x8*)(VL + s * TS + c0) = *(const bf16x8*)(Vt + (size_t)(tok0 + s) * DM + h * 512 + 256 * vh + c0); }
            __syncthreads();
#pragma unroll
            for (int i = 0; i < 4; ++i) { const int task = tid + NTHR * i, v = task & 255, sg = task >> 8;
                v4u w; w.x = (unsigned)VL[(8 * sg + 0) * TS + v] | ((unsigned)VL[(8 * sg + 1) * TS + v] << 16); w.y = (unsigned)VL[(8 * sg + 2) * TS + v] | ((unsigned)VL[(8 * sg + 3) * TS + v] << 16);
                w.z = (unsigned)VL[(8 * sg + 4) * TS + v] | ((unsigned)VL[(8 * sg + 5) * TS + v] << 16); w.w = (unsigned)VL[(8 * sg + 6) * TS + v] | ((unsigned)VL[(8 * sg + 7) * TS + v] << 16);
                *(v4u*)(VT + (((size_t)(h * 256 + c) * 32 + ((256 * vh + v) >> 4)) * 2 + (sg >> 2)) * 512 + ((v & 15) + 16 * (sg & 3)) * 8) = w; }
            f32x4 acc[4][2];
#pragma unroll
            for (int tt = 0; tt < 4; ++tt)
#pragma unroll
                for (int nt = 0; nt < 2; ++nt) acc[tt][nt] = (f32x4){0.f, 0.f, 0.f, 0.f};
#pragma unroll
            for (int ks = 0; ks < 2; ++ks) {
                bf16x8 bfr[2];
#pragma unroll
                for (int nt = 0; nt < 2; ++nt) { const unsigned a0 = vl_addr + (unsigned)((32 * ks + 8 * fq + (fr >> 2)) * TS + 16 * (2 * wid + nt) + 4 * (fr & 3)) * 2u;
                    const u16x4 lo = tr_read(a0), hi = tr_read(a0 + 4u * TS * 2u);
                    bfr[nt] = (bf16x8){(short)lo[0], (short)lo[1], (short)lo[2], (short)lo[3], (short)hi[0], (short)hi[1], (short)hi[2], (short)hi[3]}; }
#pragma unroll
                for (int tt = 0; tt < 4; ++tt) { const bf16x8 a = *(const bf16x8*)(SCL + (16 * tt + fr) * SS + 32 * ks + 8 * fq);
#pragma unroll
                    for (int nt = 0; nt < 2; ++nt) acc[tt][nt] = MFMA16(a, bfr[nt], acc[tt][nt]); }
            }
#pragma unroll
            for (int tt = 0; tt < 4; ++tt)
#pragma unroll
                for (int j = 0; j < 4; ++j) { const int t = 16 * tt + 4 * fq + j; const float w1 = W1s[t];
#pragma unroll
                    for (int nt = 0; nt < 2; ++nt) NINT[(size_t)(tok0 + t) * DM + h * 512 + 256 * vh + 16 * (2 * wid + nt) + fr] = (bf16)(pk2(acc[tt][nt][j] * w1, 0.f) & 0xffffu); }
            __syncthreads();
        }
        if (tid < 64) ((float*)(ws + WS_DENI))[hs + tid] = W1s[tid] * (((DENP[tid] + DENP[64 + tid]) + DENP[128 + tid]) + DENP[192 + tid]);
        __syncthreads();
    }
}
template <int VAR>
__device__ __forceinline__ void mlstm_seq_phase(char* ldsg, const Params& p, int tid) {
    unsigned char* ws = p.ws;
    const bf16* QP = (const bf16*)(ws + WS_QP); const bf16* KT = (const bf16*)(ws + WS_KT); const bf16* VT = (const bf16*)(ws + WS_VT); const bf16* NINT = (const bf16*)(ws + WS_NINT);
    const bf16* Ot = (const bf16*)(ws + WS_P0 + 2 * WS_PSTRIDE); const bf16* Zt = (const bf16*)(ws + WS_P0 + 3 * WS_PSTRIDE); bf16* Y = (bf16*)(ws + (VAR ? WS_END : WS_Y));
    const float* DENI = (const float*)(ws + WS_DENI); const float* ER = (const float*)(ws + WS_EROW); const float* DEC = (const float*)(ws + WS_DEC);
    constexpr int PW = 20;
    float* PART = (float*)ldsg;
    const int lane = tid & 63, wid = __builtin_amdgcn_readfirstlane(tid >> 6), fr = lane & 15, fq = lane >> 4;
    const short one = (fr == 0) ? (short)0x3F80 : (short)0;
    const bf16x8 ones = (bf16x8){one, one, one, one, one, one, one, one};
    for (int u = blockIdx.x; u < 256; u += gridDim.x) {
        const int h = u & 7, vs = u >> 3;
        f32x4 st[2][2];
#pragma unroll
        for (int dt = 0; dt < 2; ++dt)
#pragma unroll
            for (int nt = 0; nt < 2; ++nt) st[dt][nt] = (f32x4){0.f, 0.f, 0.f, 0.f};
        const bf16* qp = QP + ((size_t)h * 256 * 8 + wid) * 2048 + lane * 8;
        const bf16* kt = KT + ((size_t)h * 256 * 8 + wid) * 2048 + lane * 8;
        const bf16* vt = VT + ((size_t)h * 256 * 32 + vs) * 1024 + lane * 8;
        const int et = tid >> 3, ev = (tid & 7) * 2; const size_t ecol = (size_t)h * 512 + vs * 16 + ev;
        bf16x8 aQ0[4], aK0[2][2], bV0[2], aQ1[4], aK1[2][2], bV1[2];
        unsigned ni0, oi0, zi0, ni1, oi1, zi1; float di0, ei0, di1, ei1, dec0, dec1;
#define SEQ_LOAD(c_, aQ, aK, bV, ni, oi, zi, di, ei, dec) do { dec = DEC[h * 256 + (c_)]; _Pragma("unroll") for (int tt = 0; tt < 4; ++tt) aQ[tt] = *(const bf16x8*)(qp + (size_t)(c_) * 16384 + tt * 512); \
            _Pragma("unroll") for (int dt = 0; dt < 2; ++dt) _Pragma("unroll") for (int ks = 0; ks < 2; ++ks) aK[dt][ks] = *(const bf16x8*)(kt + (size_t)(c_) * 16384 + (dt * 2 + ks) * 512); \
            _Pragma("unroll") for (int ks = 0; ks < 2; ++ks) bV[ks] = *(const bf16x8*)(vt + (size_t)(c_) * 32768 + ks * 512); \
            { const size_t tok = (size_t)(c_) * 64 + et; \
                ni = *(const unsigned*)(NINT + tok * DM + ecol); oi = *(const unsigned*)(Ot + tok * DM + ecol); zi = *(const unsigned*)(Zt + tok * DM + ecol); di = DENI[(size_t)h * SEQ + tok]; ei = ER[(size_t)h * SEQ + tok]; } } while (0)
#define SEQ_STEP(c_, aQ, aK, bV, ni, oi, zi, di, ei, dec) do { \
            float* part = PART + ((c_) & 1) * (8 * 64 * PW) + wid * (64 * PW); \
            const float decay = dec; \
            bf16x8 bs[2]; \
            _Pragma("unroll") for (int nt = 0; nt < 2; ++nt) { v4u w; w.x = pk2(st[0][nt][0], st[0][nt][1]); w.y = pk2(st[0][nt][2], st[0][nt][3]); w.z = pk2(st[1][nt][0], st[1][nt][1]); w.w = pk2(st[1][nt][2], st[1][nt][3]); \
                bs[nt] = __builtin_bit_cast(bf16x8, w); } \
            _Pragma("unroll") for (int tt = 0; tt < 4; ++tt) { const f32x4 z4 = (f32x4){0.f, 0.f, 0.f, 0.f}; \
                  \
                const f32x4 p0 = MFMA16(bs[0], aQ[tt], z4), p1 = MFMA16(bs[1], aQ[tt], z4); \
                *(f32x4*)(part + (16 * tt + fr) * PW + 4 * fq) = p0; part[(16 * tt + fr) * PW + 16 + fq] = p1[0]; }     \
              \
            const float nn0 = __uint_as_float(ni << 16), nn1 = __uint_as_float(ni & 0xffff0000u); \
            float gg0, gg1; { const float o0 = __uint_as_float(oi << 16), o1 = __uint_as_float(oi & 0xffff0000u), z0 = __uint_as_float(zi << 16), z1 = __uint_as_float(zi & 0xffff0000u); \
                gg0 = sigmoidf_(o0) * z0 * sigmoidf_(z0); gg1 = sigmoidf_(o1) * z1 * sigmoidf_(z1); } \
            float dd, ee; asm volatile("v_mov_b32 %0, %2\n\tv_mov_b32 %1, %3" : "=&v"(dd), "=&v"(ee) : "v"(di), "v"(ei)); \
            if (VAR != 2) __syncthreads(); \
              \
            const float* pall = PART + ((c_) & 1) * (8 * 64 * PW) + et * PW; \
            f32x2v pv[8]; float dn[8]; \
            if (VAR != 2) { _Pragma("unroll") for (int w = 0; w < 8; ++w) { pv[w] = *(const f32x2v*)(pall + w * (64 * PW) + ev); dn[w] = pall[w * (64 * PW) + 16]; } } \
            _Pragma("unroll") for (int dt = 0; dt < 2; ++dt) _Pragma("unroll") for (int nt = 0; nt < 2; ++nt) { st[dt][nt] = st[dt][nt] * decay; \
                    _Pragma("unroll") for (int ks = 0; ks < 2; ++ks) st[dt][nt] = MFMA16(aK[dt][ks], nt == 0 ? bV[ks] : ones, st[dt][nt]); } \
            __builtin_amdgcn_sched_barrier(0); \
            if (VAR != 1) { const int cn_ = (c_) + 2 < 256 ? (c_) + 2 : 255; SEQ_LOAD(cn_, aQ, aK, bV, ni, oi, zi, di, ei, dec); }     \
            __builtin_amdgcn_sched_barrier(0);     \
            if (VAR != 2) { f32x2v num; num.x = nn0; num.y = nn1; float den = dd; \
                _Pragma("unroll") for (int w = 0; w < 8; ++w) { num += pv[w]; den += dn[w]; } \
                const float rd = __builtin_amdgcn_rcpf(fmaxf(fabsf(den), ee)); \
                const float y0 = num.x * rd * gg0, y1 = num.y * rd * gg1; \
                *(unsigned*)(Y + ((size_t)(c_) * 64 + et) * DM + ecol) = pk2(y0, y1); } } while (0)
        __builtin_amdgcn_sched_barrier(0);
        SEQ_LOAD(0, aQ0, aK0, bV0, ni0, oi0, zi0, di0, ei0, dec0);
        __builtin_amdgcn_sched_barrier(0);
        SEQ_LOAD(1, aQ1, aK1, bV1, ni1, oi1, zi1, di1, ei1, dec1);
        __builtin_amdgcn_sched_barrier(0);
        for (int c = 0; c < 256; c += 2) {
            SEQ_STEP(c, aQ0, aK0, bV0, ni0, oi0, zi0, di0, ei0, dec0);
            SEQ_STEP(c + 1, aQ1, aK1, bV1, ni1, oi1, zi1, di1, ei1, dec1);
        }
#undef SEQ_LOAD
#undef SEQ_STEP
        __syncthreads();
    }
}

__device__ __forceinline__ void final_norm_phase(const bf16* hsrc, const unsigned long long* ss, const float* g, float* out, int tid) {
    const int lane = tid & 63, wave = tid >> 6;
    const int gw = blockIdx.x * NWAVES + wave, NGW = gridDim.x * NWAVES;
    f32x4 gr[8][2];
#pragma unroll
    for (int j = 0; j < 8; ++j) { gr[j][0] = ((const f32x4*)g)[2 * lane + 128 * j]; gr[j][1] = ((const f32x4*)g)[2 * lane + 128 * j + 1]; }
    for (int m = gw; m < SEQ; m += NGW) { const float rs = rsqrtf((float)ss[m] * (1.0f / (1048576.0f * 4096.0f)) + 1e-6f);
        const v4u* xr = (const v4u*)(hsrc + (size_t)m * DM) + lane; f32x4* orow = (f32x4*)(out + (size_t)m * DM) + 2 * lane;
#pragma unroll
        for (int j = 0; j < 8; ++j) { const v4u c = xr[64 * j]; const f32x4 g0 = gr[j][0], g1 = gr[j][1];
            f32x4 a, b; a[0] = __uint_as_float(c.x << 16); a[1] = __uint_as_float(c.x & 0xffff0000u); a[2] = __uint_as_float(c.y << 16); a[3] = __uint_as_float(c.y & 0xffff0000u);
            b[0] = __uint_as_float(c.z << 16); b[1] = __uint_as_float(c.z & 0xffff0000u); b[2] = __uint_as_float(c.w << 16); b[3] = __uint_as_float(c.w & 0xffff0000u);
            orow[128 * j] = a * rs * g0; orow[128 * j + 1] = b * rs * g1; } }
}

constexpr int NPH = 17;
__global__ void __launch_bounds__(NTHR, 2) mk_fwd(Params p) {
    extern __shared__ __attribute__((aligned(16))) unsigned char lds[];
    const int tid = threadIdx.x;
    LAS unsigned char* ldsl = (LAS unsigned char*)lds;
    unsigned char* ws = p.ws;
    if (tid < 64) ((LAS unsigned*)(ldsl + LDS_CTL))[tid] = 0u;
    __syncthreads();
    XcdBarrier bar = xcd_barrier_post((unsigned*)(ws + WS_CTL), (volatile LAS unsigned*)(ldsl + LDS_CTL));
    const int lo = p.ph_lo, hi = p.ph_hi;
#ifdef DBG_ONLY
#define IN(k) ((k) == DBG_ONLY && lo <= (k) && (k) < hi)
#else
#define IN(k) (lo <= (k) && (k) < hi)
#endif
#define SEAM(k) do { if (IN(k) && IN((k) + 1)) xcd_barrier(bar); } while (0)
    unsigned long long* rowss = (unsigned long long*)(ws + WS_ROWSS);
    bf16* HB = (bf16*)(ws + WS_HB); bf16* P0t = (bf16*)(ws + WS_P0); bf16* Yt = (bf16*)(ws + WS_Y);
    const int G = gridDim.x;

    if (IN(0)) { p0_prologue(p, ldsl, tid); } SEAM(0);

    if (NLAYERS > 0) {
    if (IN(1)) { fox_gates(HB, (const bf16*)(ws + WS_WFF0), rowss, late_in(3), (float*)(ws + WS_FLOC), (float*)(ws + WS_FTOT), tid);
        pg8::Gemm g{HB, (const bf16*)(ws + WS_WFI0), SEQ, 16384, DM}; pg8::StaticOrder S; S.init(SEQ, 16384, G, (int)blockIdx.x);
        pg8::EpiIn<true> E{P0t, (size_t)SEQ * DM, rowss, (unsigned*)(ws + WS_NRM)};
        pg8::gemm_phase<pg8::EpiIn<true>, pg8::StaticOrder, true, true>(ldsl, g, S, E); } SEAM(1);
    if (IN(2)) { fox_attn_phase((char*)lds, P0t, P0t + (size_t)SEQ * DM, (const float*)(ws + WS_FLOC), (const float*)(ws + WS_FTOT), (const unsigned*)(ws + WS_NRM), (unsigned*)(ws + WS_QCNT), tid); } SEAM(2);
    if (IN(3)) { pg8::Gemm g{Yt, (const bf16*)(ws + WS_WFO0), SEQ, DM, DM}; pg8::StaticOrder S; S.init(SEQ, DM, G, (int)blockIdx.x);
        pg8::EpiOut E{HB, rowss + SEQ};
        pg8::gemm_phase<pg8::EpiOut, pg8::StaticOrder, true, true>(ldsl, g, S, E); } SEAM(3);
    }
    if (NLAYERS > 1) {
    if (IN(4)) { pg8::Gemm g{HB, (const bf16*)(ws + WS_WLI), SEQ, 8192, DM}; pg8::StaticOrder S; S.init(SEQ, 8192, G, (int)blockIdx.x);
        pg8::EpiIn<false> E{P0t, (size_t)SEQ * DM, rowss + SEQ, (unsigned*)nullptr};
        pg8::gemm_phase<pg8::EpiIn<false>, pg8::StaticOrder, true, true>(ldsl, g, S, E); } SEAM(4);
    if (IN(5)) { lru_scan_phase((char*)lds, p, tid); } SEAM(5);
    if (IN(6)) { lru_fix_phase(p, tid); } SEAM(6);
    if (IN(7)) { pg8::Gemm g{Yt, (const bf16*)(ws + WS_WLO), SEQ, DM, DM}; pg8::StaticOrder S; S.init(SEQ, DM, G, (int)blockIdx.x);
        pg8::EpiOut E{HB, rowss + 2 * SEQ};
        pg8::gemm_phase<pg8::EpiOut, pg8::StaticOrder, true, true>(ldsl, g, S, E); } SEAM(7);
    }
    if (NLAYERS > 2) {
    if (IN(8)) { mlstm_gates(HB, (const bf16*)(ws + WS_WMG), rowss + 2 * SEQ, late_in(15), late_in(16), (float*)(ws + WS_IG), (float*)(ws + WS_LF), tid);
        pg8::Gemm g{HB, (const bf16*)(ws + WS_WMI), SEQ, 16384, DM}; pg8::StaticOrder S; S.init(SEQ, 16384, G, (int)blockIdx.x);
        pg8::EpiIn<false> E{P0t, (size_t)SEQ * DM, rowss + 2 * SEQ, (unsigned*)nullptr};
        pg8::gemm_phase<pg8::EpiIn<false>, pg8::StaticOrder, true, true>(ldsl, g, S, E); } SEAM(8);
    if (IN(9)) { mlstm_scalars_phase((char*)lds, p, tid); } SEAM(9);
    if (IN(10)) { mlstm_pre_phase((char*)lds, p, tid); } SEAM(10);
    if (IN(11)) { mlstm_seq_phase<0>((char*)lds, p, tid); } SEAM(11);
    if (IN(12)) { pg8::Gemm g{Yt, (const bf16*)(ws + WS_WMO), SEQ, DM, DM}; pg8::StaticOrder S; S.init(SEQ, DM, G, (int)blockIdx.x);
        pg8::EpiOut E{HB, rowss + 3 * SEQ};
        pg8::gemm_phase<pg8::EpiOut, pg8::StaticOrder, true, true>(ldsl, g, S, E); } SEAM(12);
    }
    if (NLAYERS > 3) {
    if (IN(13)) { fox_gates(HB, (const bf16*)(ws + WS_WFF1), rowss + 3 * SEQ, late_in(3) + 32, (float*)(ws + WS_FLOC), (float*)(ws + WS_FTOT), tid);
        pg8::Gemm g{HB, (const bf16*)(ws + WS_WFI1), SEQ, 16384, DM}; pg8::StaticOrder S; S.init(SEQ, 16384, G, (int)blockIdx.x);
        pg8::EpiIn<true> E{P0t, (size_t)SEQ * DM, rowss + 3 * SEQ, (unsigned*)(ws + WS_NRM) + 256};
        pg8::gemm_phase<pg8::EpiIn<true>, pg8::StaticOrder, true, true>(ldsl, g, S, E); } SEAM(13);
    if (IN(14)) { fox_attn_phase((char*)lds, P0t, P0t + (size_t)SEQ * DM, (const float*)(ws + WS_FLOC), (const float*)(ws + WS_FTOT), (const unsigned*)(ws + WS_NRM) + 256, (unsigned*)(ws + WS_QCNT) + 512, tid); } SEAM(14);
    if (IN(15)) { pg8::Gemm g{Yt, (const bf16*)(ws + WS_WFO1), SEQ, DM, DM}; pg8::StaticOrder S; S.init(SEQ, DM, G, (int)blockIdx.x);
        pg8::EpiOut E{HB, rowss + 4 * SEQ};
        pg8::gemm_phase<pg8::EpiOut, pg8::StaticOrder, true, true>(ldsl, g, S, E); } SEAM(15);
    }
    if (IN(16)) { final_norm_phase(HB, rowss + NLAYERS * SEQ, late_in(18), late_out(), tid); }
#undef IN
#undef SEAM
}

#ifndef MK_N_LAUNCHES
#define MK_N_LAUNCHES 1
#endif
extern "C" void kernel_launch(void* const* d_in, const int* in_sizes, int n_in, void* d_out, int out_size, void* d_ws, size_t ws_size, hipStream_t stream) {
    static int grid = 0;
    if (grid == 0) {
        if (n_in != 19 || out_size != SEQ * DM || ws_size < WS_END) { fprintf(stderr, "kernel_launch: unexpected shapes (n_in %d out %d ws %zu, need ws >= %zu)\n", n_in, out_size, ws_size, (size_t)WS_END); grid = -1; return; }
        int dev = 0, cus = 0, per_cu = 0;
        if (hipGetDevice(&dev) != hipSuccess || hipDeviceGetAttribute(&cus, hipDeviceAttributeMultiprocessorCount, dev) != hipSuccess) { grid = -1; return; }
        if (hipFuncSetAttribute((const void*)mk_fwd, hipFuncAttributeMaxDynamicSharedMemorySize, LDS_BYTES) != hipSuccess) { fprintf(stderr, "kernel_launch: hipFuncSetAttribute failed\n"); grid = -1; return; }
        if (hipOccupancyMaxActiveBlocksPerMultiprocessor(&per_cu, (const void*)mk_fwd, NTHR, LDS_BYTES) != hipSuccess || per_cu < 1) { fprintf(stderr, "kernel_launch: occupancy query says %d\n", per_cu); }
        (void)hipGetLastError();
        grid = cus;
    }
    if (grid < 0) return;
    (void)hipMemsetAsync((char*)d_ws + WS_CTL, 0, CTL_ZERO_BYTES, stream);
    Params p{};
    for (int i = 0; i < 19; ++i) p.in[i] = (const float*)d_in[i];
    p.out = (float*)d_out; p.ws = (unsigned char*)d_ws;
#if MK_N_LAUNCHES == 1
    p.ph_lo = 0; p.ph_hi = NPH;
    hipLaunchKernelGGL(mk_fwd, dim3(grid), dim3(NTHR), LDS_BYTES, stream, p);
#else
    for (int k = 0; k < NPH; ++k) { p.ph_lo = k; p.ph_hi = k + 1; hipLaunchKernelGGL(mk_fwd, dim3(grid), dim3(NTHR), LDS_BYTES, stream, p); }
#endif
}
```

```cpp
#include <hip/hip_runtime.h>
#include <cstdio>
#include <cstdint>
namespace pg8 {
#define PG8_LAS __attribute__((address_space(3)))
typedef unsigned short bf16_t;
typedef short bf16x8 __attribute__((ext_vector_type(8)));
typedef float f32x4 __attribute__((ext_vector_type(4)));
typedef unsigned u32x4 __attribute__((ext_vector_type(4)));
constexpr int BM = 256, BK = 64, HALF = 128, HTB = HALF * BK * 2  , STAGE_BYTES = 8 * HTB, NXCD = 8, WGM = 8;

__host__ __device__ __forceinline__ int lds_byte(int r, int c) { const int st = (r >> 4) * 2 + (c >> 5), rr = r & 15, cc = c & 31, ob = rr * 64 + cc * 2; return st * 1024 + (ob ^ (((ob >> 9) & 1) << 5)); }
__host__ __device__ __forceinline__ void stage_rc(int b, int& R, int& C) { const int st = b / 1024, sb = b % 1024, swz = sb ^ (((sb >> 9) & 1) << 5); R = (st >> 1) * 16 + swz / 64; C = (st & 1) * 32 + (swz % 64) / 2; }
__host__ __device__ __forceinline__ int perm32(int rho) { const int n = rho >> 4, i = rho & 15; return 8 * (i >> 2) + 4 * n + (i & 3); }

struct Unit { int pm, pn; };
struct Gemm { const bf16_t* A; const bf16_t* Bt; int M, N, K; };

struct StaticOrder {
    int nM, nN, nwg, G, c;
    __host__ __device__ void init(int M, int N, int G_, int c_) { nM = M / BM; nN = N / BM; nwg = nM * nN; G = G_; c = c_; }
    __host__ __device__ bool next(int i, Unit& u) const {
        const long L = (long)i * G + c; if (L >= nwg) return false;
        int wgid = (int)L; { const int q = nwg / NXCD, r = nwg % NXCD, xcd = wgid % NXCD, off = wgid / NXCD; wgid = (xcd < r ? xcd * (q + 1) : r * (q + 1) + (xcd - r) * q) + off; }
        const int nig = WGM * nN, gid = wgid / nig, fm = gid * WGM, gsz = (nM - fm) < WGM ? (nM - fm) : WGM;
        u.pm = fm + ((wgid % nig) % gsz); u.pn = (wgid % nig) / gsz; return true;
    }
    __device__ __forceinline__ void a_ready(const Unit&) const {}
    __device__ __forceinline__ void done(const Unit&) const {}
};

__device__ __forceinline__ unsigned cvt_pk_bf16(float lo, float hi) { unsigned r; asm volatile("v_cvt_pk_bf16_f32 %0, %1, %2" : "=v"(r) : "v"(lo), "v"(hi)); return r; }

template <bool NORMS> struct EpiIn {
    static constexpr bool PERM = true, AFTER_DRAIN = false;
    bf16_t* O; size_t tstride; const unsigned long long* rowss;
    unsigned* nrm;
    __device__ __forceinline__ void operator()(const f32x4 (&acc)[2][2][4][2], const Unit& u, int wr, int wc, int fr, int fq) const {
        const int row0 = u.pm * BM + wr * 64 + fr; int colt = u.pn * BM;
        const int tens = colt >> 12;
        bf16_t* base = O + (size_t)tens * tstride; colt &= 4095;
        const int col0 = colt + wc * 32 + 8 * fq;
        unsigned long long sq[8];
#pragma unroll
        for (int g = 0; g < 8; ++g) sq[g] = rowss[row0 + (g >> 2) * HALF + (g & 3) * 16];
        float nmax[2] = {0.f, 0.f};
#pragma unroll
        for (int ai = 0; ai < 2; ++ai)
#pragma unroll
            for (int m = 0; m < 4; ++m) { const int row = row0 + ai * HALF + m * 16; const float rs = rsqrtf((float)sq[ai * 4 + m] * (1.0f / (1048576.0f * 4096.0f)) + 1e-6f);
                bf16_t* rowp = base + (size_t)row * 4096 + col0;
#pragma unroll
                for (int bj = 0; bj < 2; ++bj) { const f32x4 v0 = acc[ai][bj][m][0] * rs, v1 = acc[ai][bj][m][1] * rs;
                    u32x4 w; w.x = cvt_pk_bf16(v0[0], v0[1]); w.y = cvt_pk_bf16(v0[2], v0[3]); w.z = cvt_pk_bf16(v1[0], v1[1]); w.w = cvt_pk_bf16(v1[2], v1[3]);
                    *(u32x4*)(rowp + bj * HALF) = w;
                    if (NORMS && tens < 2) { float s = ((v0[0] * v0[0] + v0[1] * v0[1]) + (v0[2] * v0[2] + v0[3] * v0[3])) + ((v1[0] * v1[0] + v1[1] * v1[1]) + (v1[2] * v1[2] + v1[3] * v1[3]));
                        s += __shfl_xor(s, 16); s += __shfl_xor(s, 32); nmax[bj] = fmaxf(nmax[bj], s); } } }
        if (NORMS && tens < 2) {
#pragma unroll
            for (int bj = 0; bj < 2; ++bj) { float s = nmax[bj]; s = fmaxf(s, __shfl_xor(s, 1)); s = fmaxf(s, __shfl_xor(s, 2)); s = fmaxf(s, __shfl_xor(s, 4)); s = fmaxf(s, __shfl_xor(s, 8));
                if (fr == 0 && fq == 0) __hip_atomic_fetch_max(nrm + ((tens * 32 + (colt >> 7) + bj) * 4 + wc), __float_as_uint(s), __ATOMIC_RELAXED, __HIP_MEMORY_SCOPE_AGENT); } }
    }
};
struct EpiOut {
    static constexpr bool PERM = true, AFTER_DRAIN = false;
    bf16_t* hb; unsigned long long* ss_next;
    __device__ __forceinline__ void operator()(const f32x4 (&acc)[2][2][4][2], const Unit& u, int wr, int wc, int fr, int fq) const {
        const int row0 = u.pm * BM + wr * 64 + fr, col0 = u.pn * BM + wc * 32 + 8 * fq;
        float ssr[8]; u32x4 cur[2], nxt[2];
#pragma unroll
        for (int bj = 0; bj < 2; ++bj) cur[bj] = *(const u32x4*)(hb + (size_t)row0 * 4096 + col0 + bj * HALF);
#pragma unroll
        for (int g = 0; g < 8; ++g) { const int ai = g >> 2, m = g & 3; bf16_t* rowp = hb + (size_t)(row0 + ai * HALF + m * 16) * 4096 + col0;
            if (g < 7) { const bf16_t* rown = hb + (size_t)(row0 + ((g + 1) >> 2) * HALF + ((g + 1) & 3) * 16) * 4096 + col0;
#pragma unroll
                for (int bj = 0; bj < 2; ++bj) nxt[bj] = *(const u32x4*)(rown + bj * HALF); }
            float ss = 0.f;
#pragma unroll
            for (int bj = 0; bj < 2; ++bj) { const u32x4 c = cur[bj];
                f32x4 o0, o1;
                o0[0] = __uint_as_float(c.x << 16) + acc[ai][bj][m][0][0]; o0[1] = __uint_as_float(c.x & 0xffff0000u) + acc[ai][bj][m][0][1];
                o0[2] = __uint_as_float(c.y << 16) + acc[ai][bj][m][0][2]; o0[3] = __uint_as_float(c.y & 0xffff0000u) + acc[ai][bj][m][0][3];
                o1[0] = __uint_as_float(c.z << 16) + acc[ai][bj][m][1][0]; o1[1] = __uint_as_float(c.z & 0xffff0000u) + acc[ai][bj][m][1][1];
                o1[2] = __uint_as_float(c.w << 16) + acc[ai][bj][m][1][2]; o1[3] = __uint_as_float(c.w & 0xffff0000u) + acc[ai][bj][m][1][3];
                u32x4 w; w.x = cvt_pk_bf16(o0[0], o0[1]); w.y = cvt_pk_bf16(o0[2], o0[3]); w.z = cvt_pk_bf16(o1[0], o1[1]); w.w = cvt_pk_bf16(o1[2], o1[3]);
                *(u32x4*)(rowp + bj * HALF) = w;
                const float r0 = __uint_as_float(w.x << 16), r1 = __uint_as_float(w.x & 0xffff0000u), r2 = __uint_as_float(w.y << 16), r3 = __uint_as_float(w.y & 0xffff0000u);
                const float r4 = __uint_as_float(w.z << 16), r5 = __uint_as_float(w.z & 0xffff0000u), r6 = __uint_as_float(w.w << 16), r7 = __uint_as_float(w.w & 0xffff0000u);
                ss += ((r0 * r0 + r1 * r1) + (r2 * r2 + r3 * r3)) + ((r4 * r4 + r5 * r5) + (r6 * r6 + r7 * r7)); }
            ss += __shfl_xor(ss, 16); ss += __shfl_xor(ss, 32); ssr[g] = ss;
#pragma unroll
            for (int bj = 0; bj < 2; ++bj) cur[bj] = nxt[bj];
            asm volatile("" ::: "memory"); }
        if (fq == 0) {
#pragma unroll
            for (int g = 0; g < 8; ++g) __hip_atomic_fetch_add(ss_next + row0 + (g >> 2) * HALF + (g & 3) * 16, (unsigned long long)(ssr[g] * 1048576.0f + 0.5f), __ATOMIC_RELAXED, __HIP_MEMORY_SCOPE_AGENT); }
    }
};

template <class Epi, class Sched, bool ALIGN_EPI = false, bool SP2 = false>
__device__ __forceinline__ void gemm_phase(PG8_LAS unsigned char* lds, const Gemm g, const Sched& S, const Epi& E) {
    const int tid = threadIdx.x, wid = __builtin_amdgcn_readfirstlane(tid >> 6), lane = tid & 63, wr = wid >> 2, wc = wid & 3, fr = lane & 15, fq = lane >> 4;
    const int K = g.K, nt = K / BK;
    unsigned voffA[2], voffB[2];
#pragma unroll
    for (int i = 0; i < 2; ++i) { int R, C; stage_rc(tid * 16 + i * 8192, R, C); const int Rb = Epi::PERM ? ((R & ~31) + perm32(R & 31)) : R;
        voffA[i] = (unsigned)(R * K + C) * 2u; voffB[i] = (unsigned)(Rb * K + C) * 2u; }
    const size_t kstep = (size_t)(BK * 2);
    const size_t hstep = (size_t)HALF * K * 2;
    const size_t tstep = 2 * hstep;
    const unsigned ldsw = (unsigned)wid * 1024u;
    const int aoff = lds_byte(wr * 64 + fr, fq * 8), boff = lds_byte(wc * 32 + fr, fq * 8);
#define PG8_SA(b, h) (((b) * 2 + (h)) * HTB)
#define PG8_SB(b, h) ((4 + (b) * 2 + (h)) * HTB)
#define PG8_STAGE(bufoff, gbase, voff) do { _Pragma("unroll") for (int _i = 0; _i < 2; ++_i) \
        __builtin_amdgcn_global_load_lds((const unsigned*)((const char*)(gbase) + (voff)[_i]), (PG8_LAS unsigned*)(lds + (bufoff) + ldsw + _i * 8192), 16, 0, 0); } while (0)
#define PG8_LDA(dst, b, h) do { _Pragma("unroll") for (int m = 0; m < 4; ++m) _Pragma("unroll") for (int k = 0; k < 2; ++k) dst[m][k] = *(const PG8_LAS bf16x8*)(lds + PG8_SA(b, h) + aoff + m * 2048 + k * 1024); } while (0)
#define PG8_LDB(dst, b, h) do { _Pragma("unroll") for (int n = 0; n < 2; ++n) _Pragma("unroll") for (int k = 0; k < 2; ++k) dst[n][k] = *(const PG8_LAS bf16x8*)(lds + PG8_SB(b, h) + boff + n * 2048 + k * 1024); } while (0)
#define PG8_MMA(ai, bj, At, Bt) do { __builtin_amdgcn_s_setprio(1); _Pragma("unroll") for (int m = 0; m < 4; ++m) _Pragma("unroll") for (int n = 0; n < 2; ++n) _Pragma("unroll") for (int k = 0; k < 2; ++k) \
        acc[ai][bj][m][n] = __builtin_amdgcn_mfma_f32_16x16x32_bf16(Bt[n][k], At[m][k], acc[ai][bj][m][n], 0, 0, 0); __builtin_amdgcn_s_setprio(0); } while (0)
#define PG8_WAIT_V(n) asm volatile("s_waitcnt vmcnt(" #n ")" ::: "memory")
#define PG8_WAIT_L(n) asm volatile("s_waitcnt lgkmcnt(" #n ")" ::: "memory")
#define PG8_BAR __builtin_amdgcn_s_barrier()
#define PG8_SCHED __builtin_amdgcn_sched_barrier(0)
    Unit cur, nxt; int ui = 0;
    if (!S.next(0, cur)) return;
    f32x4 acc[2][2][4][2];
#pragma unroll
    for (int a = 0; a < 2; ++a)
#pragma unroll
        for (int b = 0; b < 2; ++b)
#pragma unroll
            for (int m = 0; m < 4; ++m)
#pragma unroll
                for (int n = 0; n < 2; ++n) acc[a][b][m][n] = (f32x4){0.f, 0.f, 0.f, 0.f};
    bf16x8 At[4][2], B0[2][2], B1[2][2];
    const char* cA = (const char*)g.A + (size_t)cur.pm * tstep; const char* cB = (const char*)g.Bt + (size_t)cur.pn * tstep;
    S.a_ready(cur);
    if constexpr (SP2) {
        PG8_STAGE(PG8_SB(0, 0), cB, voffB); PG8_STAGE(PG8_SB(0, 1), cB + hstep, voffB); PG8_STAGE(PG8_SA(0, 0), cA, voffA); PG8_STAGE(PG8_SA(0, 1), cA + hstep, voffA);
        if (wr == 1) PG8_BAR;
        PG8_WAIT_V(2); PG8_BAR;
        PG8_STAGE(PG8_SB(1, 0), cB + kstep, voffB); PG8_STAGE(PG8_SA(1, 0), cA + kstep, voffA); PG8_STAGE(PG8_SB(1, 1), cB + hstep + kstep, voffB);
        PG8_WAIT_V(6); PG8_BAR;
    } else {
        PG8_STAGE(PG8_SB(0, 0), cB, voffB); PG8_STAGE(PG8_SA(0, 0), cA, voffA); PG8_STAGE(PG8_SB(0, 1), cB + hstep, voffB); PG8_STAGE(PG8_SA(0, 1), cA + hstep, voffA);
        if (wr == 1) PG8_BAR;
        PG8_WAIT_V(4); PG8_BAR;
        PG8_STAGE(PG8_SB(1, 0), cB + kstep, voffB); PG8_STAGE(PG8_SA(1, 0), cA + kstep, voffA); PG8_STAGE(PG8_SB(1, 1), cB + hstep + kstep, voffB);
        PG8_WAIT_V(6); PG8_BAR;
    }
    for (;;) {
        const bool has_next = S.next(ui + 1, nxt);
        const char* nA = has_next ? (const char*)g.A + (size_t)nxt.pm * tstep : cA; const char* nB = has_next ? (const char*)g.Bt + (size_t)nxt.pn * tstep : cB;
        asm volatile(".p2align 6");
        for (int t = 0; t < nt; t += 2) {
            const bool last = (t == nt - 2);
            const char* a1 = cA + (size_t)(t + 1) * kstep;
            const char* a2 = last ? nA : cA + (size_t)(t + 2) * kstep; const char* b2 = last ? nB : cB + (size_t)(t + 2) * kstep;
            const char* a3 = a2 + kstep; const char* b3 = b2 + kstep;
            if (last && has_next) S.a_ready(nxt);
            if constexpr (SP2) {
            PG8_LDB(B0, 0, 0); PG8_LDB(B1, 0, 1); PG8_SCHED; PG8_LDA(At, 0, 0); PG8_STAGE(PG8_SA(1, 1), a1 + hstep, voffA);
            PG8_WAIT_V(8); PG8_WAIT_L(0); PG8_BAR; PG8_MMA(0, 0, At, B0); PG8_MMA(0, 1, At, B1); PG8_BAR; PG8_SCHED;
            PG8_LDA(At, 0, 1); PG8_STAGE(PG8_SB(0, 0), b2, voffB); PG8_STAGE(PG8_SB(0, 1), b2 + hstep, voffB); PG8_STAGE(PG8_SA(0, 0), a2, voffA);
            PG8_WAIT_V(8); PG8_WAIT_L(0); PG8_BAR; PG8_MMA(1, 0, At, B0); PG8_MMA(1, 1, At, B1); PG8_BAR; PG8_SCHED;
            PG8_LDB(B0, 1, 0); PG8_LDB(B1, 1, 1); PG8_SCHED; PG8_LDA(At, 1, 0); PG8_STAGE(PG8_SA(0, 1), a2 + hstep, voffA);
            PG8_WAIT_V(8); PG8_WAIT_L(0); PG8_BAR; PG8_MMA(0, 0, At, B0); PG8_MMA(0, 1, At, B1); PG8_BAR; PG8_SCHED;
            PG8_LDA(At, 1, 1); PG8_STAGE(PG8_SB(1, 0), b3, voffB); PG8_STAGE(PG8_SB(1, 1), b3 + hstep, voffB); PG8_STAGE(PG8_SA(1, 0), a3, voffA);
            PG8_WAIT_V(8); PG8_WAIT_L(0); PG8_BAR; PG8_MMA(1, 0, At, B0); PG8_MMA(1, 1, At, B1); PG8_BAR; PG8_SCHED;
            } else {
            PG8_LDB(B0, 0, 0); PG8_SCHED; PG8_LDA(At, 0, 0); PG8_STAGE(PG8_SA(1, 1), a1 + hstep, voffA);
            PG8_WAIT_L(8); PG8_BAR; PG8_WAIT_L(0); PG8_MMA(0, 0, At, B0); PG8_BAR; PG8_SCHED;
            PG8_LDB(B1, 0, 1); PG8_STAGE(PG8_SB(0, 0), b2, voffB);
            PG8_BAR; PG8_WAIT_L(0); PG8_MMA(0, 1, At, B1); PG8_BAR;
            PG8_LDA(At, 0, 1); PG8_STAGE(PG8_SA(0, 0), a2, voffA);
            PG8_BAR; PG8_WAIT_L(0); PG8_MMA(1, 0, At, B0); PG8_BAR; PG8_SCHED;
            PG8_STAGE(PG8_SB(0, 1), b2 + hstep, voffB);
            PG8_WAIT_V(6); PG8_BAR; PG8_MMA(1, 1, At, B1); PG8_BAR;
            PG8_LDB(B0, 1, 0); PG8_SCHED; PG8_LDA(At, 1, 0); PG8_STAGE(PG8_SA(0, 1), a2 + hstep, voffA);
            PG8_WAIT_L(8); PG8_BAR; PG8_WAIT_L(0); PG8_MMA(0, 0, At, B0); PG8_BAR; PG8_SCHED;
            PG8_LDB(B1, 1, 1); PG8_STAGE(PG8_SB(1, 0), b3, voffB);
            PG8_BAR; PG8_WAIT_L(0); PG8_MMA(0, 1, At, B1); PG8_BAR;
            PG8_LDA(At, 1, 1); PG8_STAGE(PG8_SA(1, 0), a3, voffA);
            PG8_BAR; PG8_WAIT_L(0); PG8_MMA(1, 0, At, B0); PG8_BAR; PG8_SCHED;
            PG8_STAGE(PG8_SB(1, 1), b3 + hstep, voffB);
            PG8_WAIT_V(6); PG8_BAR; PG8_MMA(1, 1, At, B1); PG8_BAR;
            }
        }
        if constexpr (ALIGN_EPI) { if (wr == 0) PG8_BAR; }
        if constexpr (!Epi::AFTER_DRAIN) { E(acc, cur, wr, wc, fr, fq); S.done(cur); }
        if (!has_next) break;
#pragma unroll
        for (int a = 0; a < 2; ++a)
#pragma unroll
            for (int b = 0; b < 2; ++b)
#pragma unroll
                for (int m = 0; m < 4; ++m)
#pragma unroll
                    for (int n = 0; n < 2; ++n) acc[a][b][m][n] = (f32x4){0.f, 0.f, 0.f, 0.f};
        cur = nxt; cA = nA; cB = nB; ++ui;
        if constexpr (ALIGN_EPI) { if (wr == 1) PG8_BAR; }
    }
    PG8_WAIT_V(0);
    if constexpr (!ALIGN_EPI) { if (wr == 0) PG8_BAR; }
    PG8_BAR;
    if constexpr (Epi::AFTER_DRAIN) { E.fused(acc, cur, wr, wc, fr, fq, lds, wid, lane); S.done(cur); }
#undef PG8_SA
#undef PG8_SB
#undef PG8_STAGE
#undef PG8_LDA
#undef PG8_LDB
#undef PG8_MMA
#undef PG8_WAIT_V
#undef PG8_WAIT_L
#undef PG8_BAR
#undef PG8_SCHED
}
}
namespace fa {

constexpr int D = 128, LD = 4096;
constexpr float SCALE = 0.08838834764831845f;
constexpr float INV_SCALE = 11.313708498984761f;
constexpr float THR = 8.f;
constexpr bool WSKIP = false;
constexpr int NW = 8, QBLK = 32, KVBLK = 64, QB = NW * QBLK;
constexpr int SHM_V = KVBLK * D * 2, SHM_K = KVBLK * D * 2;
constexpr int LDS_BODY = 2 * SHM_V + 2 * SHM_K + NW * 64 * 4;
using bf16 = unsigned short;
typedef short bf16x8 __attribute__((ext_vector_type(8)));
typedef short s16x4 __attribute__((ext_vector_type(4)));
typedef float f32x16 __attribute__((ext_vector_type(16)));
typedef float f32x4 __attribute__((ext_vector_type(4)));
typedef unsigned u32x4 __attribute__((ext_vector_type(4)));
template <class A, class Bt> struct same_t { static constexpr bool v = false; };
template <class A> struct same_t<A, A> { static constexpr bool v = true; };

#define KSWZ(row, colB) ((row) * 256 + ((colB) ^ (((row) & 7) << 4)))
#define SBAR() __builtin_amdgcn_sched_barrier(0)
__device__ __forceinline__ int v_st(int k, int c) { const int kk = (k & ~0xC) | ((k & 4) << 1) | ((k & 8) >> 1); return ((kk >> 3) * 4 + (c >> 5)) * 512 + ((kk & 7) * 32 + (c & 31)) * 2; }
__device__ __forceinline__ int v_rd_base(int lane) { return ((lane & 3) << 3) | (((lane >> 2) & 3) << 6) | (((lane >> 4) & 1) << 5) | (((lane >> 5) & 1) << 8); }
constexpr int v_rd_off(int d0, int ks, int half) { return d0 * 512 + ks * 4096 + half * 2048; }
__device__ __forceinline__ int crow(int r, int hi) { return (r & 3) + 8 * (r >> 2) + 4 * hi; }
__device__ __forceinline__ unsigned cvtpk(float lo, float hi) {
    unsigned r; asm volatile("v_cvt_pk_bf16_f32 %0, %1, %2" : "=v"(r) : "v"(lo), "v"(hi)); return r;
}
__device__ __forceinline__ bf16x8 pack8(f32x4 a, f32x4 b) {
    u32x4 w = {cvtpk(a[0], a[1]), cvtpk(a[2], a[3]), cvtpk(b[0], b[1]), cvtpk(b[2], b[3])};
    return *reinterpret_cast<bf16x8*>(&w);
}
template <class T> __device__ __forceinline__ bf16x8 load8(const T* p) {
    if constexpr (same_t<T, float>::v) { return pack8(*(const f32x4*)p, *(const f32x4*)(p + 4)); }
    else { return *reinterpret_cast<const bf16x8*>(p); }
}
__device__ __forceinline__ void mask_tile(f32x16& p0, f32x16& p1, int dq, unsigned W) {
    const float NEG = -__builtin_inff();
#pragma unroll
    for (int r = 0; r < 16; ++r) {
        const int c = (r & 3) + 8 * (r >> 2);
        if ((unsigned)(dq - c) >= W) p0[r] = NEG;
        if ((unsigned)(dq - c - 32) >= W) p1[r] = NEG;
    }
}
__device__ __forceinline__ void partialSM(f32x16& p0, f32x16& p1, float& m_reg, float& mn, float& alpha) {
    float pmax = p0[0]; for (int r = 1; r < 16; ++r) pmax = fmaxf(pmax, p0[r]); for (int r = 0; r < 16; ++r) pmax = fmaxf(pmax, p1[r]);
    { auto rr = __builtin_amdgcn_permlane32_swap(__float_as_uint(pmax), __float_as_uint(pmax), false, false);
      pmax = fmaxf(__uint_as_float(rr[0]), __uint_as_float(rr[1])); }
    constexpr float C2 = 1.4426950408889634f * SCALE;
    if (__builtin_expect(__all((pmax - m_reg) * SCALE <= THR), 1)) { mn = m_reg; alpha = 1.f; }
    else { mn = fmaxf(m_reg, pmax); alpha = __builtin_amdgcn_exp2f((m_reg - mn) * C2); m_reg = mn; }
    const float mnL = -mn * C2;
    for (int r = 0; r < 16; ++r) p0[r] = fmaf(p0[r], C2, mnL); for (int r = 0; r < 16; ++r) p1[r] = fmaf(p1[r], C2, mnL);
    for (int r = 0; r < 16; ++r) p0[r] = __builtin_amdgcn_exp2f(p0[r]);
}
__device__ __forceinline__ void finishSM(f32x16& p0, f32x16& p1, float alpha, float& l_reg, bf16x8& pa0, bf16x8& pa1, bf16x8& pa2, bf16x8& pa3) {
    for (int r = 0; r < 16; ++r) p1[r] = __builtin_amdgcn_exp2f(p1[r]);
    float ps = 0; for (int r = 0; r < 16; ++r) ps += p0[r]; for (int r = 0; r < 16; ++r) ps += p1[r];
    { auto rr = __builtin_amdgcn_permlane32_swap(__float_as_uint(ps), __float_as_uint(ps), false, false);
      ps = __uint_as_float(rr[0]) + __uint_as_float(rr[1]); }
    l_reg = l_reg * alpha + ps;
#define PK4(P, B_, OUT) do { unsigned a0 = cvtpk(P[B_+0], P[B_+1]), a1 = cvtpk(P[B_+2], P[B_+3]);                          \
        unsigned b0 = cvtpk(P[B_+4], P[B_+5]), b1 = cvtpk(P[B_+6], P[B_+7]);                                             \
        auto r0 = __builtin_amdgcn_permlane32_swap(a0, b0, false, false); auto r1 = __builtin_amdgcn_permlane32_swap(a1, b1, false, false); \
        u32x4 w = {r0[0], r1[0], r0[1], r1[1]}; OUT = *reinterpret_cast<bf16x8*>(&w); } while (0)
    PK4(p0, 0, pa0); PK4(p0, 8, pa1); PK4(p1, 0, pa2); PK4(p1, 8, pa3);
#undef PK4
}
template <int KB, bool SK>
__device__ __forceinline__ void qkt(f32x16& p0, f32x16& p1, const char* K_lds, int r32, int hi, const bf16x8* qr, bool act, const __attribute__((address_space(3))) float* fk, float ft) {
    if (SK && !act) { const float NEG = -__builtin_inff();
#pragma unroll
        for (int r = 0; r < 16; ++r) { p0[r] = NEG; p1[r] = NEG; } return; }
#pragma unroll
    for (int g = 0; g < 4; ++g) { const f32x4 a = *(const __attribute__((address_space(3))) f32x4*)(fk + 8 * g), b = *(const __attribute__((address_space(3))) f32x4*)(fk + 32 + 8 * g);
#pragma unroll
        for (int i = 0; i < 4; ++i) { p0[4 * g + i] = ft - a[i]; p1[4 * g + i] = ft - b[i]; } }
    const char* kb[4];
#pragma unroll
    for (int dd = 0; dd < 4; ++dd) kb[dd] = K_lds + KB * SHM_K + KSWZ(r32, (dd * 16 + hi * 8) * 2);
#pragma unroll
    for (int d0 = 0; d0 < 8; ++d0) { const char* a = kb[d0 & 3] + (d0 >> 2) * 128;
        bf16x8 b0 = *reinterpret_cast<const bf16x8*>(a);
        bf16x8 b1 = *reinterpret_cast<const bf16x8*>(a + 32 * 256);
        p0 = __builtin_amdgcn_mfma_f32_32x32x16_bf16(b0, qr[d0], p0, 0, 0, 0);
        p1 = __builtin_amdgcn_mfma_f32_32x32x16_bf16(b1, qr[d0], p1, 0, 0, 0); }
}
template <int VB, bool SK>
__device__ __forceinline__ void pv_tile(f32x16* o, int vb0, bf16x8 pa0, bf16x8 pa1, bf16x8 pa2, bf16x8 pa3, bool act) {
    if (SK && !act) return;
#define TRRD(dst, off) asm volatile("ds_read_b64_tr_b16 %0, %1 offset:%2" : "=&v"(dst) : "v"(vb0), "i"(off) : "memory")
#define PV_D0(d0) do { s16x4 l0, l1, l2, l3, h0, h1, h2, h3; constexpr int b_ = VB * SHM_V + v_rd_off(d0, 0, 0);     \
        TRRD(l0, b_); TRRD(h0, b_ + 2048); TRRD(l1, b_ + 4096); TRRD(h1, b_ + 6144); TRRD(l2, b_ + 8192); TRRD(h2, b_ + 10240); TRRD(l3, b_ + 12288); TRRD(h3, b_ + 14336); \
        asm volatile("s_waitcnt lgkmcnt(0)" ::: "memory"); SBAR();                 \
        o[d0] = __builtin_amdgcn_mfma_f32_32x32x16_bf16(pa0, (bf16x8){l0[0], l0[1], l0[2], l0[3], h0[0], h0[1], h0[2], h0[3]}, o[d0], 0, 0, 0);   \
        o[d0] = __builtin_amdgcn_mfma_f32_32x32x16_bf16(pa1, (bf16x8){l1[0], l1[1], l1[2], l1[3], h1[0], h1[1], h1[2], h1[3]}, o[d0], 0, 0, 0);   \
        o[d0] = __builtin_amdgcn_mfma_f32_32x32x16_bf16(pa2, (bf16x8){l2[0], l2[1], l2[2], l2[3], h2[0], h2[1], h2[2], h2[3]}, o[d0], 0, 0, 0);   \
        o[d0] = __builtin_amdgcn_mfma_f32_32x32x16_bf16(pa3, (bf16x8){l3[0], l3[1], l3[2], l3[3], h3[0], h3[1], h3[2], h3[3]}, o[d0], 0, 0, 0); } while (0)
    PV_D0(0); PV_D0(1); PV_D0(2); PV_D0(3);
#undef PV_D0
#undef TRRD
}

constexpr size_t V_OFF = (size_t)16384 * 4096, Z_OFF = 3 * V_OFF, O_OFF = 4 * V_OFF;
template <class TIn, class TOut> struct BlockRef { const TIn* Q; const TIn* K; int P0; int JLO; };
template <class TIn> struct Seam {
    bf16x8 qr[8];
    bf16x8 st_v0, st_v1, st_k0, st_k1; f32x4 sf0, sf1, sf2, sf3;
    f32x4 tq[16];
};
__device__ __forceinline__ int swa_jlo(int P0, int W) { const int lowk = P0 - W + 1; return lowk > 0 ? lowk / KVBLK : 0; }
#define ROW(p, k0, rr) ((p) + (size_t)((k0) + (rr)) * LD + sc)
#define VMW() asm volatile("s_waitcnt vmcnt(0)" ::: "memory")
#define VMWN(n) asm volatile("s_waitcnt vmcnt(%0)" :: "i"(n) : "memory")
#define SLOAD_H(Kp, Vp, k0) do { S.st_v0 = load8<TIn>(ROW(Vp, k0, sr)); S.st_v1 = load8<TIn>(ROW(Vp, k0, 32 + sr));              \
                         S.st_k0 = load8<TIn>(ROW(Kp, k0, sr)); S.st_k1 = load8<TIn>(ROW(Kp, k0, 32 + sr)); } while (0)
#define SWRITE_HK(bf) do { *(bf16x8*)(K_lds + (bf) * SHM_K + kws) = S.st_k0; *(bf16x8*)(K_lds + (bf) * SHM_K + kws + 32 * 256) = S.st_k1; } while (0)
#define SWRITE_HV(bf) do { *(bf16x8*)(V_lds + (bf) * SHM_V + vst0) = S.st_v0; *(bf16x8*)(V_lds + (bf) * SHM_V + vst1) = S.st_v1; } while (0)
#define SWRITE_H(bf) do { SWRITE_HV(bf); SWRITE_HK(bf); } while (0)
#define SLOAD_F(p, k0) do { S.sf0 = *(const f32x4*)ROW(p, k0, sr); S.sf1 = *(const f32x4*)(ROW(p, k0, sr) + 4);                \
                            S.sf2 = *(const f32x4*)ROW(p, k0, 32 + sr); S.sf3 = *(const f32x4*)(ROW(p, k0, 32 + sr) + 4); } while (0)
#define SWRITE_KF(bf) do { *(bf16x8*)(K_lds + (bf) * SHM_K + kws) = pack8(S.sf0, S.sf1); *(bf16x8*)(K_lds + (bf) * SHM_K + kws + 32 * 256) = pack8(S.sf2, S.sf3); } while (0)
#define SWRITE_VF(bf) do { *(bf16x8*)(V_lds + (bf) * SHM_V + vst0) = pack8(S.sf0, S.sf1); *(bf16x8*)(V_lds + (bf) * SHM_V + vst1) = pack8(S.sf2, S.sf3); } while (0)
template <class TIn, class TOut>
__device__ __forceinline__ void causal_swa_prime(const BlockRef<TIn, TOut>& cur, int W, char* lds, Seam<TIn>& S) {
    constexpr bool F32 = same_t<TIn, float>::v;
    const int tid = threadIdx.x, wid = __builtin_amdgcn_readfirstlane(tid >> 6), lane = tid & 63, r32 = lane & 31, hi = lane >> 5;
    const int sr = tid >> 4, sc = (tid & 15) * 8, kws = KSWZ(sr, sc * 2); char* K_lds = lds + 2 * SHM_V;
    const int kb0 = ((cur.P0 + QB - 1) / KVBLK) * KVBLK;
    for (int d0 = 0; d0 < 8; ++d0) S.qr[d0] = load8<TIn>(cur.Q + (size_t)(wid * QBLK + r32) * LD + d0 * 16 + hi * 8);
    if constexpr (F32) { SLOAD_F((const float*)cur.K, kb0); VMW(); SWRITE_KF(0); SBAR(); SLOAD_F((const float*)(cur.K + V_OFF), kb0); }
    else { SLOAD_H(cur.K, (cur.K + V_OFF), kb0); VMW(); SWRITE_HK(0); }
    __syncthreads();
}
template <class TIn, class TOut>
__device__ __forceinline__ void causal_swa_reprime(const BlockRef<TIn, TOut>& cur, char* lds, Seam<TIn>& S) {
    const int tid = threadIdx.x;
    const int sr = tid >> 4, sc = (tid & 15) * 8, kws = KSWZ(sr, sc * 2); char* K_lds = lds + 2 * SHM_V;
    const int kb0 = ((cur.P0 + QB - 1) / KVBLK) * KVBLK;
    SLOAD_H(cur.K, (cur.K + V_OFF), kb0); VMW(); SWRITE_HK(0);
    __syncthreads();
}
template <class TIn, class TOut>
__device__ __forceinline__ void causal_swa_block(const BlockRef<TIn, TOut>& cur, const BlockRef<TIn, TOut>& nxt, int skv, int W, char* lds, Seam<TIn>& S, const __attribute__((address_space(3))) float* fabs_l) {
    constexpr bool F32 = same_t<TIn, float>::v;
    const int tid = threadIdx.x, wid = __builtin_amdgcn_readfirstlane(tid >> 6), lane = tid & 63, r32 = lane & 31, hi = lane >> 5;
    const int j_lo = cur.JLO;
    int j_hi = (cur.P0 + QB - 1) / KVBLK + 1; if (j_hi > skv / KVBLK) j_hi = skv / KVBLK;
    const int NT = j_hi - j_lo;
    const int kbn = ((nxt.P0 + QB - 1) / KVBLK) * KVBLK;
    const int qlo = cur.P0 + wid * QBLK, qm = qlo + r32 - 4 * hi;
    const float ft = __int_as_float(__builtin_amdgcn_readfirstlane(__float_as_int(fabs_l[qlo])));
#define FK(t) (fabs_l + KBASE(t) + 4 * hi)
    char* V_lds = lds; char* K_lds = lds + 2 * SHM_V;
    float* ws = (float*)(lds + 2 * SHM_V + 2 * SHM_K) + wid * 64; float* li_l = ws, * al_l = ws + 32;
    float m_reg = -1e30f, l_reg = 0; f32x16 o[4] = {};
    if (wid >= 4) __builtin_amdgcn_s_setprio(1);
    const int sr = tid >> 4, sc = (tid & 15) * 8, vst0 = v_st(sr, sc), vst1 = v_st(32 + sr, sc), kws = KSWZ(sr, sc * 2);
    const int vb0 = (int)(uintptr_t)V_lds + v_rd_base(lane);
    const TIn* Kh = cur.K; const TIn* Vh = (cur.K + V_OFF);
#define RESC(a) do { if (__any((a) < 1.f)) { if (hi == 0) al_l[r32] = (a); asm volatile("s_waitcnt lgkmcnt(0)" ::: "memory");              \
                     for (int d_ = 0; d_ < 4; ++d_) for (int r = 0; r < 16; ++r) o[d_][r] *= al_l[crow(r, hi)]; } } while (0)
#define KBASE(t) ((j_hi - 1 - (t)) * KVBLK)
#define ACT(t) (KBASE(t) <= qlo + QBLK - 1 && KBASE(t) + KVBLK - 1 >= qlo - W + 1)
#define MASKT(P0_, P1_, t) do { const int kb_ = KBASE(t); if ((!SK || ACT(t)) && (kb_ + KVBLK - 1 > qlo || kb_ <= qlo + QBLK - 1 - W)) mask_tile(P0_, P1_, qm - kb_, (unsigned)W); } while (0)
    constexpr int NQL = F32 ? 16 : 8;
    constexpr bool SK = WSKIP && !F32;
#define SEAM_K0() do { VMWN(NQL); if constexpr (F32) { SWRITE_KF(0); SBAR(); SLOAD_F((const float*)(nxt.K + V_OFF), kbn); } else { SWRITE_HK(0); } SBAR(); } while (0)
    f32x16 pA0, pA1, pB0, pB1; float mnA, mnB, alA, alB; bf16x8 pa0, pa1, pa2, pa3;
    if constexpr (F32) { VMW(); SWRITE_VF(0); SBAR(); } else { SWRITE_HV(0); SBAR(); }
    if (NT > 1) { if constexpr (F32) SLOAD_F((const float*)Kh, KBASE(1)); else SLOAD_H(Kh, Vh, KBASE(1)); }
    SBAR(); qkt<0, SK>(pA0, pA1, K_lds, r32, hi, S.qr, ACT(0), FK(0), ft);
    if constexpr (F32) { if (NT > 1) { VMW(); SWRITE_KF(1); SBAR(); SLOAD_F((const float*)Vh, KBASE(1)); } }
    MASKT(pA0, pA1, 0); partialSM(pA0, pA1, m_reg, mnA, alA);
    if (NT > 1) { VMW(); if constexpr (F32) { SWRITE_VF(1); SBAR(); if (NT > 2) SLOAD_F((const float*)Kh, KBASE(2)); } else SWRITE_H(1); }
    __syncthreads();
#define HALF_STEP(PX0, PX1, mnX, alX, PY0, PY1, alY, t, KB, VB, SB) do {                                                      \
        SBAR(); qkt<KB, SK>(PX0, PX1, K_lds, r32, hi, S.qr, ACT(t), FK(t), ft);                                             \
        finishSM(PY0, PY1, alY, l_reg, pa0, pa1, pa2, pa3); SBAR();                                                           \
        if ((t) + 1 < NT) { if constexpr (F32) { VMW(); SWRITE_KF(SB); SBAR(); SLOAD_F((const float*)Vh, KBASE((t) + 1)); }  \
                            else { SLOAD_H(Kh, Vh, KBASE((t) + 1)); } SBAR(); }                                               \
        pv_tile<VB, SK>(o, vb0, pa0, pa1, pa2, pa3, ACT((t) - 1)); MASKT(PX0, PX1, (t)); partialSM(PX0, PX1, m_reg, mnX, alX);                                        \
        __syncthreads();                                                                                                      \
        if ((t) + 1 < NT) { VMW(); if constexpr (F32) { SWRITE_VF(SB); SBAR(); if ((t) + 2 < NT) SLOAD_F((const float*)Kh, KBASE((t) + 2)); } \
                            else { SWRITE_H(SB); } }                                                                          \
        RESC(alX); __syncthreads(); } while (0)
    asm volatile(".p2align 6");
    for (int t = 1; t + 1 < NT; t += 2) {
        HALF_STEP(pB0, pB1, mnB, alB, pA0, pA1, alA, t, 1, 0, 0);
        HALF_STEP(pA0, pA1, mnA, alA, pB0, pB1, alB, t + 1, 0, 1, 1);
    }
    const bool even = (NT & 1) == 0;
    if (even) { SBAR(); qkt<1, SK>(pB0, pB1, K_lds, r32, hi, S.qr, ACT(NT - 1), FK(NT - 1), ft); SBAR(); }
#define QROW(e) (nxt.Q + (size_t)(wid * QBLK + r32) * D + ((e) >> 1) * 16 + hi * 8 + ((e) & 1) * 4)
    if constexpr (F32) { SLOAD_F((const float*)nxt.K, kbn); SBAR();
#pragma unroll
        for (int e = 0; e < 8; ++e) S.tq[e] = *(const f32x4*)QROW(e); }
    else { SLOAD_H(nxt.K, (nxt.K + V_OFF), kbn); SBAR();
#pragma unroll
        for (int d0 = 0; d0 < 8; ++d0) S.qr[d0] = load8<TIn>(nxt.Q + (size_t)(wid * QBLK + r32) * LD + d0 * 16 + hi * 8); }
    SBAR();
    finishSM(pA0, pA1, alA, l_reg, pa0, pa1, pa2, pa3); SBAR();
    if constexpr (F32) {
#pragma unroll
        for (int e = 8; e < 16; ++e) S.tq[e] = *(const f32x4*)QROW(e); SBAR(); }
#undef QROW
    pv_tile<0, SK>(o, vb0, pa0, pa1, pa2, pa3, ACT(even ? NT - 2 : NT - 1));
    if (even) { MASKT(pB0, pB1, NT - 1); partialSM(pB0, pB1, m_reg, mnB, alB); __syncthreads(); RESC(alB);
        finishSM(pB0, pB1, alB, l_reg, pa0, pa1, pa2, pa3); SBAR(); pv_tile<1, SK>(o, vb0, pa0, pa1, pa2, pa3, ACT(NT - 1)); }
    SBAR(); SEAM_K0();
    if (hi == 0) li_l[r32] = l_reg; asm volatile("s_waitcnt lgkmcnt(0)" ::: "memory");
    float rli[16];
#pragma unroll
    for (int r = 0; r < 16; ++r) rli[r] = __builtin_amdgcn_rcpf(li_l[crow(r, hi)]);
    unsigned loff = (unsigned)((4 * hi) * LD + r32) * 2u; asm volatile("" : "+v"(loff));
    char* Ow = (char*)((TOut*)cur.Q + O_OFF + (size_t)(wid * QBLK) * LD); const char* Zw = (const char*)(cur.Q + Z_OFF + (size_t)(wid * QBLK) * LD);
    unsigned yw[16][4];
#pragma unroll
    for (int r = 0; r < 16; ++r) { const size_t roff = (size_t)((r & 3) + 8 * (r >> 2)) * LD * 2;
#pragma unroll
        for (int d0 = 0; d0 < 4; ++d0) yw[r][d0] = *(const unsigned short*)(Zw + roff + d0 * 64 + loff); }
#pragma unroll
    for (int r = 0; r < 16; ++r) {
#pragma unroll
        for (int d0 = 0; d0 < 4; ++d0) { const float z = __uint_as_float(yw[r][d0] << 16);
            const float y = o[d0][r] * rli[r] * z * __builtin_amdgcn_rcpf(1.f + __expf(-z));
            const float yn = __shfl_xor(y, 1);
            yw[r][d0] = cvtpk(y, yn); } }
    if ((r32 & 1) == 0) {
#pragma unroll
        for (int r = 0; r < 16; ++r) { const size_t roff = (size_t)((r & 3) + 8 * (r >> 2)) * LD * 2;
#pragma unroll
            for (int d0 = 0; d0 < 4; ++d0) *(unsigned*)(Ow + roff + d0 * 64 + loff) = yw[r][d0]; } }
    if constexpr (F32) {
#pragma unroll
        for (int d0 = 0; d0 < 8; ++d0) S.qr[d0] = pack8(S.tq[2 * d0], S.tq[2 * d0 + 1]); }
    if (wid >= 4) __builtin_amdgcn_s_setprio(0);
    __syncthreads();
#undef RESC
#undef FK
#undef KBASE
#undef ACT
#undef MASKT
#undef SEAM_K0
#undef HALF_STEP
}
#undef ROW
#undef VMW
#undef VMWN
#undef SLOAD_H
#undef SWRITE_HK
#undef SWRITE_HV
#undef SWRITE_H
#undef SLOAD_F
#undef SWRITE_KF
#undef SWRITE_VF


}

#define GAS __attribute__((address_space(1)))
#define LAS __attribute__((address_space(3)))
typedef unsigned short bf16;
typedef unsigned v4u __attribute__((ext_vector_type(4)));
typedef unsigned v2u __attribute__((ext_vector_type(2)));
typedef float f32x4 __attribute__((ext_vector_type(4)));
typedef short bf16x8 __attribute__((ext_vector_type(8)));
typedef unsigned short u16x4 __attribute__((ext_vector_type(4)));
typedef float f32x2v __attribute__((ext_vector_type(2)));

constexpr int SEQ = 16384, DM = 4096;
constexpr int NLAYERS = 4;
constexpr int NWAVES = 8, NTHR = 512;
constexpr int LDS_BYTES = 147456;
constexpr int LDS_CTL = LDS_BYTES - 256;

constexpr size_t MiB = 1u << 20;
constexpr size_t WS_CTL = 0, CTL_ZERO_BYTES = 2 * MiB;
constexpr size_t WS_NRM = 1 * MiB;
constexpr size_t WS_QCNT = 1 * MiB + 65536;
constexpr size_t WS_ROWSS = 65536;
constexpr size_t WS_WFI0 = 2 * MiB, WS_WFI1 = 130 * MiB, WS_WFO0 = 258 * MiB, WS_WFO1 = 290 * MiB;
constexpr size_t WS_WLI = 322 * MiB, WS_WLO = 386 * MiB, WS_WMI = 418 * MiB, WS_WMO = 546 * MiB;
constexpr size_t WS_WFF0 = 578 * MiB, WS_WFF1 = WS_WFF0 + 256 * 1024, WS_WMG = WS_WFF0 + 512 * 1024, WS_WLA = 579 * MiB, WS_WLX = 581 * MiB;
constexpr size_t WS_HB = 584 * MiB;
constexpr size_t WS_P0 = 712 * MiB, WS_PSTRIDE = 128 * MiB;
constexpr size_t WS_Y = 1224 * MiB;
constexpr size_t WS_QP = 1352 * MiB, WS_KT = 1416 * MiB, WS_VT = 1480 * MiB, WS_NINT = 1608 * MiB;
constexpr size_t WS_FLOC = 1736 * MiB, WS_FTOT = 1738 * MiB, WS_CA = 1739 * MiB, WS_CB = WS_CA + 256 * 1024;
constexpr size_t WS_IG = 1740 * MiB, WS_LF = WS_IG + 512 * 1024, WS_W1 = 1741 * MiB, WS_W2 = WS_W1 + 512 * 1024, WS_WK = 1742 * MiB, WS_EROW = WS_WK + 512 * 1024;
constexpr size_t WS_BC = 1743 * MiB, WS_IGB = WS_BC + 512 * 1024, WS_DMAX = 1744 * MiB, WS_DENI = WS_DMAX + 512 * 1024, WS_DEC = 1745 * MiB;
constexpr size_t WS_END = 1746 * MiB;

__device__ __forceinline__ float bf2f(unsigned short b) { return __uint_as_float((unsigned)b << 16); }
__device__ __forceinline__ unsigned pk2(float lo, float hi) { return pg8::cvt_pk_bf16(lo, hi); }
__device__ __forceinline__ float sigmoidf_(float x) { return __builtin_amdgcn_rcpf(1.f + __expf(-x)); }
__device__ __forceinline__ float logsigmoidf_(float x) { return fminf(x, 0.f) - log1pf(__expf(-fabsf(x))); }
#define LDS_WAIT() asm volatile("s_waitcnt lgkmcnt(0)" ::: "memory")
#define VM_WAIT() asm volatile("s_waitcnt vmcnt(0)" ::: "memory")
#define MFMA16(a, b, c) __builtin_amdgcn_mfma_f32_16x16x32_bf16(a, b, c, 0, 0, 0)

#define XB_TMO      128
#define XB_XCNT(j)  (256  + 64 * (j))
#define XB_XSUB(j)  (1280 + 64 * (j))
#define XB_XGEN(j)  (2304 + 64 * (j))
#define XB_TOP      3328
#define XB_TOPGEN   3392
#define XCD_BAR_WORDS 3456
#define XB_SPIN_CAP (1u << 18)

__device__ __forceinline__ unsigned xb_ld(unsigned* p)              { return __hip_atomic_load(p, __ATOMIC_RELAXED, __HIP_MEMORY_SCOPE_AGENT); }
__device__ __forceinline__ unsigned xb_add(unsigned* p, unsigned v) { return __hip_atomic_fetch_add(p, v, __ATOMIC_RELAXED, __HIP_MEMORY_SCOPE_AGENT); }
__device__ __forceinline__ unsigned xb_xcc_id() { return (unsigned)__builtin_amdgcn_s_getreg((3 << 11) | 20) & 0xFu; }
#define XB_SPIN(cond, bar) do { unsigned _sp = 0; while (cond) { __builtin_amdgcn_s_sleep(1); \
    if ((++_sp & 255u) == 0u) { if (xb_ld(&(bar)[XB_TMO])) break; if (_sp > XB_SPIN_CAP) { atomicAdd(&(bar)[XB_TMO], 1u); break; } } } } while (0)

struct XcdBarrier {
    unsigned* bar; unsigned x;
    volatile LAS unsigned* st;
};
__device__ __forceinline__ XcdBarrier xcd_barrier_post(unsigned* bar, volatile LAS unsigned* st) {
    XcdBarrier b; b.bar = bar; b.x = xb_xcc_id(); b.st = st;
    if (threadIdx.x == 0) (void)xb_add(&bar[XB_XCNT(b.x)], 1u);
    return b;
}
__device__ __forceinline__ void xcd_barrier_complete(unsigned* bar, unsigned x, unsigned& nloc, unsigned& nx) {
    const unsigned G = gridDim.x * gridDim.y * gridDim.z;
    unsigned sum, cnt, mine, sp = 0u;
    for (;;) {
        sum = 0u; cnt = 0u; mine = 0u;
#pragma unroll
        for (unsigned j = 0; j < 16; ++j) { const unsigned c = xb_ld(&bar[XB_XCNT(j)]); sum += c; cnt += (c > 0u) ? 1u : 0u; mine = (j == x) ? c : mine; }
        if (sum == G) break;
        __builtin_amdgcn_s_sleep(1);
        if ((++sp & 255u) == 0u) { if (xb_ld(&bar[XB_TMO])) break; if (sp > XB_SPIN_CAP) { atomicAdd(&bar[XB_TMO], 1u); break; } }
    }
    nloc = mine > 0u ? mine : 1u; nx = cnt > 0u ? cnt : 1u;
}
__device__ __forceinline__ void xcd_barrier(const XcdBarrier& b) {
    asm volatile("s_waitcnt vmcnt(0)" ::: "memory");
    __syncthreads();
    if (threadIdx.x == 0) {
        unsigned* bar = b.bar;
        __builtin_amdgcn_s_waitcnt(0);
        unsigned nloc = b.st[0], nx = b.st[1];
        if (nloc == 0u) { xcd_barrier_complete(bar, b.x, nloc, nx); b.st[0] = nloc; b.st[1] = nx; }
        const unsigned old = xb_add(&bar[XB_XSUB(b.x)], 1u);
        const unsigned gen = old / nloc;
        if (old + 1u == (gen + 1u) * nloc) {
            __builtin_amdgcn_fence(__ATOMIC_RELEASE, "agent");
            asm volatile("s_waitcnt vmcnt(0)" ::: "memory");
            const unsigned og = xb_add(&bar[XB_TOP], 1u);
            const unsigned tg = og / nx;
            if (og + 1u == (tg + 1u) * nx) xb_add(&bar[XB_TOPGEN], 1u);
            else XB_SPIN(xb_ld(&bar[XB_TOPGEN]) == tg, bar);
            __builtin_amdgcn_fence(__ATOMIC_ACQUIRE, "agent");
            xb_add(&bar[XB_XGEN(b.x)], 1u);
            asm volatile("s_waitcnt vmcnt(0)" ::: "memory");
        } else {
            XB_SPIN(xb_ld(&bar[XB_XGEN(b.x)]) == gen, bar);
            __builtin_amdgcn_fence(__ATOMIC_ACQUIRE, "agent");
            asm volatile("s_waitcnt vmcnt(0)" ::: "memory");
        }
    }
    __syncthreads();
}

struct Params { const float* in[19]; float* out; unsigned char* ws; int ph_lo, ph_hi; };
#define CAS __attribute__((address_space(4)))
__device__ __forceinline__ const float* late_in(int k) { const CAS char* ka = (const CAS char*)__builtin_amdgcn_kernarg_segment_ptr(); asm volatile("" : "+s"(ka));
    return *(const float* const CAS*)(ka + 8 * k); }
__device__ __forceinline__ float* late_out() { const CAS char* ka = (const CAS char*)__builtin_amdgcn_kernarg_segment_ptr(); asm volatile("" : "+s"(ka));
    return *(float* const CAS*)(ka + 8 * 19); }

struct TrSeg { const float* W; int ldn, col0, ncb; bf16* WT; int K; const LAS float* gain; };
__device__ __forceinline__ void tr_load(const TrSeg& s, int item, int lane, float (&v)[32]) {
    const int kb = item / s.ncb, nb = item - kb * s.ncb, k0 = 64 * kb, n0 = 32 * nb;
    const float* src = s.W + (size_t)(k0 + (lane >> 5)) * s.ldn + s.col0 + n0 + (lane & 31);
#pragma unroll
    for (int i = 0; i < 32; ++i) v[i] = src[(size_t)(2 * i) * s.ldn];
}
__device__ __forceinline__ void tr_store(const TrSeg& s, int item, int lane, const float (&v)[32], LAS float* scr) {
    const int kb = item / s.ncb, nb = item - kb * s.ncb, k0 = 64 * kb, n0 = 32 * nb;
#pragma unroll
    for (int i = 0; i < 32; ++i) { const int kk = 2 * i + (lane >> 5); const float g = s.gain ? s.gain[k0 + kk] : 1.f; scr[kk * 33 + (lane & 31)] = v[i] * g; }
    LDS_WAIT(); asm volatile("" ::: "memory");
    const int c = lane & 7;
#pragma unroll
    for (int j = 0; j < 4; ++j) { const int n = (lane >> 3) + 8 * j; const LAS float* p = scr + (8 * c) * 33 + n;
        v4u o; o.x = pk2(p[0 * 33], p[1 * 33]); o.y = pk2(p[2 * 33], p[3 * 33]); o.z = pk2(p[4 * 33], p[5 * 33]); o.w = pk2(p[6 * 33], p[7 * 33]);
        *(v4u*)(s.WT + (size_t)(n0 + n) * s.K + k0 + 8 * c) = o; }
    LDS_WAIT(); asm volatile("" ::: "memory");
}
__device__ __forceinline__ float wave_sum(float v) {
#pragma unroll
    for (int o = 1; o < 64; o <<= 1) v += __shfl_xor(v, o);
    return v;
}
__device__ __forceinline__ void p0_prologue(const Params& p, LAS unsigned char* lds, int tid) {
    const int lane = tid & 63, wave = __builtin_amdgcn_readfirstlane(tid >> 6);
    LAS float* scr = (LAS float*)(lds + wave * 8448);
    LAS float* GL = (LAS float*)(lds + 69632);
    for (int i = tid; i < 4 * 4096; i += NTHR) GL[i] = p.in[1][i];
    __syncthreads();
    const int gw = blockIdx.x * NWAVES + wave, NGW = gridDim.x * NWAVES;
    unsigned char* ws = p.ws;
    const LAS float* ng = GL;
    int rot_ = 0;
#define SEG(Wp, ldn_, col0_, ncols, dst, K_, gain_) do { TrSeg sg_; sg_.W = (Wp); sg_.ldn = (ldn_); sg_.col0 = (col0_); sg_.ncb = (ncols) / 32; sg_.WT = (dst); sg_.K = (K_); sg_.gain = (gain_); \
        const int nit_ = ((K_) / 64) * sg_.ncb; float va_[32], vb_[32]; int it = gw - rot_; if (it < 0) it += NGW; rot_ = (rot_ + nit_) % NGW;     \
        if (it < nit_) tr_load(sg_, it, lane, va_); \
        for (; it < nit_; it += 2 * NGW) { const bool nx_ = it + NGW < nit_, nx2_ = it + 2 * NGW < nit_; \
            if (nx_) tr_load(sg_, it + NGW, lane, vb_); \
            tr_store(sg_, it, lane, va_, scr); \
            if (nx2_) tr_load(sg_, it + 2 * NGW, lane, va_); \
            if (nx_) tr_store(sg_, it + NGW, lane, vb_, scr); } } while (0)
    SEG(p.in[2], 16416, 16384, 32, (bf16*)(ws + WS_WFF0), 4096, ng + 0 * 4096);
    SEG(p.in[2] + (size_t)4096 * 16416, 16416, 0, 16384, (bf16*)(ws + WS_WFI1), 4096, ng + 3 * 4096);
    SEG(p.in[2] + (size_t)4096 * 16416, 16416, 16384, 32, (bf16*)(ws + WS_WFF1), 4096, ng + 3 * 4096);
    SEG(p.in[4], 4096, 0, 4096, (bf16*)(ws + WS_WFO0), 4096, (const LAS float*)nullptr);
    SEG(p.in[4] + (size_t)4096 * 4096, 4096, 0, 4096, (bf16*)(ws + WS_WFO1), 4096, (const LAS float*)nullptr);
    SEG(p.in[5], 8192, 0, 8192, (bf16*)(ws + WS_WLI), 4096, ng + 1 * 4096);
    SEG(p.in[13], 4096, 0, 4096, (bf16*)(ws + WS_WLO), 4096, (const LAS float*)nullptr);
    for (int n = 0; n < 16; ++n) {
        SEG(p.in[8] + (size_t)n * 65536, 256, 0, 256, (bf16*)(ws + WS_WLA) + (size_t)n * 65536, 256, (const LAS float*)nullptr);
        SEG(p.in[10] + (size_t)n * 65536, 256, 0, 256, (bf16*)(ws + WS_WLX) + (size_t)n * 65536, 256, (const LAS float*)nullptr);
    }
    SEG(p.in[14], 16400, 0, 12288, (bf16*)(ws + WS_WMI), 4096, ng + 2 * 4096);
    SEG(p.in[14], 16400, 12288, 32, (bf16*)(ws + WS_WMG), 4096, ng + 2 * 4096);
    SEG(p.in[14], 16400, 12304, 4096, (bf16*)(ws + WS_WMI) + (size_t)12288 * 4096, 4096, ng + 2 * 4096);
    SEG(p.in[17], 4096, 0, 4096, (bf16*)(ws + WS_WMO), 4096, (const LAS float*)nullptr);
    SEG(p.in[2], 16416, 0, 16384, (bf16*)(ws + WS_WFI0), 4096, ng + 0 * 4096);
#undef SEG
    const float* x = p.in[0]; bf16* hb = (bf16*)(ws + WS_HB); unsigned long long* ss0 = (unsigned long long*)(ws + WS_ROWSS);
    for (int m = gw; m < SEQ; m += NGW) {
        const f32x4* xr = (const f32x4*)(x + (size_t)m * DM) + lane; unsigned long long* o8 = (unsigned long long*)(hb + (size_t)m * DM) + lane; float s = 0.f;
#pragma unroll
        for (int j = 0; j < 16; ++j) { const f32x4 v = xr[64 * j]; const unsigned w0 = pk2(v.x, v.y), w1 = pk2(v.z, v.w);
            const float r0 = __uint_as_float(w0 << 16), r1 = __uint_as_float(w0 & 0xffff0000u), r2 = __uint_as_float(w1 << 16), r3 = __uint_as_float(w1 & 0xffff0000u);
            s += (r0 * r0 + r1 * r1) + (r2 * r2 + r3 * r3);
            o8[64 * j] = (unsigned long long)w0 | ((unsigned long long)w1 << 32); }
        s = wave_sum(s);
        if (lane == 0) ss0[m] = (unsigned long long)(s * 1048576.0f + 0.5f);
    }
}

template <int NT>
__device__ __forceinline__ void side_gate_tile(const bf16* hb, const bf16* Wg, int row0, int lane, f32x4 (&acc)[NT]) {
    const int fr = lane & 15, fq = lane >> 4;
    const bf16* ap = hb + (size_t)(row0 + fr) * DM + 8 * fq;
    const bf16* bp = Wg + (size_t)fr * DM + 8 * fq;
#pragma unroll
    for (int nt = 0; nt < NT; ++nt) acc[nt] = (f32x4){0.f, 0.f, 0.f, 0.f};
    bf16x8 a0[4], b0[NT][4], a1[4], b1[NT][4];
#define SG_LOAD(a, b, k0_) do { _Pragma("unroll") for (int j = 0; j < 4; ++j) a[j] = *(const bf16x8*)(ap + (k0_) + 32 * j); \
        _Pragma("unroll") for (int nt = 0; nt < NT; ++nt) _Pragma("unroll") for (int j = 0; j < 4; ++j) b[nt][j] = *(const bf16x8*)(bp + (size_t)nt * 16 * DM + (k0_) + 32 * j); } while (0)
#define SG_MMA(a, b) do { _Pragma("unroll") for (int j = 0; j < 4; ++j) _Pragma("unroll") for (int nt = 0; nt < NT; ++nt) acc[nt] = MFMA16(a[j], b[nt][j], acc[nt]); } while (0)
    SG_LOAD(a0, b0, 0);
#pragma unroll 1
    for (int k0 = 0; k0 < DM; k0 += 256) { SG_LOAD(a1, b1, k0 + 128); SG_MMA(a0, b0); SG_LOAD(a0, b0, (k0 + 256) & (DM - 1)); SG_MMA(a1, b1); }
#undef SG_LOAD
#undef SG_MMA
}
__device__ __forceinline__ void fox_gates(const bf16* hb, const bf16* Wf, const unsigned long long* rowss, const float* b_f, float* FLOC, float* FTOT, int tid) {
    const int lane = tid & 63, wave = tid >> 6, fr = lane & 15, fq = lane >> 4;
    if (wave >= 4) return;
    for (int tile = blockIdx.x * 4 + wave; tile < SEQ / 16; tile += gridDim.x * 4) {
        const int row0 = tile * 16;
        f32x4 acc[2]; side_gate_tile<2>(hb, Wf, row0, lane, acc);
        float rs[4];
#pragma unroll
        for (int j = 0; j < 4; ++j) rs[j] = rsqrtf((float)rowss[row0 + 4 * fq + j] * (1.0f / (1048576.0f * 4096.0f)) + 1e-6f);
#pragma unroll
        for (int nt = 0; nt < 2; ++nt) { const int h = 16 * nt + fr; const float bb = b_f[h];
            float c[4]; float run = 0.f;
#pragma unroll
            for (int j = 0; j < 4; ++j) { run += logsigmoidf_(acc[nt][j] * rs[j] + bb); c[j] = run; }
            float inc = run; float u = __shfl_up(inc, 16); if (fq >= 1) inc += u; u = __shfl_up(inc, 32); if (fq >= 2) inc += u;
            const float exc = inc - run;
#pragma unroll
            for (int j = 0; j < 4; ++j) FLOC[(size_t)h * SEQ + row0 + 4 * fq + j] = exc + c[j];
            if (fq == 3) FTOT[h * 1024 + tile] = inc; }
    }
}
__device__ __forceinline__ void mlstm_gates(const bf16* hb, const bf16* Wg, const unsigned long long* rowss, const float* b_i, const float* b_f, float* IG, float* LF, int tid) {
    const int lane = tid & 63, wave = tid >> 6, fr = lane & 15, fq = lane >> 4;
    if (wave >= 4) return;
    for (int tile = blockIdx.x * 4 + wave; tile < SEQ / 16; tile += gridDim.x * 4) {
        const int row0 = tile * 16;
        f32x4 acc[1]; side_gate_tile<1>(hb, Wg, row0, lane, acc);
        const int h = fr & 7; const float bb = (fr < 8) ? b_i[h] : b_f[h];
#pragma unroll
        for (int j = 0; j < 4; ++j) { const int row = row0 + 4 * fq + j; const float rs = rsqrtf((float)rowss[row] * (1.0f / (1048576.0f * 4096.0f)) + 1e-6f);
            const float v = acc[0][j] * rs + bb;
            if (fr < 8) IG[(size_t)h * SEQ + row] = v; else LF[(size_t)h * SEQ + row] = logsigmoidf_(v); }
    }
}

__device__ __forceinline__ float fox_setup_fabs(char* lds, const float* FLOC, const float* FTOT, const unsigned* nrm, int h, int tid) {
    float* PH = (float*)(lds + fa::LDS_BODY); float* FABS = PH + 1024;
    asm volatile("" : "+v"(tid));
    const int lane = tid & 63;
    if (tid < 64) {
        const f32x4* src = (const f32x4*)(FTOT + h * 1024 + lane * 16);
        const f32x4 a = src[0], b = src[1], c = src[2], d = src[3];
        const float v[16] = {a[0], a[1], a[2], a[3], b[0], b[1], b[2], b[3], c[0], c[1], c[2], c[3], d[0], d[1], d[2], d[3]};
        float ex[16]; float run = 0.f;
#pragma unroll
        for (int i = 0; i < 16; ++i) { ex[i] = run; run += v[i]; }
        float inc = run;
#pragma unroll
        for (int o = 1; o < 64; o <<= 1) { const float u = __shfl_up(inc, o); if (lane >= o) inc += u; }
        const float base = inc - run;
#pragma unroll
        for (int i = 0; i < 16; ++i) PH[lane * 16 + i] = base + ex[i];
    }
    __syncthreads();
#pragma unroll
    for (int k = 0; k < SEQ / 4 / NTHR; ++k) { const int i = tid + NTHR * k; const f32x4 f = ((const f32x4*)(FLOC + (size_t)h * SEQ))[i]; const float ph = PH[i >> 2];
        ((f32x4*)FABS)[i] = (f + ph) * fa::INV_SCALE; }
    __syncthreads();
    float B = 0.f;
#pragma unroll
    for (int c = 0; c < 4; ++c) B += sqrtf(__uint_as_float(nrm[h * 4 + c])) * sqrtf(__uint_as_float(nrm[(32 + h) * 4 + c]));
    B *= 1.02f * fa::SCALE;
    return (105.0f + 2.0f * B) * fa::INV_SCALE;
}
__device__ __forceinline__ int fox_jlo(const float* FABS, int P0, float thp, int lane) {
    asm volatile("" : "+v"(lane));
    const float f0 = FABS[P0]; int cnt = 0;
#pragma unroll
    for (int c = 0; c < 4; ++c) { const int s = 64 * (64 * c + lane) + 63; const bool skip = (s < P0) && (FABS[s] - f0 >= thp); cnt += __popcll(__ballot(skip)); }
    return cnt;
}
__device__ __forceinline__ int fox_grab(unsigned* qcnt, volatile LAS unsigned* slot, int tid) {
    if (tid == 0) { const unsigned i = __hip_atomic_fetch_add(qcnt, 1u, __ATOMIC_RELAXED, __HIP_MEMORY_SCOPE_AGENT); *slot = i < 1024u ? i : 0xffffffffu; }
    __syncthreads();
    const int r = (int)*slot;
    __syncthreads();
    return r;
}
__device__ __forceinline__ void fox_attn_phase(char* lds, const bf16* Q, const bf16* K, const float* FLOC, const float* FTOT, const unsigned* nrm, unsigned* qcnt, int tid) {
    static_assert(WS_PSTRIDE / 2 == fa::V_OFF && (WS_Y - WS_P0) / 2 == fa::O_OFF, "attention tensor offsets");
    const int lane = tid & 63;
    volatile LAS unsigned* slot = (volatile LAS unsigned*)((LAS unsigned char*)lds + LDS_CTL) + 8;
    const float* FABS = (const float*)(lds + fa::LDS_BODY) + 1024;
    typedef fa::BlockRef<bf16, bf16> Ref;
#define FOX_REF(r, h_, qb_, jlo_) do { r.Q = Q + (size_t)(qb_) * fa::QB * fa::LD + (size_t)(h_) * fa::D; r.K = K + (size_t)(h_) * fa::D; r.P0 = (qb_) * fa::QB; r.JLO = (jlo_); } while (0)
#define FOX_ITEM(it_, h_, x_) do { h_ = 31 - ((it_) >> 5); x_ = 31 - ((it_) & 31); } while (0)
    int it = fox_grab(qcnt, slot, tid); if (it < 0) return;
    fa::Seam<bf16> S;
    int h, x, pass = 0, jl1; bool fresh = true; FOX_ITEM(it, h, x);
    float thp = fox_setup_fabs(lds, FLOC, FTOT, nrm, h, tid);
    Ref cur; FOX_REF(cur, h, x, fox_jlo(FABS, x * fa::QB, thp, lane)); jl1 = fox_jlo(FABS, (63 - x) * fa::QB, thp, lane);
    for (;;) {
        if (fresh) { fa::causal_swa_prime<bf16, bf16>(cur, SEQ, lds, S); fresh = false; }
        Ref nxt; if (pass == 0) { FOX_REF(nxt, h, 63 - x, jl1); } else nxt = cur;
        fa::causal_swa_block<bf16, bf16>(cur, nxt, SEQ, SEQ, lds, S, (const LAS float*)FABS);
        if (pass == 0) { pass = 1; cur = nxt; continue; }
        it = fox_grab(qcnt, slot, tid); if (it < 0) break;
        int hn, xn; FOX_ITEM(it, hn, xn);
        if (hn != h) thp = fox_setup_fabs(lds, FLOC, FTOT, nrm, hn, tid);
        h = hn; x = xn; pass = 0; fresh = true;
        FOX_REF(cur, h, x, fox_jlo(FABS, x * fa::QB, thp, lane)); jl1 = fox_jlo(FABS, (63 - x) * fa::QB, thp, lane);
    }
#undef FOX_REF
#undef FOX_ITEM
}

__device__ __forceinline__ void lru_scan_phase(char* ldsg, const Params& p, int tid) {
    unsigned char* ws = p.ws;
    const bf16* XB = (const bf16*)(ws + WS_P0); const bf16* Zt = (const bf16*)(ws + WS_P0 + WS_PSTRIDE);
    bf16* HZ = (bf16*)(ws + WS_P0 + 2 * WS_PSTRIDE); bf16* PZ = (bf16*)(ws + WS_P0 + 3 * WS_PSTRIDE);
    const bf16* WLA = (const bf16*)(ws + WS_WLA); const bf16* WLX = (const bf16*)(ws + WS_WLX);
    float* CA = (float*)(ws + WS_CA); float* CB = (float*)(ws + WS_CB);
    const float* conv_w = late_in(6); const float* conv_b = late_in(7); const float* b_a = late_in(9); const float* b_x = late_in(11); const float* lam = late_in(12);
    constexpr int XS = 264;
    bf16* XC = (bf16*)ldsg; bf16* PT = XC + 128 * XS; float* CW = (float*)(ldsg + 2 * 128 * XS * 2); float* CBs = CW + 1024;
    const int lane = tid & 63, wid = __builtin_amdgcn_readfirstlane(tid >> 6), fr = lane & 15, fq = lane >> 4;
    for (int u = blockIdx.x; u < 256; u += gridDim.x) {
        const int n = u & 15, sc = u >> 4;
        for (int i = tid; i < 1024; i += NTHR) CW[i] = conv_w[(i >> 8) * 4096 + n * 256 + (i & 255)];
        if (tid < 256) CBs[tid] = conv_b[n * 256 + tid];
        float ba[2], bx[2], nl[2], hc[2], pc[2];
#pragma unroll
        for (int nt = 0; nt < 2; ++nt) { const int c = n * 256 + 32 * wid + 16 * nt + fr; ba[nt] = b_a[c]; bx[nt] = b_x[c]; nl[nt] = -8.0f * log1pf(__expf(-lam[c])); hc[nt] = 0.f; pc[nt] = 1.f; }
        __syncthreads();
        for (int tile = 0; tile < 8; ++tile) {
            const int T0 = sc * 1024 + tile * 128;
            int tidq = tid; asm volatile("" : "+v"(tidq));
            { const int c0 = (tidq & 31) * 8, tq = tidq >> 5;
                float wv[4][8], bv[8];
#pragma unroll
                for (int e = 0; e < 8; ++e) bv[e] = CBs[c0 + e];
#pragma unroll
                for (int j = 0; j < 4; ++j)
#pragma unroll
                    for (int e = 0; e < 8; ++e) wv[j][e] = CW[j * 256 + c0 + e];
                const bf16* xrow = XB + (size_t)T0 * DM + n * 256 + c0;
                bf16x8 xv[8][4];
#pragma unroll
                for (int i = 0; i < 8; ++i)
#pragma unroll
                    for (int j = 0; j < 4; ++j) { const int dt = tq + 16 * i - 3 + j;
                        if (i == 0) { const bool neg = T0 + dt < 0; xv[i][j] = *(const bf16x8*)(xrow + (ptrdiff_t)(neg ? -T0 : dt) * DM); }
                        else xv[i][j] = *(const bf16x8*)(xrow + (ptrdiff_t)dt * DM); }
                __builtin_amdgcn_sched_barrier(0);
#pragma unroll
                for (int i = 0; i < 8; ++i) { const int t = tq + 16 * i;
                    if (i == 0) {
#pragma unroll
                        for (int j = 0; j < 3; ++j) if (T0 + t - 3 + j < 0) xv[0][j] = (bf16x8){0, 0, 0, 0, 0, 0, 0, 0}; }
                    float a[8];
#pragma unroll
                    for (int e = 0; e < 8; ++e) a[e] = bv[e];
#pragma unroll
                    for (int j = 0; j < 4; ++j)
#pragma unroll
                        for (int e = 0; e < 8; ++e) a[e] = __builtin_fmaf(wv[j][e], bf2f((unsigned short)xv[i][j][e]), a[e]);
                    v4u o; o.x = pk2(a[0], a[1]); o.y = pk2(a[2], a[3]); o.z = pk2(a[4], a[5]); o.w = pk2(a[6], a[7]);
                    *(v4u*)(XC + t * XS + c0) = o; } }
            __syncthreads();
            f32x4 acc[2][8][2];
#pragma unroll
            for (int g = 0; g < 2; ++g)
#pragma unroll
                for (int rt = 0; rt < 8; ++rt)
#pragma unroll
                    for (int nt = 0; nt < 2; ++nt) acc[g][rt][nt] = (f32x4){0.f, 0.f, 0.f, 0.f};
#pragma unroll 2
            for (int kk = 0; kk < 8; ++kk) {
                bf16x8 bfr[2][2];
#pragma unroll
                for (int nt = 0; nt < 2; ++nt) { const size_t wo = (size_t)n * 65536 + (size_t)(32 * wid + 16 * nt + fr) * 256 + 32 * kk + 8 * fq;
                    bfr[0][nt] = *(const bf16x8*)(WLA + wo); bfr[1][nt] = *(const bf16x8*)(WLX + wo); }
#pragma unroll
                for (int rt = 0; rt < 8; ++rt) { const bf16x8 a = *(const bf16x8*)(XC + (16 * rt + fr) * XS + 32 * kk + 8 * fq);
#pragma unroll
                    for (int g = 0; g < 2; ++g)
#pragma unroll
                        for (int nt = 0; nt < 2; ++nt) acc[g][rt][nt] = MFMA16(a, bfr[g][nt], acc[g][rt][nt]); }
            }
            __syncthreads();
            LAS bf16* xcb = (LAS bf16*)XC + (4 * fq) * XS + 32 * wid + fr; LAS bf16* ptb = xcb + 128 * XS; asm volatile("" : "+v"(xcb), "+v"(ptb));
#pragma unroll
            for (int nt = 0; nt < 2; ++nt) {
#pragma unroll
                for (int rt = 0; rt < 8; ++rt) {
                    float A[4], B[4];
#pragma unroll
                    for (int j = 0; j < 4; ++j) {
                        const float r = sigmoidf_(acc[0][rt][nt][j] + ba[nt]), ig = sigmoidf_(acc[1][rt][nt][j] + bx[nt]);
                        const float la = r * nl[nt], av = __expf(la), x2 = 2.0f * la;
                        const float es = -x2 * (1.0f + x2 * 0.5f * (1.0f + x2 * (1.0f / 3.0f) * (1.0f + x2 * 0.25f))), ed = 1.0f - av * av;
                        const float em = (x2 > -0.0625f) ? es : ed;
                        const float mult = __builtin_amdgcn_sqrtf(em);
                        const float xcv = bf2f(xcb[(16 * rt + j) * XS + 16 * nt]);
                        A[j] = av; B[j] = mult * ig * xcv; }
#pragma unroll
                    for (int j = 1; j < 4; ++j) { B[j] = B[j - 1] * A[j] + B[j]; A[j] = A[j - 1] * A[j]; }
                    float At = A[3], Bt = B[3];
                    { const float Au = __shfl_up(At, 16), Bu = __shfl_up(Bt, 16); if (fq >= 1) { Bt = At * Bu + Bt; At = At * Au; } }
                    { const float Au = __shfl_up(At, 32), Bu = __shfl_up(Bt, 32); if (fq >= 2) { Bt = At * Bu + Bt; At = At * Au; } }
                    float Ae = __shfl_up(At, 16), Be = __shfl_up(Bt, 16); if (fq == 0) { Ae = 1.f; Be = 0.f; }
                    const float At3 = __shfl(At, 48 + fr), Bt3 = __shfl(Bt, 48 + fr);
                    const float h0 = Ae * hc[nt] + Be, P0 = Ae * pc[nt];
#pragma unroll
                    for (int j = 0; j < 4; ++j) {
                        const float hj = A[j] * h0 + B[j], Pj = A[j] * P0;
                        xcb[(16 * rt + j) * XS + 16 * nt] = (bf16)(pk2(hj, 0.f) & 0xffffu); ptb[(16 * rt + j) * XS + 16 * nt] = (bf16)(pk2(Pj, 0.f) & 0xffffu); }
                    hc[nt] = At3 * hc[nt] + Bt3; pc[nt] = At3 * pc[nt];
                }
            }
            __syncthreads();
            int tidp = tid; asm volatile("" : "+v"(tidp));
            bf16x8 zq[8];
#pragma unroll
            for (int i = 0; i < 8; ++i) { const int task = tidp + NTHR * i; zq[i] = *(const bf16x8*)(Zt + (size_t)(T0 + (task >> 5)) * DM + n * 256 + (task & 31) * 8); }
#pragma unroll
            for (int i = 0; i < 8; ++i) { const int task = tidp + NTHR * i, t = task >> 5, c0 = (task & 31) * 8; const size_t go = (size_t)(T0 + t) * DM + n * 256 + c0;
                const bf16x8 z8 = zq[i], h8 = *(const bf16x8*)(XC + t * XS + c0), p8 = *(const bf16x8*)(PT + t * XS + c0);
                float hz[8], pz[8];
#pragma unroll
                for (int e = 0; e < 8; ++e) { const float z = bf2f((unsigned short)z8[e]), sz = z * sigmoidf_(z); hz[e] = bf2f((unsigned short)h8[e]) * sz; pz[e] = bf2f((unsigned short)p8[e]) * sz; }
                v4u w; w.x = pk2(hz[0], hz[1]); w.y = pk2(hz[2], hz[3]); w.z = pk2(hz[4], hz[5]); w.w = pk2(hz[6], hz[7]); *(v4u*)(HZ + go) = w;
                w.x = pk2(pz[0], pz[1]); w.y = pk2(pz[2], pz[3]); w.z = pk2(pz[4], pz[5]); w.w = pk2(pz[6], pz[7]); *(v4u*)(PZ + go) = w; }
            __syncthreads();
        }
        if (fq == 0) {
#pragma unroll
            for (int nt = 0; nt < 2; ++nt) { const size_t c = (size_t)sc * DM + n * 256 + 32 * wid + 16 * nt + fr; CA[c] = pc[nt]; CB[c] = hc[nt]; } }
    }
}
__device__ __forceinline__ void lru_fix_phase(const Params& p, int tid) {
    unsigned char* ws = p.ws;
    const bf16* HZ = (const bf16*)(ws + WS_P0 + 2 * WS_PSTRIDE); const bf16* PZ = (const bf16*)(ws + WS_P0 + 3 * WS_PSTRIDE); bf16* Y = (bf16*)(ws + WS_Y);
    const float* CA = (const float*)(ws + WS_CA); const float* CB = (const float*)(ws + WS_CB);
    const int c0 = tid * 8;
    for (int b = blockIdx.x; b < 256; b += gridDim.x) {
        const int sc = b >> 4;
        float hin[8];
#pragma unroll
        for (int e = 0; e < 8; ++e) hin[e] = 0.f;
#pragma unroll 4
        for (int s = 0; s < sc; ++s) { const f32x4 a0 = *(const f32x4*)(CA + (size_t)s * DM + c0), a1 = *(const f32x4*)(CA + (size_t)s * DM + c0 + 4);
            const f32x4 b0 = *(const f32x4*)(CB + (size_t)s * DM + c0), b1 = *(const f32x4*)(CB + (size_t)s * DM + c0 + 4);
#pragma unroll
            for (int e = 0; e < 4; ++e) { hin[e] = b0[e] + a0[e] * hin[e]; hin[4 + e] = b1[e] + a1[e] * hin[4 + e]; } }
#pragma unroll 8
        for (int r = 0; r < 64; ++r) { const size_t o = (size_t)(b * 64 + r) * DM + c0;
            const bf16x8 hz = *(const bf16x8*)(HZ + o), pz = *(const bf16x8*)(PZ + o);
            float y[8];
#pragma unroll
            for (int e = 0; e < 8; ++e) y[e] = bf2f((unsigned short)hz[e]) + bf2f((unsigned short)pz[e]) * hin[e];
            v4u w; w.x = pk2(y[0], y[1]); w.y = pk2(y[2], y[3]); w.z = pk2(y[4], y[5]); w.w = pk2(y[6], y[7]);
            *(v4u*)(Y + o) = w; }
    }
}

__device__ __forceinline__ void mlstm_scalars_phase(char* ldsg, const Params& p, int tid) {
    if (blockIdx.x >= 8) return;
    unsigned char* ws = p.ws; const int h = blockIdx.x, lane = tid & 63, wid = tid >> 6;
    const float* IG = (const float*)(ws + WS_IG) + (size_t)h * SEQ; const float* LF = (const float*)(ws + WS_LF) + (size_t)h * SEQ;
    float* G = (float*)ldsg; float* AM = G + 256; float* M0 = AM + 256; float* MN = M0 + 256;
    float lfv[32], igv[32];
#pragma unroll
    for (int k = 0; k < 32; ++k) { const int tok = (wid + NWAVES * k) * 64 + lane; lfv[k] = LF[tok]; igv[k] = IG[tok]; }
#pragma unroll
    for (int k = 0; k < 32; ++k) { const int c = wid + NWAVES * k; const float ig = igv[k];
        float bc = lfv[k];
#pragma unroll
        for (int o = 1; o < 64; o <<= 1) { const float u = __shfl_up(bc, o); if (lane >= o) bc += u; }
        lfv[k] = bc;
        const float g = __shfl(bc, 63); float pm = ig - bc;
#pragma unroll
        for (int o = 1; o < 64; o <<= 1) pm = fmaxf(pm, __shfl_xor(pm, o));
        if (lane == 0) { G[c] = g; AM[c] = g + pm; } }
    __syncthreads();
    if (tid < 64) { float* DEC = (float*)(ws + WS_DEC) + h * 256;
        float g[4], am[4];
#pragma unroll
        for (int j = 0; j < 4; ++j) { g[j] = G[4 * lane + j]; am[j] = AM[4 * lane + j]; }
        float A = g[0], B = am[0];
#pragma unroll
        for (int j = 1; j < 4; ++j) { B = fmaxf(B + g[j], am[j]); A += g[j]; }
#pragma unroll
        for (int o = 1; o < 64; o <<= 1) { const float Au = __shfl_up(A, o), Bu = __shfl_up(B, o); if (lane >= o) { B = fmaxf(Bu + A, B); A = Au + A; } }
        float Ae = __shfl_up(A, 1), Be = __shfl_up(B, 1); if (lane == 0) { Ae = 0.f; Be = -__builtin_inff(); }
        float m = fmaxf(Ae, Be);
#pragma unroll
        for (int j = 0; j < 4; ++j) { const int c = 4 * lane + j; M0[c] = m; const float mn = fmaxf(g[j] + m, am[j]); DEC[c] = __expf(g[j] + m - mn); MN[c] = mn; m = mn; } }
    __syncthreads();
    float* W1 = (float*)(ws + WS_W1) + (size_t)h * SEQ; float* W2 = (float*)(ws + WS_W2) + (size_t)h * SEQ; float* WK = (float*)(ws + WS_WK) + (size_t)h * SEQ;
    float* ER = (float*)(ws + WS_EROW) + (size_t)h * SEQ; float* BC = (float*)(ws + WS_BC) + (size_t)h * SEQ; float* IGB = (float*)(ws + WS_IGB) + (size_t)h * SEQ;
    float* DMX = (float*)(ws + WS_DMAX) + (size_t)h * SEQ;
#pragma unroll
    for (int k = 0; k < 32; ++k) { const int c = wid + NWAVES * k, tok = c * 64 + lane; const float ig = igv[k], bc = lfv[k];
        const float g = __shfl(bc, 63); const float xs = ig - bc; float pm = xs;
#pragma unroll
        for (int o = 1; o < 64; o <<= 1) { const float u = __shfl_up(pm, o); if (lane >= o) pm = fmaxf(pm, u); }
        const float dmax = bc + pm, m = M0[c], mrow = fmaxf(bc + m, dmax);
        BC[tok] = bc; IGB[tok] = xs; DMX[tok] = dmax;
        W1[tok] = __expf(dmax - mrow); W2[tok] = __expf(bc + m - mrow) * 0.0625f; ER[tok] = __expf(-mrow); WK[tok] = __expf(g + xs - MN[c]); }
}
__device__ __forceinline__ u16x4 tr_read(unsigned lds_addr) { u16x4 r; asm volatile("ds_read_b64_tr_b16 %0, %1\n\ts_waitcnt lgkmcnt(0)" : "=&v"(r) : "v"(lds_addr) : "memory"); return r; }
__device__ __forceinline__ void mlstm_pre_phase(char* ldsg, const Params& p, int tid) {
    unsigned char* ws = p.ws;
    const bf16* QK = (const bf16*)(ws + WS_P0); const bf16* Vt = (const bf16*)(ws + WS_P0 + WS_PSTRIDE);
    bf16* QP = (bf16*)(ws + WS_QP); bf16* KT = (bf16*)(ws + WS_KT); bf16* VT = (bf16*)(ws + WS_VT); bf16* NINT = (bf16*)(ws + WS_NINT);
    constexpr int TS = 264, SS = 72;
    bf16* QL = (bf16*)ldsg; bf16* KL = QL + 64 * TS; bf16* VL = KL + 64 * TS; bf16* SCL = VL + 64 * TS;
    float* W1s = (float*)(SCL + 64 * SS); float* BCs = W1s + 64; float* IGBs = BCs + 64; float* DMs = IGBs + 64; float* DENP = DMs + 64; float* WKs = DENP + 256;
    const int lane = tid & 63, wid = __builtin_amdgcn_readfirstlane(tid >> 6), fr = lane & 15, fq = lane >> 4;
    const unsigned vl_addr = (unsigned)(uintptr_t)VL;
    for (int u = blockIdx.x; u < 2048; u += gridDim.x) {
        const int h = u >> 8, c = u & 255, tok0 = c * 64; const size_t hs = (size_t)h * SEQ + tok0;
        if (tid < 64) { W1s[tid] = ((const float*)(ws + WS_W1))[hs + tid]; BCs[tid] = ((const float*)(ws + WS_BC))[hs + tid]; IGBs[tid] = ((const float*)(ws + WS_IGB))[hs + tid];
            DMs[tid] = ((const float*)(ws + WS_DMAX))[hs + tid]; WKs[tid] = ((const float*)(ws + WS_WK))[hs + tid]; }
#pragma unroll
        for (int i = 0; i < 4; ++i) { const int task = tid + NTHR * i, t = task >> 5, d0 = (task & 31) * 8;
            const bf16x8 q8 = *(const bf16x8*)(QK + (size_t)(tok0 + t) * DM + h * 256 + d0), k8 = *(const bf16x8*)(QK + (size_t)(tok0 + t) * DM + 2048 + h * 256 + d0);
            *(bf16x8*)(QL + t * TS + d0) = q8; *(bf16x8*)(KL + t * TS + d0) = k8;
            const float w2 = ((const float*)(ws + WS_W2))[hs + t];
            v2u lo, hi; lo.x = pk2(bf2f((unsigned short)q8[0]) * w2, bf2f((unsigned short)q8[1]) * w2); lo.y = pk2(bf2f((unsigned short)q8[2]) * w2, bf2f((unsigned short)q8[3]) * w2);
            hi.x = pk2(bf2f((unsigned short)q8[4]) * w2, bf2f((unsigned short)q8[5]) * w2); hi.y = pk2(bf2f((unsigned short)q8[6]) * w2, bf2f((unsigned short)q8[7]) * w2);
            const int r = d0 & 31, g0 = (r >> 2) & 3, dtq = r >> 4;
            bf16* qf = QP + ((((size_t)(h * 256 + c) * 8 + (d0 >> 5)) * 4 + (t >> 4)) * 512) + ((t & 15) + 16 * g0) * 8 + 4 * dtq;
            *(v2u*)qf = lo; *(v2u*)(qf + 128) = hi; }
        __syncthreads();
#pragma unroll
        for (int i = 0; i < 4; ++i) { const int task = tid + NTHR * i, d = task & 255, sg = task >> 8;
            float v[8];
#pragma unroll
            for (int e = 0; e < 8; ++e) v[e] = bf2f(KL[(8 * sg + e) * TS + d]) * WKs[8 * sg + e];
            v4u w; w.x = pk2(v[0], v[1]); w.y = pk2(v[2], v[3]); w.z = pk2(v[4], v[5]); w.w = pk2(v[6], v[7]);
            *(v4u*)(KT + ((((size_t)(h * 256 + c) * 8 + (d >> 5)) * 2 + ((d >> 4) & 1)) * 2 + (sg >> 2)) * 512 + ((d & 15) + 16 * (sg & 3)) * 8) = w; }
        { const int tr = wid >> 1;
#pragma unroll
          for (int tci = 0; tci < 2; ++tci) { const int tc = (wid & 1) * 2 + tci;
            if (tc <= tr) { f32x4 acc = (f32x4){0.f, 0.f, 0.f, 0.f};
#pragma unroll
                for (int kk = 0; kk < 8; ++kk) { const bf16x8 a = *(const bf16x8*)(QL + (16 * tr + fr) * TS + 32 * kk + 8 * fq), b = *(const bf16x8*)(KL + (16 * tc + fr) * TS + 32 * kk + 8 * fq);
                    acc = MFMA16(a, b, acc); }
                const int s = 16 * tc + fr; const float igb = IGBs[s];
#pragma unroll
                for (int j = 0; j < 4; ++j) { const int t = 16 * tr + 4 * fq + j;
                    float val = (s <= t) ? acc[j] * 0.0625f * __expf(BCs[t] + igb - DMs[t]) : 0.f;
                    SCL[t * SS + s] = (bf16)(pk2(val, 0.f) & 0xffffu);
                    val += __shfl_xor(val, 1); val += __shfl_xor(val, 2); val += __shfl_xor(val, 4); val += __shfl_xor(val, 8);
                    if (fr == 0) DENP[tc * 64 + t] = val; } }
            else {
#pragma unroll
                for (int j = 0; j < 4; ++j) { SCL[(16 * tr + 4 * fq + j) * SS + 16 * tc + fr] = (bf16)0; if (fr == 0) DENP[tc * 64 + 16 * tr + 4 * fq + j] = 0.f; } } } }
        __syncthreads();
        for (int vh = 0; vh < 2; ++vh) {
#pragma unroll
            for (int i = 0; i < 4; ++i) { const int task = tid + NTHR * i, s = task >> 5, c0 = (task & 31) * 8;
                *(bf16x8*)(VL + s * TS + c0) = *(const bf16x8*)(Vt + (size_t)(tok0 + s) * DM + h * 512 + 256 * vh + c0); }
            __syncthreads();
#pragma unroll
            for (int i = 0; i < 4; ++i) { const int task = tid + NTHR * i, v = task & 255, sg = task >> 8;
                v4u w; w.x = (unsigned)VL[(8 * sg + 0) * TS + v] | ((unsigned)VL[(8 * sg + 1) * TS + v] << 16); w.y = (unsigned)VL[(8 * sg + 2) * TS + v] | ((unsigned)VL[(8 * sg + 3) * TS + v] << 16);
                w.z = (unsigned)VL[(8 * sg + 4) * TS + v] | ((unsigned)VL[(8 * sg + 5) * TS + v] << 16); w.w = (unsigned)VL[(8 * sg + 6) * TS + v] | ((unsigned)VL[(8 * sg + 7) * TS + v] << 16);
                *(v4u*)(VT + (((size_t)(h * 256 + c) * 32 + ((256 * vh + v) >> 4)) * 2 + (sg >> 2)) * 512 + ((v & 15) + 16 * (sg & 3)) * 8) = w; }
            f32x4 acc[4][2];
#pragma unroll
            for (int tt = 0; tt < 4; ++tt)
#pragma unroll
                for (int nt = 0; nt < 2; ++nt) acc[tt][nt] = (f32x4){0.f, 0.f, 0.f, 0.f};
#pragma unroll
            for (int ks = 0; ks < 2; ++ks) {
                bf16x8 bfr[2];
#pragma unroll
                for (int nt = 0; nt < 2; ++nt) { const unsigned a0 = vl_addr + (unsigned)((32 * ks + 8 * fq + (fr >> 2)) * TS + 16 * (2 * wid + nt) + 4 * (fr & 3)) * 2u;
                    const u16x4 lo = tr_read(a0), hi = tr_read(a0 + 4u * TS * 2u);
                    bfr[nt] = (bf16x8){(short)lo[0], (short)lo[1], (short)lo[2], (short)lo[3], (short)hi[0], (short)hi[1], (short)hi[2], (short)hi[3]}; }
#pragma unroll
                for (int tt = 0; tt < 4; ++tt) { const bf16x8 a = *(const bf16x8*)(SCL + (16 * tt + fr) * SS + 32 * ks + 8 * fq);
#pragma unroll
                    for (int nt = 0; nt < 2; ++nt) acc[tt][nt] = MFMA16(a, bfr[nt], acc[tt][nt]); }
            }
#pragma unroll
            for (int tt = 0; tt < 4; ++tt)
#pragma unroll
                for (int j = 0; j < 4; ++j) { const int t = 16 * tt + 4 * fq + j; const float w1 = W1s[t];
#pragma unroll
                    for (int nt = 0; nt < 2; ++nt) NINT[(size_t)(tok0 + t) * DM + h * 512 + 256 * vh + 16 * (2 * wid + nt) + fr] = (bf16)(pk2(acc[tt][nt][j] * w1, 0.f) & 0xffffu); }
            __syncthreads();
        }
        if (tid < 64) ((float*)(ws + WS_DENI))[hs + tid] = W1s[tid] * (((DENP[tid] + DENP[64 + tid]) + DENP[128 + tid]) + DENP[192 + tid]);
        __syncthreads();
    }
}
template <int VAR>
__device__ __forceinline__ void mlstm_seq_phase(char* ldsg, const Params& p, int tid) {
    unsigned char* ws = p.ws;
    const bf16* QP = (const bf16*)(ws + WS_QP); const bf16* KT = (const bf16*)(ws + WS_KT); const bf16* VT = (const bf16*)(ws + WS_VT); const bf16* NINT = (const bf16*)(ws + WS_NINT);
    const bf16* Ot = (const bf16*)(ws + WS_P0 + 2 * WS_PSTRIDE); const bf16* Zt = (const bf16*)(ws + WS_P0 + 3 * WS_PSTRIDE); bf16* Y = (bf16*)(ws + (VAR ? WS_END : WS_Y));
    const float* DENI = (const float*)(ws + WS_DENI); const float* ER = (const float*)(ws + WS_EROW); const float* DEC = (const float*)(ws + WS_DEC);
    constexpr int PW = 20;
    float* PART = (float*)ldsg;
    unsigned* vtl = (unsigned*)(ldsg + 2 * 8 * 64 * PW * 4);
    const int lane = tid & 63, wid = __builtin_amdgcn_readfirstlane(tid >> 6), fr = lane & 15, fq = lane >> 4;
    const short one = (fr == 0) ? (short)0x3F80 : (short)0;
    const bf16x8 ones = (bf16x8){one, one, one, one, one, one, one, one};
    for (int u = blockIdx.x; u < 256; u += gridDim.x) {
        const int h = u & 7, vs = u >> 3;
        f32x4 st[2][2];
#pragma unroll
        for (int dt = 0; dt < 2; ++dt)
#pragma unroll
            for (int nt = 0; nt < 2; ++nt) st[dt][nt] = (f32x4){0.f, 0.f, 0.f, 0.f};
        const bf16* qp = QP + ((size_t)h * 256 * 8 + wid) * 2048 + lane * 8;
        const bf16* kt = KT + ((size_t)h * 256 * 8 + wid) * 2048 + lane * 8;
        const bf16* vt = VT + ((size_t)h * 256 * 32 + vs) * 1024 + lane * 8;
        const bf16* vtp = VT + ((size_t)h * 256 * 32 + vs) * 1024 + tid * 2;
        const int et = tid >> 3, ev = (tid & 7) * 2; const size_t ecol = (size_t)h * 512 + vs * 16 + ev;
        bf16x8 aQ0[4], aK0[2][2], bV0[2], aQ1[4], aK1[2][2], bV1[2];
        unsigned vp; unsigned ni0, oi0, zi0, ni1, oi1, zi1; float di0, ei0, di1, ei1, dec0, dec1;
#define SEQ_LOAD(c_, aQ, aK, ni, oi, zi, di, ei, dec) do { vp = *(const unsigned*)(vtp + (size_t)(c_) * 32768);     \
            dec = DEC[h * 256 + (c_)]; _Pragma("unroll") for (int tt = 0; tt < 4; ++tt) aQ[tt] = *(const bf16x8*)(qp + (size_t)(c_) * 16384 + tt * 512); \
            _Pragma("unroll") for (int dt = 0; dt < 2; ++dt) _Pragma("unroll") for (int ks = 0; ks < 2; ++ks) aK[dt][ks] = *(const bf16x8*)(kt + (size_t)(c_) * 16384 + (dt * 2 + ks) * 512); \
            { const size_t tok = (size_t)(c_) * 64 + et; \
                ni = *(const unsigned*)(NINT + tok * DM + ecol); oi = *(const unsigned*)(Ot + tok * DM + ecol); zi = *(const unsigned*)(Zt + tok * DM + ecol); di = DENI[(size_t)h * SEQ + tok]; ei = ER[(size_t)h * SEQ + tok]; } } while (0)
#define SEQ_STEP(c_, aQ, aK, bV, bVn, ni, oi, zi, di, ei, dec) do { \
            float* part = PART + ((c_) & 1) * (8 * 64 * PW) + wid * (64 * PW); \
            const float decay = dec; \
            bf16x8 bs[2]; \
            _Pragma("unroll") for (int nt = 0; nt < 2; ++nt) { v4u w; w.x = pk2(st[0][nt][0], st[0][nt][1]); w.y = pk2(st[0][nt][2], st[0][nt][3]); w.z = pk2(st[1][nt][0], st[1][nt][1]); w.w = pk2(st[1][nt][2], st[1][nt][3]); \
                bs[nt] = __builtin_bit_cast(bf16x8, w); } \
            _Pragma("unroll") for (int tt = 0; tt < 4; ++tt) { const f32x4 z4 = (f32x4){0.f, 0.f, 0.f, 0.f}; \
                  \
                const f32x4 p0 = MFMA16(bs[0], aQ[tt], z4), p1 = MFMA16(bs[1], aQ[tt], z4); \
                *(f32x4*)(part + (16 * tt + fr) * PW + 4 * fq) = p0; part[(16 * tt + fr) * PW + 16 + fq] = p1[0]; }     \
              \
            const float nn0 = __uint_as_float(ni << 16), nn1 = __uint_as_float(ni & 0xffff0000u); \
            float gg0, gg1; { const float o0 = __uint_as_float(oi << 16), o1 = __uint_as_float(oi & 0xffff0000u), z0 = __uint_as_float(zi << 16), z1 = __uint_as_float(zi & 0xffff0000u); \
                gg0 = sigmoidf_(o0) * z0 * sigmoidf_(z0); gg1 = sigmoidf_(o1) * z1 * sigmoidf_(z1); } \
            float dd, ee; asm volatile("v_mov_b32 %0, %2\n\tv_mov_b32 %1, %3" : "=&v"(dd), "=&v"(ee) : "v"(di), "v"(ei)); \
            vtl[(((c_) + 1) & 1) * 512 + tid] = vp;     \
            if (VAR != 2) __syncthreads(); \
              \
            const float* pall = PART + ((c_) & 1) * (8 * 64 * PW) + et * PW; \
            f32x2v pv[8]; float dn[8]; \
            if (VAR != 2) { _Pragma("unroll") for (int w = 0; w < 8; ++w) { pv[w] = *(const f32x2v*)(pall + w * (64 * PW) + ev); dn[w] = pall[w * (64 * PW) + 16]; } } \
            _Pragma("unroll") for (int ks = 0; ks < 2; ++ks) bVn[ks] = *(const bf16x8*)((const bf16*)vtl + (((c_) + 1) & 1) * 1024 + ks * 512 + lane * 8);     \
            _Pragma("unroll") for (int dt = 0; dt < 2; ++dt) _Pragma("unroll") for (int nt = 0; nt < 2; ++nt) { st[dt][nt] = st[dt][nt] * decay; \
                    _Pragma("unroll") for (int ks = 0; ks < 2; ++ks) st[dt][nt] = MFMA16(aK[dt][ks], nt == 0 ? bV[ks] : ones, st[dt][nt]); } \
            __builtin_amdgcn_sched_barrier(0); \
            if (VAR != 1) { const int cn_ = (c_) + 2 < 256 ? (c_) + 2 : 255; SEQ_LOAD(cn_, aQ, aK, ni, oi, zi, di, ei, dec); }     \
            __builtin_amdgcn_sched_barrier(0);     \
            if (VAR != 2) { f32x2v num; num.x = nn0; num.y = nn1; float den = dd; \
                _Pragma("unroll") for (int w = 0; w < 8; ++w) { num += pv[w]; den += dn[w]; } \
                const float rd = __builtin_amdgcn_rcpf(fmaxf(fabsf(den), ee)); \
                const float y0 = num.x * rd * gg0, y1 = num.y * rd * gg1; \
                *(unsigned*)(Y + ((size_t)(c_) * 64 + et) * DM + ecol) = pk2(y0, y1); } } while (0)
        __builtin_amdgcn_sched_barrier(0);
        _Pragma("unroll") for (int ks = 0; ks < 2; ++ks) bV0[ks] = *(const bf16x8*)(vt + ks * 512);
        SEQ_LOAD(0, aQ0, aK0, ni0, oi0, zi0, di0, ei0, dec0);
        __builtin_amdgcn_sched_barrier(0);
        SEQ_LOAD(1, aQ1, aK1, ni1, oi1, zi1, di1, ei1, dec1);
        __builtin_amdgcn_sched_barrier(0);
        for (int c = 0; c < 256; c += 2) {
            SEQ_STEP(c, aQ0, aK0, bV0, bV1, ni0, oi0, zi0, di0, ei0, dec0);
            SEQ_STEP(c + 1, aQ1, aK1, bV1, bV0, ni1, oi1, zi1, di1, ei1, dec1);
        }
#undef SEQ_LOAD
#undef SEQ_STEP
        __syncthreads();
    }
}

__device__ __forceinline__ void final_norm_phase(const bf16* hsrc, const unsigned long long* ss, const float* g, float* out, int tid) {
    const int lane = tid & 63, wave = tid >> 6;
    const int gw = blockIdx.x * NWAVES + wave, NGW = gridDim.x * NWAVES;
    f32x4 gr[8][2];
#pragma unroll
    for (int j = 0; j < 8; ++j) { gr[j][0] = ((const f32x4*)g)[2 * lane + 128 * j]; gr[j][1] = ((const f32x4*)g)[2 * lane + 128 * j + 1]; }
    for (int m = gw; m < SEQ; m += NGW) { const float rs = rsqrtf((float)ss[m] * (1.0f / (1048576.0f * 4096.0f)) + 1e-6f);
        const v4u* xr = (const v4u*)(hsrc + (size_t)m * DM) + lane; f32x4* orow = (f32x4*)(out + (size_t)m * DM) + 2 * lane;
#pragma unroll
        for (int j = 0; j < 8; ++j) { const v4u c = xr[64 * j]; const f32x4 g0 = gr[j][0], g1 = gr[j][1];
            f32x4 a, b; a[0] = __uint_as_float(c.x << 16); a[1] = __uint_as_float(c.x & 0xffff0000u); a[2] = __uint_as_float(c.y << 16); a[3] = __uint_as_float(c.y & 0xffff0000u);
            b[0] = __uint_as_float(c.z << 16); b[1] = __uint_as_float(c.z & 0xffff0000u); b[2] = __uint_as_float(c.w << 16); b[3] = __uint_as_float(c.w & 0xffff0000u);
            orow[128 * j] = a * rs * g0; orow[128 * j + 1] = b * rs * g1; } }
}

constexpr int NPH = 17;
__global__ void __launch_bounds__(NTHR, 2) mk_fwd(Params p) {
    extern __shared__ __attribute__((aligned(16))) unsigned char lds[];
    const int tid = threadIdx.x;
    LAS unsigned char* ldsl = (LAS unsigned char*)lds;
    unsigned char* ws = p.ws;
    if (tid < 64) ((LAS unsigned*)(ldsl + LDS_CTL))[tid] = 0u;
    __syncthreads();
    XcdBarrier bar = xcd_barrier_post((unsigned*)(ws + WS_CTL), (volatile LAS unsigned*)(ldsl + LDS_CTL));
    const int lo = p.ph_lo, hi = p.ph_hi;
#ifdef DBG_ONLY
#define IN(k) ((k) == DBG_ONLY && lo <= (k) && (k) < hi)
#else
#define IN(k) (lo <= (k) && (k) < hi)
#endif
#define SEAM(k) do { if (IN(k) && IN((k) + 1)) xcd_barrier(bar); } while (0)
    unsigned long long* rowss = (unsigned long long*)(ws + WS_ROWSS);
    bf16* HB = (bf16*)(ws + WS_HB); bf16* P0t = (bf16*)(ws + WS_P0); bf16* Yt = (bf16*)(ws + WS_Y);
    const int G = gridDim.x;

    if (IN(0)) { p0_prologue(p, ldsl, tid); } SEAM(0);

    if (NLAYERS > 0) {
    if (IN(1)) { fox_gates(HB, (const bf16*)(ws + WS_WFF0), rowss, late_in(3), (float*)(ws + WS_FLOC), (float*)(ws + WS_FTOT), tid);
        pg8::Gemm g{HB, (const bf16*)(ws + WS_WFI0), SEQ, 16384, DM}; pg8::StaticOrder S; S.init(SEQ, 16384, G, (int)blockIdx.x);
        pg8::EpiIn<true> E{P0t, (size_t)SEQ * DM, rowss, (unsigned*)(ws + WS_NRM)};
        pg8::gemm_phase<pg8::EpiIn<true>, pg8::StaticOrder, true, true>(ldsl, g, S, E); } SEAM(1);
    if (IN(2)) { fox_attn_phase((char*)lds, P0t, P0t + (size_t)SEQ * DM, (const float*)(ws + WS_FLOC), (const float*)(ws + WS_FTOT), (const unsigned*)(ws + WS_NRM), (unsigned*)(ws + WS_QCNT), tid); } SEAM(2);
    if (IN(3)) { pg8::Gemm g{Yt, (const bf16*)(ws + WS_WFO0), SEQ, DM, DM}; pg8::StaticOrder S; S.init(SEQ, DM, G, (int)blockIdx.x);
        pg8::EpiOut E{HB, rowss + SEQ};
        pg8::gemm_phase<pg8::EpiOut, pg8::StaticOrder, true, true>(ldsl, g, S, E); } SEAM(3);
    }
    if (NLAYERS > 1) {
    if (IN(4)) { pg8::Gemm g{HB, (const bf16*)(ws + WS_WLI), SEQ, 8192, DM}; pg8::StaticOrder S; S.init(SEQ, 8192, G, (int)blockIdx.x);
        pg8::EpiIn<false> E{P0t, (size_t)SEQ * DM, rowss + SEQ, (unsigned*)nullptr};
        pg8::gemm_phase<pg8::EpiIn<false>, pg8::StaticOrder, true, true>(ldsl, g, S, E); } SEAM(4);
    if (IN(5)) { lru_scan_phase((char*)lds, p, tid); } SEAM(5);
    if (IN(6)) { lru_fix_phase(p, tid); } SEAM(6);
    if (IN(7)) { pg8::Gemm g{Yt, (const bf16*)(ws + WS_WLO), SEQ, DM, DM}; pg8::StaticOrder S; S.init(SEQ, DM, G, (int)blockIdx.x);
        pg8::EpiOut E{HB, rowss + 2 * SEQ};
        pg8::gemm_phase<pg8::EpiOut, pg8::StaticOrder, true, true>(ldsl, g, S, E); } SEAM(7);
    }
    if (NLAYERS > 2) {
    if (IN(8)) { mlstm_gates(HB, (const bf16*)(ws + WS_WMG), rowss + 2 * SEQ, late_in(15), late_in(16), (float*)(ws + WS_IG), (float*)(ws + WS_LF), tid);
        pg8::Gemm g{HB, (const bf16*)(ws + WS_WMI), SEQ, 16384, DM}; pg8::StaticOrder S; S.init(SEQ, 16384, G, (int)blockIdx.x);
        pg8::EpiIn<false> E{P0t, (size_t)SEQ * DM, rowss + 2 * SEQ, (unsigned*)nullptr};
        pg8::gemm_phase<pg8::EpiIn<false>, pg8::StaticOrder, true, true>(ldsl, g, S, E); } SEAM(8);
    if (IN(9)) { mlstm_scalars_phase((char*)lds, p, tid); } SEAM(9);
    if (IN(10)) { mlstm_pre_phase((char*)lds, p, tid); } SEAM(10);
    if (IN(11)) { mlstm_seq_phase<0>((char*)lds, p, tid); } SEAM(11);
    if (IN(12)) { pg8::Gemm g{Yt, (const bf16*)(ws + WS_WMO), SEQ, DM, DM}; pg8::StaticOrder S; S.init(SEQ, DM, G, (int)blockIdx.x);
        pg8::EpiOut E{HB, rowss + 3 * SEQ};
        pg8::gemm_phase<pg8::EpiOut, pg8::StaticOrder, true, true>(ldsl, g, S, E); } SEAM(12);
    }
    if (NLAYERS > 3) {
    if (IN(13)) { fox_gates(HB, (const bf16*)(ws + WS_WFF1), rowss + 3 * SEQ, late_in(3) + 32, (float*)(ws + WS_FLOC), (float*)(ws + WS_FTOT), tid);
        pg8::Gemm g{HB, (const bf16*)(ws + WS_WFI1), SEQ, 16384, DM}; pg8::StaticOrder S; S.init(SEQ, 16384, G, (int)blockIdx.x);
        pg8::EpiIn<true> E{P0t, (size_t)SEQ * DM, rowss + 3 * SEQ, (unsigned*)(ws + WS_NRM) + 256};
        pg8::gemm_phase<pg8::EpiIn<true>, pg8::StaticOrder, true, true>(ldsl, g, S, E); } SEAM(13);
    if (IN(14)) { fox_attn_phase((char*)lds, P0t, P0t + (size_t)SEQ * DM, (const float*)(ws + WS_FLOC), (const float*)(ws + WS_FTOT), (const unsigned*)(ws + WS_NRM) + 256, (unsigned*)(ws + WS_QCNT) + 512, tid); } SEAM(14);
    if (IN(15)) { pg8::Gemm g{Yt, (const bf16*)(ws + WS_WFO1), SEQ, DM, DM}; pg8::StaticOrder S; S.init(SEQ, DM, G, (int)blockIdx.x);
        pg8::EpiOut E{HB, rowss + 4 * SEQ};
        pg8::gemm_phase<pg8::EpiOut, pg8::StaticOrder, true, true>(ldsl, g, S, E); } SEAM(15);
    }
    if (IN(16)) { final_norm_phase(HB, rowss + NLAYERS * SEQ, late_in(18), late_out(), tid); }
#undef IN
#undef SEAM
}

#ifndef MK_N_LAUNCHES
#define MK_N_LAUNCHES 1
#endif
extern "C" void kernel_launch(void* const* d_in, const int* in_sizes, int n_in, void* d_out, int out_size, void* d_ws, size_t ws_size, hipStream_t stream) {
    static int grid = 0;
    if (grid == 0) {
        if (n_in != 19 || out_size != SEQ * DM || ws_size < WS_END) { fprintf(stderr, "kernel_launch: unexpected shapes (n_in %d out %d ws %zu, need ws >= %zu)\n", n_in, out_size, ws_size, (size_t)WS_END); grid = -1; return; }
        int dev = 0, cus = 0, per_cu = 0;
        if (hipGetDevice(&dev) != hipSuccess || hipDeviceGetAttribute(&cus, hipDeviceAttributeMultiprocessorCount, dev) != hipSuccess) { grid = -1; return; }
        if (hipFuncSetAttribute((const void*)mk_fwd, hipFuncAttributeMaxDynamicSharedMemorySize, LDS_BYTES) != hipSuccess) { fprintf(stderr, "kernel_launch: hipFuncSetAttribute failed\n"); grid = -1; return; }
        if (hipOccupancyMaxActiveBlocksPerMultiprocessor(&per_cu, (const void*)mk_fwd, NTHR, LDS_BYTES) != hipSuccess || per_cu < 1) { fprintf(stderr, "kernel_launch: occupancy query says %d\n", per_cu); }
        (void)hipGetLastError();
        grid = cus;
    }
    if (grid < 0) return;
    (void)hipMemsetAsync((char*)d_ws + WS_CTL, 0, CTL_ZERO_BYTES, stream);
    Params p{};
    for (int i = 0; i < 19; ++i) p.in[i] = (const float*)d_in[i];
    p.out = (float*)d_out; p.ws = (unsigned char*)d_ws;
#if MK_N_LAUNCHES == 1
    p.ph_lo = 0; p.ph_hi = NPH;
    hipLaunchKernelGGL(mk_fwd, dim3(grid), dim3(NTHR), LDS_BYTES, stream, p);
#else
    for (int k = 0; k < NPH; ++k) { p.ph_lo = k; p.ph_hi = k + 1; hipLaunchKernelGGL(mk_fwd, dim3(grid), dim3(NTHR), LDS_BYTES, stream, p); }
#endif
}
```

```cpp
#include <hip/hip_runtime.h>
#include <cstdio>
#include <cstdint>
namespace pg8 {
#define PG8_LAS __attribute__((address_space(3)))
typedef unsigned short bf16_t;
typedef short bf16x8 __attribute__((ext_vector_type(8)));
typedef float f32x4 __attribute__((ext_vector_type(4)));
typedef unsigned u32x4 __attribute__((ext_vector_type(4)));
constexpr int BM = 256, BK = 64, HALF = 128, HTB = HALF * BK * 2  , STAGE_BYTES = 8 * HTB, NXCD = 8, WGM = 8;

__host__ __device__ __forceinline__ int lds_byte(int r, int c) { const int st = (r >> 4) * 2 + (c >> 5), rr = r & 15, cc = c & 31, ob = rr * 64 + cc * 2; return st * 1024 + (ob ^ (((ob >> 9) & 1) << 5)); }
__host__ __device__ __forceinline__ void stage_rc(int b, int& R, int& C) { const int st = b / 1024, sb = b % 1024, swz = sb ^ (((sb >> 9) & 1) << 5); R = (st >> 1) * 16 + swz / 64; C = (st & 1) * 32 + (swz % 64) / 2; }
__host__ __device__ __forceinline__ int perm32(int rho) { const int n = rho >> 4, i = rho & 15; return 8 * (i >> 2) + 4 * n + (i & 3); }

struct Unit { int pm, pn; };
struct Gemm { const bf16_t* A; const bf16_t* Bt; int M, N, K; };

struct StaticOrder {
    int nM, nN, nwg, G, c;
    __host__ __device__ void init(int M, int N, int G_, int c_) { nM = M / BM; nN = N / BM; nwg = nM * nN; G = G_; c = c_; }
    __host__ __device__ bool next(int i, Unit& u) const {
        const long L = (long)i * G + c; if (L >= nwg) return false;
        int wgid = (int)L; { const int q = nwg / NXCD, r = nwg % NXCD, xcd = wgid % NXCD, off = wgid / NXCD; wgid = (xcd < r ? xcd * (q + 1) : r * (q + 1) + (xcd - r) * q) + off; }
        const int nig = WGM * nN, gid = wgid / nig, fm = gid * WGM, gsz = (nM - fm) < WGM ? (nM - fm) : WGM;
        u.pm = fm + ((wgid % nig) % gsz); u.pn = (wgid % nig) / gsz; return true;
    }
    __device__ __forceinline__ void a_ready(const Unit&) const {}
    __device__ __forceinline__ void done(const Unit&) const {}
};

__device__ __forceinline__ unsigned cvt_pk_bf16(float lo, float hi) { unsigned r; asm volatile("v_cvt_pk_bf16_f32 %0, %1, %2" : "=v"(r) : "v"(lo), "v"(hi)); return r; }

template <bool NORMS> struct EpiIn {
    static constexpr bool PERM = true, AFTER_DRAIN = false;
    bf16_t* O; size_t tstride; const unsigned long long* rowss;
    unsigned* nrm;
    __device__ __forceinline__ void operator()(const f32x4 (&acc)[2][2][4][2], const Unit& u, int wr, int wc, int fr, int fq) const {
        const int row0 = u.pm * BM + wr * 64 + fr; int colt = u.pn * BM;
        const int tens = colt >> 12;
        bf16_t* base = O + (size_t)tens * tstride; colt &= 4095;
        const int col0 = colt + wc * 32 + 8 * fq;
        unsigned long long sq[8];
#pragma unroll
        for (int g = 0; g < 8; ++g) sq[g] = rowss[row0 + (g >> 2) * HALF + (g & 3) * 16];
        float nmax[2] = {0.f, 0.f};
#pragma unroll
        for (int ai = 0; ai < 2; ++ai)
#pragma unroll
            for (int m = 0; m < 4; ++m) { const int row = row0 + ai * HALF + m * 16; const float rs = rsqrtf((float)sq[ai * 4 + m] * (1.0f / (1048576.0f * 4096.0f)) + 1e-6f);
                bf16_t* rowp = base + (size_t)row * 4096 + col0;
#pragma unroll
                for (int bj = 0; bj < 2; ++bj) { const f32x4 v0 = acc[ai][bj][m][0] * rs, v1 = acc[ai][bj][m][1] * rs;
                    u32x4 w; w.x = cvt_pk_bf16(v0[0], v0[1]); w.y = cvt_pk_bf16(v0[2], v0[3]); w.z = cvt_pk_bf16(v1[0], v1[1]); w.w = cvt_pk_bf16(v1[2], v1[3]);
                    *(u32x4*)(rowp + bj * HALF) = w;
                    if (NORMS && tens < 2) { float s = ((v0[0] * v0[0] + v0[1] * v0[1]) + (v0[2] * v0[2] + v0[3] * v0[3])) + ((v1[0] * v1[0] + v1[1] * v1[1]) + (v1[2] * v1[2] + v1[3] * v1[3]));
                        s += __shfl_xor(s, 16); s += __shfl_xor(s, 32); nmax[bj] = fmaxf(nmax[bj], s); } } }
        if (NORMS && tens < 2) {
#pragma unroll
            for (int bj = 0; bj < 2; ++bj) { float s = nmax[bj]; s = fmaxf(s, __shfl_xor(s, 1)); s = fmaxf(s, __shfl_xor(s, 2)); s = fmaxf(s, __shfl_xor(s, 4)); s = fmaxf(s, __shfl_xor(s, 8));
                if (fr == 0 && fq == 0) __hip_atomic_fetch_max(nrm + ((tens * 32 + (colt >> 7) + bj) * 4 + wc), __float_as_uint(s), __ATOMIC_RELAXED, __HIP_MEMORY_SCOPE_AGENT); } }
    }
};
struct EpiOut {
    static constexpr bool PERM = true, AFTER_DRAIN = false;
    bf16_t* hb; unsigned long long* ss_next;
    __device__ __forceinline__ void operator()(const f32x4 (&acc)[2][2][4][2], const Unit& u, int wr, int wc, int fr, int fq) const {
        const int row0 = u.pm * BM + wr * 64 + fr, col0 = u.pn * BM + wc * 32 + 8 * fq;
        float ssr[8]; u32x4 cur[2], nxt[2];
#pragma unroll
        for (int bj = 0; bj < 2; ++bj) cur[bj] = *(const u32x4*)(hb + (size_t)row0 * 4096 + col0 + bj * HALF);
#pragma unroll
        for (int g = 0; g < 8; ++g) { const int ai = g >> 2, m = g & 3; bf16_t* rowp = hb + (size_t)(row0 + ai * HALF + m * 16) * 4096 + col0;
            if (g < 7) { const bf16_t* rown = hb + (size_t)(row0 + ((g + 1) >> 2) * HALF + ((g + 1) & 3) * 16) * 4096 + col0;
#pragma unroll
                for (int bj = 0; bj < 2; ++bj) nxt[bj] = *(const u32x4*)(rown + bj * HALF); }
            float ss = 0.f;
#pragma unroll
            for (int bj = 0; bj < 2; ++bj) { const u32x4 c = cur[bj];
                f32x4 o0, o1;
                o0[0] = __uint_as_float(c.x << 16) + acc[ai][bj][m][0][0]; o0[1] = __uint_as_float(c.x & 0xffff0000u) + acc[ai][bj][m][0][1];
                o0[2] = __uint_as_float(c.y << 16) + acc[ai][bj][m][0][2]; o0[3] = __uint_as_float(c.y & 0xffff0000u) + acc[ai][bj][m][0][3];
                o1[0] = __uint_as_float(c.z << 16) + acc[ai][bj][m][1][0]; o1[1] = __uint_as_float(c.z & 0xffff0000u) + acc[ai][bj][m][1][1];
                o1[2] = __uint_as_float(c.w << 16) + acc[ai][bj][m][1][2]; o1[3] = __uint_as_float(c.w & 0xffff0000u) + acc[ai][bj][m][1][3];
                u32x4 w; w.x = cvt_pk_bf16(o0[0], o0[1]); w.y = cvt_pk_bf16(o0[2], o0[3]); w.z = cvt_pk_bf16(o1[0], o1[1]); w.w = cvt_pk_bf16(o1[2], o1[3]);
                *(u32x4*)(rowp + bj * HALF) = w;
                const float r0 = __uint_as_float(w.x << 16), r1 = __uint_as_float(w.x & 0xffff0000u), r2 = __uint_as_float(w.y << 16), r3 = __uint_as_float(w.y & 0xffff0000u);
                const float r4 = __uint_as_float(w.z << 16), r5 = __uint_as_float(w.z & 0xffff0000u), r6 = __uint_as_float(w.w << 16), r7 = __uint_as_float(w.w & 0xffff0000u);
                ss += ((r0 * r0 + r1 * r1) + (r2 * r2 + r3 * r3)) + ((r4 * r4 + r5 * r5) + (r6 * r6 + r7 * r7)); }
            ss += __shfl_xor(ss, 16); ss += __shfl_xor(ss, 32); ssr[g] = ss;
#pragma unroll
            for (int bj = 0; bj < 2; ++bj) cur[bj] = nxt[bj];
            asm volatile("" ::: "memory"); }
        if (fq == 0) {
#pragma unroll
            for (int g = 0; g < 8; ++g) __hip_atomic_fetch_add(ss_next + row0 + (g >> 2) * HALF + (g & 3) * 16, (unsigned long long)(ssr[g] * 1048576.0f + 0.5f), __ATOMIC_RELAXED, __HIP_MEMORY_SCOPE_AGENT); }
    }
};

template <class Epi, class Sched, bool ALIGN_EPI = false, bool SP2 = false>
__device__ __forceinline__ void gemm_phase(PG8_LAS unsigned char* lds, const Gemm g, const Sched& S, const Epi& E) {
    const int tid = threadIdx.x, wid = __builtin_amdgcn_readfirstlane(tid >> 6), lane = tid & 63, wr = wid >> 2, wc = wid & 3, fr = lane & 15, fq = lane >> 4;
    const int K = g.K, nt = K / BK;
    unsigned voffA[2], voffB[2];
#pragma unroll
    for (int i = 0; i < 2; ++i) { int R, C; stage_rc(tid * 16 + i * 8192, R, C); const int Rb = Epi::PERM ? ((R & ~31) + perm32(R & 31)) : R;
        voffA[i] = (unsigned)(R * K + C) * 2u; voffB[i] = (unsigned)(Rb * K + C) * 2u; }
    const size_t kstep = (size_t)(BK * 2);
    const size_t hstep = (size_t)HALF * K * 2;
    const size_t tstep = 2 * hstep;
    const unsigned ldsw = (unsigned)wid * 1024u;
    const int aoff = lds_byte(wr * 64 + fr, fq * 8), boff = lds_byte(wc * 32 + fr, fq * 8);
#define PG8_SA(b, h) (((b) * 2 + (h)) * HTB)
#define PG8_SB(b, h) ((4 + (b) * 2 + (h)) * HTB)
#define PG8_STAGE(bufoff, gbase, voff) do { _Pragma("unroll") for (int _i = 0; _i < 2; ++_i) \
        __builtin_amdgcn_global_load_lds((const unsigned*)((const char*)(gbase) + (voff)[_i]), (PG8_LAS unsigned*)(lds + (bufoff) + ldsw + _i * 8192), 16, 0, 0); } while (0)
#define PG8_LDA(dst, b, h) do { _Pragma("unroll") for (int m = 0; m < 4; ++m) _Pragma("unroll") for (int k = 0; k < 2; ++k) dst[m][k] = *(const PG8_LAS bf16x8*)(lds + PG8_SA(b, h) + aoff + m * 2048 + k * 1024); } while (0)
#define PG8_LDB(dst, b, h) do { _Pragma("unroll") for (int n = 0; n < 2; ++n) _Pragma("unroll") for (int k = 0; k < 2; ++k) dst[n][k] = *(const PG8_LAS bf16x8*)(lds + PG8_SB(b, h) + boff + n * 2048 + k * 1024); } while (0)
#define PG8_MMA(ai, bj, At, Bt) do { __builtin_amdgcn_s_setprio(1); _Pragma("unroll") for (int m = 0; m < 4; ++m) _Pragma("unroll") for (int n = 0; n < 2; ++n) _Pragma("unroll") for (int k = 0; k < 2; ++k) \
        acc[ai][bj][m][n] = __builtin_amdgcn_mfma_f32_16x16x32_bf16(Bt[n][k], At[m][k], acc[ai][bj][m][n], 0, 0, 0); __builtin_amdgcn_s_setprio(0); } while (0)
#define PG8_WAIT_V(n) asm volatile("s_waitcnt vmcnt(" #n ")" ::: "memory")
#define PG8_WAIT_L(n) asm volatile("s_waitcnt lgkmcnt(" #n ")" ::: "memory")
#define PG8_BAR __builtin_amdgcn_s_barrier()
#define PG8_SCHED __builtin_amdgcn_sched_barrier(0)
    Unit cur, nxt; int ui = 0;
    if (!S.next(0, cur)) return;
    f32x4 acc[2][2][4][2];
#pragma unroll
    for (int a = 0; a < 2; ++a)
#pragma unroll
        for (int b = 0; b < 2; ++b)
#pragma unroll
            for (int m = 0; m < 4; ++m)
#pragma unroll
                for (int n = 0; n < 2; ++n) acc[a][b][m][n] = (f32x4){0.f, 0.f, 0.f, 0.f};
    bf16x8 At[4][2], B0[2][2], B1[2][2];
    const char* cA = (const char*)g.A + (size_t)cur.pm * tstep; const char* cB = (const char*)g.Bt + (size_t)cur.pn * tstep;
    S.a_ready(cur);
    if constexpr (SP2) {
        PG8_STAGE(PG8_SB(0, 0), cB, voffB); PG8_STAGE(PG8_SB(0, 1), cB + hstep, voffB); PG8_STAGE(PG8_SA(0, 0), cA, voffA); PG8_STAGE(PG8_SA(0, 1), cA + hstep, voffA);
        if (wr == 1) PG8_BAR;
        PG8_WAIT_V(2); PG8_BAR;
        PG8_STAGE(PG8_SB(1, 0), cB + kstep, voffB); PG8_STAGE(PG8_SA(1, 0), cA + kstep, voffA); PG8_STAGE(PG8_SB(1, 1), cB + hstep + kstep, voffB);
        PG8_WAIT_V(6); PG8_BAR;
    } else {
        PG8_STAGE(PG8_SB(0, 0), cB, voffB); PG8_STAGE(PG8_SA(0, 0), cA, voffA); PG8_STAGE(PG8_SB(0, 1), cB + hstep, voffB); PG8_STAGE(PG8_SA(0, 1), cA + hstep, voffA);
        if (wr == 1) PG8_BAR;
        PG8_WAIT_V(4); PG8_BAR;
        PG8_STAGE(PG8_SB(1, 0), cB + kstep, voffB); PG8_STAGE(PG8_SA(1, 0), cA + kstep, voffA); PG8_STAGE(PG8_SB(1, 1), cB + hstep + kstep, voffB);
        PG8_WAIT_V(6); PG8_BAR;
    }
    for (;;) {
        const bool has_next = S.next(ui + 1, nxt);
        const char* nA = has_next ? (const char*)g.A + (size_t)nxt.pm * tstep : cA; const char* nB = has_next ? (const char*)g.Bt + (size_t)nxt.pn * tstep : cB;
        asm volatile(".p2align 6");
        for (int t = 0; t < nt; t += 2) {
            const bool last = (t == nt - 2);
            const char* a1 = cA + (size_t)(t + 1) * kstep;
            const char* a2 = last ? nA : cA + (size_t)(t + 2) * kstep; const char* b2 = last ? nB : cB + (size_t)(t + 2) * kstep;
            const char* a3 = a2 + kstep; const char* b3 = b2 + kstep;
            if (last && has_next) S.a_ready(nxt);
            if constexpr (SP2) {
            PG8_LDB(B0, 0, 0); PG8_LDB(B1, 0, 1); PG8_SCHED; PG8_LDA(At, 0, 0); PG8_STAGE(PG8_SA(1, 1), a1 + hstep, voffA);
            PG8_WAIT_V(8); PG8_WAIT_L(0); PG8_BAR; PG8_MMA(0, 0, At, B0); PG8_MMA(0, 1, At, B1); PG8_BAR; PG8_SCHED;
            PG8_LDA(At, 0, 1); PG8_STAGE(PG8_SB(0, 0), b2, voffB); PG8_STAGE(PG8_SB(0, 1), b2 + hstep, voffB); PG8_STAGE(PG8_SA(0, 0), a2, voffA);
            PG8_WAIT_V(8); PG8_WAIT_L(0); PG8_BAR; PG8_MMA(1, 0, At, B0); PG8_MMA(1, 1, At, B1); PG8_BAR; PG8_SCHED;
            PG8_LDB(B0, 1, 0); PG8_LDB(B1, 1, 1); PG8_SCHED; PG8_LDA(At, 1, 0); PG8_STAGE(PG8_SA(0, 1), a2 + hstep, voffA);
            PG8_WAIT_V(8); PG8_WAIT_L(0); PG8_BAR; PG8_MMA(0, 0, At, B0); PG8_MMA(0, 1, At, B1); PG8_BAR; PG8_SCHED;
            PG8_LDA(At, 1, 1); PG8_STAGE(PG8_SB(1, 0), b3, voffB); PG8_STAGE(PG8_SB(1, 1), b3 + hstep, voffB); PG8_STAGE(PG8_SA(1, 0), a3, voffA);
            PG8_WAIT_V(8); PG8_WAIT_L(0); PG8_BAR; PG8_MMA(1, 0, At, B0); PG8_MMA(1, 1, At, B1); PG8_BAR; PG8_SCHED;
            } else {
            PG8_LDB(B0, 0, 0); PG8_SCHED; PG8_LDA(At, 0, 0); PG8_STAGE(PG8_SA(1, 1), a1 + hstep, voffA);
            PG8_WAIT_L(8); PG8_BAR; PG8_WAIT_L(0); PG8_MMA(0, 0, At, B0); PG8_BAR; PG8_SCHED;
            PG8_LDB(B1, 0, 1); PG8_STAGE(PG8_SB(0, 0), b2, voffB);
            PG8_BAR; PG8_WAIT_L(0); PG8_MMA(0, 1, At, B1); PG8_BAR;
            PG8_LDA(At, 0, 1); PG8_STAGE(PG8_SA(0, 0), a2, voffA);
            PG8_BAR; PG8_WAIT_L(0); PG8_MMA(1, 0, At, B0); PG8_BAR; PG8_SCHED;
            PG8_STAGE(PG8_SB(0, 1), b2 + hstep, voffB);
            PG8_WAIT_V(6); PG8_BAR; PG8_MMA(1, 1, At, B1); PG8_BAR;
            PG8_LDB(B0, 1, 0); PG8_SCHED; PG8_LDA(At, 1, 0); PG8_STAGE(PG8_SA(0, 1), a2 + hstep, voffA);
            PG8_WAIT_L(8); PG8_BAR; PG8_WAIT_L(0); PG8_MMA(0, 0, At, B0); PG8_BAR; PG8_SCHED;
            PG8_LDB(B1, 1, 1); PG8_STAGE(PG8_SB(1, 0), b3, voffB);
            PG8_BAR; PG8_WAIT_L(0); PG8_MMA(0, 1, At, B1); PG8_BAR;
            PG8_LDA(At, 1, 1); PG8_STAGE(PG8_SA(1, 0), a3, voffA);
            PG8_BAR; PG8_WAIT_L(0); PG8_MMA(1, 0, At, B0); PG8_BAR; PG8_SCHED;
            PG8_STAGE(PG8_SB(1, 1), b3 + hstep, voffB);
            PG8_WAIT_V(6); PG8_BAR; PG8_MMA(1, 1, At, B1); PG8_BAR;
            }
        }
        if constexpr (ALIGN_EPI) { if (wr == 0) PG8_BAR; }
        if constexpr (!Epi::AFTER_DRAIN) { E(acc, cur, wr, wc, fr, fq); S.done(cur); }
        if (!has_next) break;
#pragma unroll
        for (int a = 0; a < 2; ++a)
#pragma unroll
            for (int b = 0; b < 2; ++b)
#pragma unroll
                for (int m = 0; m < 4; ++m)
#pragma unroll
                    for (int n = 0; n < 2; ++n) acc[a][b][m][n] = (f32x4){0.f, 0.f, 0.f, 0.f};
        cur = nxt; cA = nA; cB = nB; ++ui;
        if constexpr (ALIGN_EPI) { if (wr == 1) PG8_BAR; }
    }
    PG8_WAIT_V(0);
    if constexpr (!ALIGN_EPI) { if (wr == 0) PG8_BAR; }
    PG8_BAR;
    if constexpr (Epi::AFTER_DRAIN) { E.fused(acc, cur, wr, wc, fr, fq, lds, wid, lane); S.done(cur); }
#undef PG8_SA
#undef PG8_SB
#undef PG8_STAGE
#undef PG8_LDA
#undef PG8_LDB
#undef PG8_MMA
#undef PG8_WAIT_V
#undef PG8_WAIT_L
#undef PG8_BAR
#undef PG8_SCHED
}
}
namespace fa {

constexpr int D = 128, LD = 4096;
constexpr float SCALE = 0.08838834764831845f;
constexpr float INV_SCALE = 11.313708498984761f;
constexpr float THR = 8.f;
constexpr bool WSKIP = false;
constexpr int NW = 8, QBLK = 32, KVBLK = 64, QB = NW * QBLK;
constexpr int SHM_V = KVBLK * D * 2, SHM_K = KVBLK * D * 2;
constexpr int LDS_BODY = 2 * SHM_V + 2 * SHM_K + NW * 64 * 4;
using bf16 = unsigned short;
typedef short bf16x8 __attribute__((ext_vector_type(8)));
typedef short s16x4 __attribute__((ext_vector_type(4)));
typedef float f32x16 __attribute__((ext_vector_type(16)));
typedef float f32x4 __attribute__((ext_vector_type(4)));
typedef unsigned u32x4 __attribute__((ext_vector_type(4)));
template <class A, class Bt> struct same_t { static constexpr bool v = false; };
template <class A> struct same_t<A, A> { static constexpr bool v = true; };

#define KSWZ(row, colB) ((row) * 256 + ((colB) ^ (((row) & 7) << 4)))
#define SBAR() __builtin_amdgcn_sched_barrier(0)
__device__ __forceinline__ int v_st(int k, int c) { const int kk = (k & ~0xC) | ((k & 4) << 1) | ((k & 8) >> 1); return ((kk >> 3) * 4 + (c >> 5)) * 512 + ((kk & 7) * 32 + (c & 31)) * 2; }
__device__ __forceinline__ int v_rd_base(int lane) { return ((lane & 3) << 3) | (((lane >> 2) & 3) << 6) | (((lane >> 4) & 1) << 5) | (((lane >> 5) & 1) << 8); }
constexpr int v_rd_off(int d0, int ks, int half) { return d0 * 512 + ks * 4096 + half * 2048; }
__device__ __forceinline__ int crow(int r, int hi) { return (r & 3) + 8 * (r >> 2) + 4 * hi; }
__device__ __forceinline__ unsigned cvtpk(float lo, float hi) {
    unsigned r; asm volatile("v_cvt_pk_bf16_f32 %0, %1, %2" : "=v"(r) : "v"(lo), "v"(hi)); return r;
}
__device__ __forceinline__ bf16x8 pack8(f32x4 a, f32x4 b) {
    u32x4 w = {cvtpk(a[0], a[1]), cvtpk(a[2], a[3]), cvtpk(b[0], b[1]), cvtpk(b[2], b[3])};
    return *reinterpret_cast<bf16x8*>(&w);
}
template <class T> __device__ __forceinline__ bf16x8 load8(const T* p) {
    if constexpr (same_t<T, float>::v) { return pack8(*(const f32x4*)p, *(const f32x4*)(p + 4)); }
    else { return *reinterpret_cast<const bf16x8*>(p); }
}
__device__ __forceinline__ void mask_tile(f32x16& p0, f32x16& p1, int dq, unsigned W) {
    const float NEG = -__builtin_inff();
#pragma unroll
    for (int r = 0; r < 16; ++r) {
        const int c = (r & 3) + 8 * (r >> 2);
        if ((unsigned)(dq - c) >= W) p0[r] = NEG;
        if ((unsigned)(dq - c - 32) >= W) p1[r] = NEG;
    }
}
__device__ __forceinline__ void partialSM(f32x16& p0, f32x16& p1, float& m_reg, float& mn, float& alpha) {
    float pmax = p0[0]; for (int r = 1; r < 16; ++r) pmax = fmaxf(pmax, p0[r]); for (int r = 0; r < 16; ++r) pmax = fmaxf(pmax, p1[r]);
    { auto rr = __builtin_amdgcn_permlane32_swap(__float_as_uint(pmax), __float_as_uint(pmax), false, false);
      pmax = fmaxf(__uint_as_float(rr[0]), __uint_as_float(rr[1])); }
    constexpr float C2 = 1.4426950408889634f * SCALE;
    if (__builtin_expect(__all((pmax - m_reg) * SCALE <= THR), 1)) { mn = m_reg; alpha = 1.f; }
    else { mn = fmaxf(m_reg, pmax); alpha = __builtin_amdgcn_exp2f((m_reg - mn) * C2); m_reg = mn; }
    const float mnL = -mn * C2;
    for (int r = 0; r < 16; ++r) p0[r] = fmaf(p0[r], C2, mnL); for (int r = 0; r < 16; ++r) p1[r] = fmaf(p1[r], C2, mnL);
    for (int r = 0; r < 16; ++r) p0[r] = __builtin_amdgcn_exp2f(p0[r]);
}
__device__ __forceinline__ void finishSM(f32x16& p0, f32x16& p1, float alpha, float& l_reg, bf16x8& pa0, bf16x8& pa1, bf16x8& pa2, bf16x8& pa3) {
    for (int r = 0; r < 16; ++r) p1[r] = __builtin_amdgcn_exp2f(p1[r]);
    float ps = 0; for (int r = 0; r < 16; ++r) ps += p0[r]; for (int r = 0; r < 16; ++r) ps += p1[r];
    { auto rr = __builtin_amdgcn_permlane32_swap(__float_as_uint(ps), __float_as_uint(ps), false, false);
      ps = __uint_as_float(rr[0]) + __uint_as_float(rr[1]); }
    l_reg = l_reg * alpha + ps;
#define PK4(P, B_, OUT) do { unsigned a0 = cvtpk(P[B_+0], P[B_+1]), a1 = cvtpk(P[B_+2], P[B_+3]);                          \
        unsigned b0 = cvtpk(P[B_+4], P[B_+5]), b1 = cvtpk(P[B_+6], P[B_+7]);                                             \
        auto r0 = __builtin_amdgcn_permlane32_swap(a0, b0, false, false); auto r1 = __builtin_amdgcn_permlane32_swap(a1, b1, false, false); \
        u32x4 w = {r0[0], r1[0], r0[1], r1[1]}; OUT = *reinterpret_cast<bf16x8*>(&w); } while (0)
    PK4(p0, 0, pa0); PK4(p0, 8, pa1); PK4(p1, 0, pa2); PK4(p1, 8, pa3);
#undef PK4
}
template <int KB, bool SK>
__device__ __forceinline__ void qkt(f32x16& p0, f32x16& p1, const char* K_lds, int r32, int hi, const bf16x8* qr, bool act, const __attribute__((address_space(3))) float* fk, float ft) {
    if (SK && !act) { const float NEG = -__builtin_inff();
#pragma unroll
        for (int r = 0; r < 16; ++r) { p0[r] = NEG; p1[r] = NEG; } return; }
#pragma unroll
    for (int g = 0; g < 4; ++g) { const f32x4 a = *(const __attribute__((address_space(3))) f32x4*)(fk + 8 * g), b = *(const __attribute__((address_space(3))) f32x4*)(fk + 32 + 8 * g);
#pragma unroll
        for (int i = 0; i < 4; ++i) { p0[4 * g + i] = ft - a[i]; p1[4 * g + i] = ft - b[i]; } }
    const char* kb[4];
#pragma unroll
    for (int dd = 0; dd < 4; ++dd) kb[dd] = K_lds + KB * SHM_K + KSWZ(r32, (dd * 16 + hi * 8) * 2);
#pragma unroll
    for (int d0 = 0; d0 < 8; ++d0) { const char* a = kb[d0 & 3] + (d0 >> 2) * 128;
        bf16x8 b0 = *reinterpret_cast<const bf16x8*>(a);
        bf16x8 b1 = *reinterpret_cast<const bf16x8*>(a + 32 * 256);
        p0 = __builtin_amdgcn_mfma_f32_32x32x16_bf16(b0, qr[d0], p0, 0, 0, 0);
        p1 = __builtin_amdgcn_mfma_f32_32x32x16_bf16(b1, qr[d0], p1, 0, 0, 0); }
}
template <int VB, bool SK>
__device__ __forceinline__ void pv_tile(f32x16* o, int vb0, bf16x8 pa0, bf16x8 pa1, bf16x8 pa2, bf16x8 pa3, bool act) {
    if (SK && !act) return;
#define TRRD(dst, off) asm volatile("ds_read_b64_tr_b16 %0, %1 offset:%2" : "=&v"(dst) : "v"(vb0), "i"(off) : "memory")
#define PV_D0(d0) do { s16x4 l0, l1, l2, l3, h0, h1, h2, h3; constexpr int b_ = VB * SHM_V + v_rd_off(d0, 0, 0);     \
        TRRD(l0, b_); TRRD(h0, b_ + 2048); TRRD(l1, b_ + 4096); TRRD(h1, b_ + 6144); TRRD(l2, b_ + 8192); TRRD(h2, b_ + 10240); TRRD(l3, b_ + 12288); TRRD(h3, b_ + 14336); \
        asm volatile("s_waitcnt lgkmcnt(0)" ::: "memory"); SBAR();                 \
        o[d0] = __builtin_amdgcn_mfma_f32_32x32x16_bf16(pa0, (bf16x8){l0[0], l0[1], l0[2], l0[3], h0[0], h0[1], h0[2], h0[3]}, o[d0], 0, 0, 0);   \
        o[d0] = __builtin_amdgcn_mfma_f32_32x32x16_bf16(pa1, (bf16x8){l1[0], l1[1], l1[2], l1[3], h1[0], h1[1], h1[2], h1[3]}, o[d0], 0, 0, 0);   \
        o[d0] = __builtin_amdgcn_mfma_f32_32x32x16_bf16(pa2, (bf16x8){l2[0], l2[1], l2[2], l2[3], h2[0], h2[1], h2[2], h2[3]}, o[d0], 0, 0, 0);   \
        o[d0] = __builtin_amdgcn_mfma_f32_32x32x16_bf16(pa3, (bf16x8){l3[0], l3[1], l3[2], l3[3], h3[0], h3[1], h3[2], h3[3]}, o[d0], 0, 0, 0); } while (0)
    PV_D0(0); PV_D0(1); PV_D0(2); PV_D0(3);
#undef PV_D0
#undef TRRD
}

constexpr size_t V_OFF = (size_t)16384 * 4096, Z_OFF = 3 * V_OFF, O_OFF = 4 * V_OFF;
template <class TIn, class TOut> struct BlockRef { const TIn* Q; const TIn* K; int P0; int JLO; };
template <class TIn> struct Seam {
    bf16x8 qr[8];
    bf16x8 st_v0, st_v1, st_k0, st_k1; f32x4 sf0, sf1, sf2, sf3;
    f32x4 tq[16];
};
__device__ __forceinline__ int swa_jlo(int P0, int W) { const int lowk = P0 - W + 1; return lowk > 0 ? lowk / KVBLK : 0; }
#define ROW(p, k0, rr) ((p) + (size_t)((k0) + (rr)) * LD + sc)
#define VMW() asm volatile("s_waitcnt vmcnt(0)" ::: "memory")
#define VMWN(n) asm volatile("s_waitcnt vmcnt(%0)" :: "i"(n) : "memory")
#define SLOAD_H(Kp, Vp, k0) do { S.st_v0 = load8<TIn>(ROW(Vp, k0, sr)); S.st_v1 = load8<TIn>(ROW(Vp, k0, 32 + sr));              \
                         S.st_k0 = load8<TIn>(ROW(Kp, k0, sr)); S.st_k1 = load8<TIn>(ROW(Kp, k0, 32 + sr)); } while (0)
#define SWRITE_HK(bf) do { *(bf16x8*)(K_lds + (bf) * SHM_K + kws) = S.st_k0; *(bf16x8*)(K_lds + (bf) * SHM_K + kws + 32 * 256) = S.st_k1; } while (0)
#define SWRITE_HV(bf) do { *(bf16x8*)(V_lds + (bf) * SHM_V + vst0) = S.st_v0; *(bf16x8*)(V_lds + (bf) * SHM_V + vst1) = S.st_v1; } while (0)
#define SWRITE_H(bf) do { SWRITE_HV(bf); SWRITE_HK(bf); } while (0)
#define SLOAD_F(p, k0) do { S.sf0 = *(const f32x4*)ROW(p, k0, sr); S.sf1 = *(const f32x4*)(ROW(p, k0, sr) + 4);                \
                            S.sf2 = *(const f32x4*)ROW(p, k0, 32 + sr); S.sf3 = *(const f32x4*)(ROW(p, k0, 32 + sr) + 4); } while (0)
#define SWRITE_KF(bf) do { *(bf16x8*)(K_lds + (bf) * SHM_K + kws) = pack8(S.sf0, S.sf1); *(bf16x8*)(K_lds + (bf) * SHM_K + kws + 32 * 256) = pack8(S.sf2, S.sf3); } while (0)
#define SWRITE_VF(bf) do { *(bf16x8*)(V_lds + (bf) * SHM_V + vst0) = pack8(S.sf0, S.sf1); *(bf16x8*)(V_lds + (bf) * SHM_V + vst1) = pack8(S.sf2, S.sf3); } while (0)
template <class TIn, class TOut>
__device__ __forceinline__ void causal_swa_prime(const BlockRef<TIn, TOut>& cur, int W, char* lds, Seam<TIn>& S) {
    constexpr bool F32 = same_t<TIn, float>::v;
    const int tid = threadIdx.x, wid = __builtin_amdgcn_readfirstlane(tid >> 6), lane = tid & 63, r32 = lane & 31, hi = lane >> 5;
    const int sr = tid >> 4, sc = (tid & 15) * 8, kws = KSWZ(sr, sc * 2); char* K_lds = lds + 2 * SHM_V;
    const int kb0 = ((cur.P0 + QB - 1) / KVBLK) * KVBLK;
    for (int d0 = 0; d0 < 8; ++d0) S.qr[d0] = load8<TIn>(cur.Q + (size_t)(wid * QBLK + r32) * LD + d0 * 16 + hi * 8);
    if constexpr (F32) { SLOAD_F((const float*)cur.K, kb0); VMW(); SWRITE_KF(0); SBAR(); SLOAD_F((const float*)(cur.K + V_OFF), kb0); }
    else { SLOAD_H(cur.K, (cur.K + V_OFF), kb0); VMW(); SWRITE_HK(0); }
    __syncthreads();
}
template <class TIn, class TOut>
__device__ __forceinline__ void causal_swa_reprime(const BlockRef<TIn, TOut>& cur, char* lds, Seam<TIn>& S) {
    const int tid = threadIdx.x;
    const int sr = tid >> 4, sc = (tid & 15) * 8, kws = KSWZ(sr, sc * 2); char* K_lds = lds + 2 * SHM_V;
    const int kb0 = ((cur.P0 + QB - 1) / KVBLK) * KVBLK;
    SLOAD_H(cur.K, (cur.K + V_OFF), kb0); VMW(); SWRITE_HK(0);
    __syncthreads();
}
template <class TIn, class TOut>
__device__ __forceinline__ void causal_swa_block(const BlockRef<TIn, TOut>& cur, const BlockRef<TIn, TOut>& nxt, int skv, int W, char* lds, Seam<TIn>& S, const __attribute__((address_space(3))) float* fabs_l) {
    constexpr bool F32 = same_t<TIn, float>::v;
    const int tid = threadIdx.x, wid = __builtin_amdgcn_readfirstlane(tid >> 6), lane = tid & 63, r32 = lane & 31, hi = lane >> 5;
    const int j_lo = cur.JLO;
    int j_hi = (cur.P0 + QB - 1) / KVBLK + 1; if (j_hi > skv / KVBLK) j_hi = skv / KVBLK;
    const int NT = j_hi - j_lo;
    const int kbn = ((nxt.P0 + QB - 1) / KVBLK) * KVBLK;
    const int qlo = cur.P0 + wid * QBLK, qm = qlo + r32 - 4 * hi;
    const float ft = __int_as_float(__builtin_amdgcn_readfirstlane(__float_as_int(fabs_l[qlo])));
#define FK(t) (fabs_l + KBASE(t) + 4 * hi)
    char* V_lds = lds; char* K_lds = lds + 2 * SHM_V;
    float* ws = (float*)(lds + 2 * SHM_V + 2 * SHM_K) + wid * 64; float* li_l = ws, * al_l = ws + 32;
    float m_reg = -1e30f, l_reg = 0; f32x16 o[4] = {};
    if (wid >= 4) __builtin_amdgcn_s_setprio(1);
    const int sr = tid >> 4, sc = (tid & 15) * 8, vst0 = v_st(sr, sc), vst1 = v_st(32 + sr, sc), kws = KSWZ(sr, sc * 2);
    const int vb0 = (int)(uintptr_t)V_lds + v_rd_base(lane);
    const TIn* Kh = cur.K; const TIn* Vh = (cur.K + V_OFF);
#define RESC(a) do { if (__any((a) < 1.f)) { if (hi == 0) al_l[r32] = (a); asm volatile("s_waitcnt lgkmcnt(0)" ::: "memory");              \
                     for (int d_ = 0; d_ < 4; ++d_) for (int r = 0; r < 16; ++r) o[d_][r] *= al_l[crow(r, hi)]; } } while (0)
#define KBASE(t) ((j_hi - 1 - (t)) * KVBLK)
#define ACT(t) (KBASE(t) <= qlo + QBLK - 1 && KBASE(t) + KVBLK - 1 >= qlo - W + 1)
#define MASKT(P0_, P1_, t) do { const int kb_ = KBASE(t); if ((!SK || ACT(t)) && (kb_ + KVBLK - 1 > qlo || kb_ <= qlo + QBLK - 1 - W)) mask_tile(P0_, P1_, qm - kb_, (unsigned)W); } while (0)
    constexpr int NQL = F32 ? 16 : 8;
    constexpr bool SK = WSKIP && !F32;
#define SEAM_K0() do { VMWN(NQL); if constexpr (F32) { SWRITE_KF(0); SBAR(); SLOAD_F((const float*)(nxt.K + V_OFF), kbn); } else { SWRITE_HK(0); } SBAR(); } while (0)
    f32x16 pA0, pA1, pB0, pB1; float mnA, mnB, alA, alB; bf16x8 pa0, pa1, pa2, pa3;
    if constexpr (F32) { VMW(); SWRITE_VF(0); SBAR(); } else { SWRITE_HV(0); SBAR(); }
    if (NT > 1) { if constexpr (F32) SLOAD_F((const float*)Kh, KBASE(1)); else SLOAD_H(Kh, Vh, KBASE(1)); }
    SBAR(); qkt<0, SK>(pA0, pA1, K_lds, r32, hi, S.qr, ACT(0), FK(0), ft);
    if constexpr (F32) { if (NT > 1) { VMW(); SWRITE_KF(1); SBAR(); SLOAD_F((const float*)Vh, KBASE(1)); } }
    MASKT(pA0, pA1, 0); partialSM(pA0, pA1, m_reg, mnA, alA);
    if (NT > 1) { VMW(); if constexpr (F32) { SWRITE_VF(1); SBAR(); if (NT > 2) SLOAD_F((const float*)Kh, KBASE(2)); } else SWRITE_H(1); }
    __syncthreads();
#define HALF_STEP(PX0, PX1, mnX, alX, PY0, PY1, alY, t, KB, VB, SB) do {                                                      \
        SBAR(); qkt<KB, SK>(PX0, PX1, K_lds, r32, hi, S.qr, ACT(t), FK(t), ft);                                             \
        finishSM(PY0, PY1, alY, l_reg, pa0, pa1, pa2, pa3); SBAR();                                                           \
        if ((t) + 1 < NT) { if constexpr (F32) { VMW(); SWRITE_KF(SB); SBAR(); SLOAD_F((const float*)Vh, KBASE((t) + 1)); }  \
                            else { SLOAD_H(Kh, Vh, KBASE((t) + 1)); } SBAR(); }                                               \
        pv_tile<VB, SK>(o, vb0, pa0, pa1, pa2, pa3, ACT((t) - 1)); MASKT(PX0, PX1, (t)); partialSM(PX0, PX1, m_reg, mnX, alX);                                        \
        __syncthreads();                                                                                                      \
        if ((t) + 1 < NT) { VMW(); if constexpr (F32) { SWRITE_VF(SB); SBAR(); if ((t) + 2 < NT) SLOAD_F((const float*)Kh, KBASE((t) + 2)); } \
                            else { SWRITE_H(SB); } }                                                                          \
        RESC(alX); __syncthreads(); } while (0)
    asm volatile(".p2align 6");
    for (int t = 1; t + 1 < NT; t += 2) {
        HALF_STEP(pB0, pB1, mnB, alB, pA0, pA1, alA, t, 1, 0, 0);
        HALF_STEP(pA0, pA1, mnA, alA, pB0, pB1, alB, t + 1, 0, 1, 1);
    }
    const bool even = (NT & 1) == 0;
    if (even) { SBAR(); qkt<1, SK>(pB0, pB1, K_lds, r32, hi, S.qr, ACT(NT - 1), FK(NT - 1), ft); SBAR(); }
#define QROW(e) (nxt.Q + (size_t)(wid * QBLK + r32) * D + ((e) >> 1) * 16 + hi * 8 + ((e) & 1) * 4)
    if constexpr (F32) { SLOAD_F((const float*)nxt.K, kbn); SBAR();
#pragma unroll
        for (int e = 0; e < 8; ++e) S.tq[e] = *(const f32x4*)QROW(e); }
    else { SLOAD_H(nxt.K, (nxt.K + V_OFF), kbn); SBAR();
#pragma unroll
        for (int d0 = 0; d0 < 8; ++d0) S.qr[d0] = load8<TIn>(nxt.Q + (size_t)(wid * QBLK + r32) * LD + d0 * 16 + hi * 8); }
    SBAR();
    finishSM(pA0, pA1, alA, l_reg, pa0, pa1, pa2, pa3); SBAR();
    if constexpr (F32) {
#pragma unroll
        for (int e = 8; e < 16; ++e) S.tq[e] = *(const f32x4*)QROW(e); SBAR(); }
#undef QROW
    pv_tile<0, SK>(o, vb0, pa0, pa1, pa2, pa3, ACT(even ? NT - 2 : NT - 1));
    if (even) { MASKT(pB0, pB1, NT - 1); partialSM(pB0, pB1, m_reg, mnB, alB); __syncthreads(); RESC(alB);
        finishSM(pB0, pB1, alB, l_reg, pa0, pa1, pa2, pa3); SBAR(); pv_tile<1, SK>(o, vb0, pa0, pa1, pa2, pa3, ACT(NT - 1)); }
    SBAR(); SEAM_K0();
    if (hi == 0) li_l[r32] = l_reg; asm volatile("s_waitcnt lgkmcnt(0)" ::: "memory");
    float rli[16];
#pragma unroll
    for (int r = 0; r < 16; ++r) rli[r] = __builtin_amdgcn_rcpf(li_l[crow(r, hi)]);
    unsigned loff = (unsigned)((4 * hi) * LD + r32) * 2u; asm volatile("" : "+v"(loff));
    char* Ow = (char*)((TOut*)cur.Q + O_OFF + (size_t)(wid * QBLK) * LD); const char* Zw = (const char*)(cur.Q + Z_OFF + (size_t)(wid * QBLK) * LD);
    unsigned yw[16][4];
#pragma unroll
    for (int r = 0; r < 16; ++r) { const size_t roff = (size_t)((r & 3) + 8 * (r >> 2)) * LD * 2;
#pragma unroll
        for (int d0 = 0; d0 < 4; ++d0) yw[r][d0] = *(const unsigned short*)(Zw + roff + d0 * 64 + loff); }
#pragma unroll
    for (int r = 0; r < 16; ++r) {
#pragma unroll
        for (int d0 = 0; d0 < 4; ++d0) { const float z = __uint_as_float(yw[r][d0] << 16);
            const float y = o[d0][r] * rli[r] * z * __builtin_amdgcn_rcpf(1.f + __expf(-z));
            const float yn = __shfl_xor(y, 1);
            yw[r][d0] = cvtpk(y, yn); } }
    if ((r32 & 1) == 0) {
#pragma unroll
        for (int r = 0; r < 16; ++r) { const size_t roff = (size_t)((r & 3) + 8 * (r >> 2)) * LD * 2;
#pragma unroll
            for (int d0 = 0; d0 < 4; ++d0) *(unsigned*)(Ow + roff + d0 * 64 + loff) = yw[r][d0]; } }
    if constexpr (F32) {
#pragma unroll
        for (int d0 = 0; d0 < 8; ++d0) S.qr[d0] = pack8(S.tq[2 * d0], S.tq[2 * d0 + 1]); }
    if (wid >= 4) __builtin_amdgcn_s_setprio(0);
    __syncthreads();
#undef RESC
#undef FK
#undef KBASE
#undef ACT
#undef MASKT
#undef SEAM_K0
#undef HALF_STEP
}
#undef ROW
#undef VMW
#undef VMWN
#undef SLOAD_H
#undef SWRITE_HK
#undef SWRITE_HV
#undef SWRITE_H
#undef SLOAD_F
#undef SWRITE_KF
#undef SWRITE_VF


}

#define GAS __attribute__((address_space(1)))
#define LAS __attribute__((address_space(3)))
typedef unsigned short bf16;
typedef unsigned v4u __attribute__((ext_vector_type(4)));
typedef unsigned v2u __attribute__((ext_vector_type(2)));
typedef float f32x4 __attribute__((ext_vector_type(4)));
typedef short bf16x8 __attribute__((ext_vector_type(8)));
typedef unsigned short u16x4 __attribute__((ext_vector_type(4)));
typedef float f32x2v __attribute__((ext_vector_type(2)));

constexpr int SEQ = 16384, DM = 4096;
constexpr int NLAYERS = 4;
constexpr int NWAVES = 8, NTHR = 512;
constexpr int LDS_BYTES = 147456;
constexpr int LDS_CTL = LDS_BYTES - 256;

constexpr size_t MiB = 1u << 20;
constexpr size_t WS_CTL = 0, CTL_ZERO_BYTES = 2 * MiB;
constexpr size_t WS_NRM = 1 * MiB;
constexpr size_t WS_QCNT = 1 * MiB + 65536;
constexpr size_t WS_ROWSS = 65536;
constexpr size_t WS_WFI0 = 2 * MiB, WS_WFI1 = 130 * MiB, WS_WFO0 = 258 * MiB, WS_WFO1 = 290 * MiB;
constexpr size_t WS_WLI = 322 * MiB, WS_WLO = 386 * MiB, WS_WMI = 418 * MiB, WS_WMO = 546 * MiB;
constexpr size_t WS_WFF0 = 578 * MiB, WS_WFF1 = WS_WFF0 + 256 * 1024, WS_WMG = WS_WFF0 + 512 * 1024, WS_WLA = 579 * MiB, WS_WLX = 581 * MiB;
constexpr size_t WS_HB = 584 * MiB;
constexpr size_t WS_P0 = 712 * MiB, WS_PSTRIDE = 128 * MiB;
constexpr size_t WS_Y = 1224 * MiB;
constexpr size_t WS_QP = 1352 * MiB, WS_KT = 1416 * MiB, WS_VT = 1480 * MiB, WS_NINT = 1608 * MiB;
constexpr size_t WS_FLOC = 1736 * MiB, WS_FTOT = 1738 * MiB, WS_CA = 1739 * MiB, WS_CB = WS_CA + 256 * 1024;
constexpr size_t WS_IG = 1740 * MiB, WS_LF = WS_IG + 512 * 1024, WS_W1 = 1741 * MiB, WS_W2 = WS_W1 + 512 * 1024, WS_WK = 1742 * MiB, WS_EROW = WS_WK + 512 * 1024;
constexpr size_t WS_BC = 1743 * MiB, WS_IGB = WS_BC + 512 * 1024, WS_DMAX = 1744 * MiB, WS_DENI = WS_DMAX + 512 * 1024, WS_DEC = 1745 * MiB;
constexpr size_t WS_END = 1746 * MiB;

__device__ __forceinline__ float bf2f(unsigned short b) { return __uint_as_float((unsigned)b << 16); }
__device__ __forceinline__ unsigned pk2(float lo, float hi) { return pg8::cvt_pk_bf16(lo, hi); }
__device__ __forceinline__ float sigmoidf_(float x) { return __builtin_amdgcn_rcpf(1.f + __expf(-x)); }
__device__ __forceinline__ float logsigmoidf_(float x) { return fminf(x, 0.f) - log1pf(__expf(-fabsf(x))); }
#define LDS_WAIT() asm volatile("s_waitcnt lgkmcnt(0)" ::: "memory")
#define VM_WAIT() asm volatile("s_waitcnt vmcnt(0)" ::: "memory")
#define MFMA16(a, b, c) __builtin_amdgcn_mfma_f32_16x16x32_bf16(a, b, c, 0, 0, 0)

#define XB_TMO      128
#define XB_XCNT(j)  (256  + 64 * (j))
#define XB_XSUB(j)  (1280 + 64 * (j))
#define XB_XGEN(j)  (2304 + 64 * (j))
#define XB_TOP      3328
#define XB_TOPGEN   3392
#define XCD_BAR_WORDS 3456
#define XB_SPIN_CAP (1u << 18)

__device__ __forceinline__ unsigned xb_ld(unsigned* p)              { return __hip_atomic_load(p, __ATOMIC_RELAXED, __HIP_MEMORY_SCOPE_AGENT); }
__device__ __forceinline__ unsigned xb_add(unsigned* p, unsigned v) { return __hip_atomic_fetch_add(p, v, __ATOMIC_RELAXED, __HIP_MEMORY_SCOPE_AGENT); }
__device__ __forceinline__ unsigned xb_xcc_id() { return (unsigned)__builtin_amdgcn_s_getreg((3 << 11) | 20) & 0xFu; }
#define XB_SPIN(cond, bar) do { unsigned _sp = 0; while (cond) { __builtin_amdgcn_s_sleep(1); \
    if ((++_sp & 255u) == 0u) { if (xb_ld(&(bar)[XB_TMO])) break; if (_sp > XB_SPIN_CAP) { atomicAdd(&(bar)[XB_TMO], 1u); break; } } } } while (0)

struct XcdBarrier {
    unsigned* bar; unsigned x;
    volatile LAS unsigned* st;
};
__device__ __forceinline__ XcdBarrier xcd_barrier_post(unsigned* bar, volatile LAS unsigned* st) {
    XcdBarrier b; b.bar = bar; b.x = xb_xcc_id(); b.st = st;
    if (threadIdx.x == 0) (void)xb_add(&bar[XB_XCNT(b.x)], 1u);
    return b;
}
__device__ __forceinline__ void xcd_barrier_complete(unsigned* bar, unsigned x, unsigned& nloc, unsigned& nx) {
    const unsigned G = gridDim.x * gridDim.y * gridDim.z;
    unsigned sum, cnt, mine, sp = 0u;
    for (;;) {
        sum = 0u; cnt = 0u; mine = 0u;
#pragma unroll
        for (unsigned j = 0; j < 16; ++j) { const unsigned c = xb_ld(&bar[XB_XCNT(j)]); sum += c; cnt += (c > 0u) ? 1u : 0u; mine = (j == x) ? c : mine; }
        if (sum == G) break;
        __builtin_amdgcn_s_sleep(1);
        if ((++sp & 255u) == 0u) { if (xb_ld(&bar[XB_TMO])) break; if (sp > XB_SPIN_CAP) { atomicAdd(&bar[XB_TMO], 1u); break; } }
    }
    nloc = mine > 0u ? mine : 1u; nx = cnt > 0u ? cnt : 1u;
}
__device__ __forceinline__ void xcd_barrier(const XcdBarrier& b) {
    asm volatile("s_waitcnt vmcnt(0)" ::: "memory");
    __syncthreads();
    if (threadIdx.x == 0) {
        unsigned* bar = b.bar;
        __builtin_amdgcn_s_waitcnt(0);
        unsigned nloc = b.st[0], nx = b.st[1];
        if (nloc == 0u) { xcd_barrier_complete(bar, b.x, nloc, nx); b.st[0] = nloc; b.st[1] = nx; }
        const unsigned old = xb_add(&bar[XB_XSUB(b.x)], 1u);
        const unsigned gen = old / nloc;
        if (old + 1u == (gen + 1u) * nloc) {
            __builtin_amdgcn_fence(__ATOMIC_RELEASE, "agent");
            asm volatile("s_waitcnt vmcnt(0)" ::: "memory");
            const unsigned og = xb_add(&bar[XB_TOP], 1u);
            const unsigned tg = og / nx;
            if (og + 1u == (tg + 1u) * nx) xb_add(&bar[XB_TOPGEN], 1u);
            else XB_SPIN(xb_ld(&bar[XB_TOPGEN]) == tg, bar);
            __builtin_amdgcn_fence(__ATOMIC_ACQUIRE, "agent");
            xb_add(&bar[XB_XGEN(b.x)], 1u);
            asm volatile("s_waitcnt vmcnt(0)" ::: "memory");
        } else {
            XB_SPIN(xb_ld(&bar[XB_XGEN(b.x)]) == gen, bar);
            __builtin_amdgcn_fence(__ATOMIC_ACQUIRE, "agent");
            asm volatile("s_waitcnt vmcnt(0)" ::: "memory");
        }
    }
    __syncthreads();
}

struct Params { const float* in[19]; float* out; unsigned char* ws; int ph_lo, ph_hi; };
#define CAS __attribute__((address_space(4)))
__device__ __forceinline__ const float* late_in(int k) { const CAS char* ka = (const CAS char*)__builtin_amdgcn_kernarg_segment_ptr(); asm volatile("" : "+s"(ka));
    return *(const float* const CAS*)(ka + 8 * k); }
__device__ __forceinline__ float* late_out() { const CAS char* ka = (const CAS char*)__builtin_amdgcn_kernarg_segment_ptr(); asm volatile("" : "+s"(ka));
    return *(float* const CAS*)(ka + 8 * 19); }

struct TrSeg { const float* W; int ldn, col0, ncb; bf16* WT; int K; const LAS float* gain; };
__device__ __forceinline__ void tr_load(const TrSeg& s, int item, int lane, float (&v)[32]) {
    const int kb = item / s.ncb, nb = item - kb * s.ncb, k0 = 64 * kb, n0 = 32 * nb;
    const float* src = s.W + (size_t)(k0 + (lane >> 5)) * s.ldn + s.col0 + n0 + (lane & 31);
#pragma unroll
    for (int i = 0; i < 32; ++i) v[i] = src[(size_t)(2 * i) * s.ldn];
}
__device__ __forceinline__ void tr_store(const TrSeg& s, int item, int lane, const float (&v)[32], LAS float* scr) {
    const int kb = item / s.ncb, nb = item - kb * s.ncb, k0 = 64 * kb, n0 = 32 * nb;
#pragma unroll
    for (int i = 0; i < 32; ++i) { const int kk = 2 * i + (lane >> 5); const float g = s.gain ? s.gain[k0 + kk] : 1.f; scr[kk * 33 + (lane & 31)] = v[i] * g; }
    LDS_WAIT(); asm volatile("" ::: "memory");
    const int c = lane & 7;
#pragma unroll
    for (int j = 0; j < 4; ++j) { const int n = (lane >> 3) + 8 * j; const LAS float* p = scr + (8 * c) * 33 + n;
        v4u o; o.x = pk2(p[0 * 33], p[1 * 33]); o.y = pk2(p[2 * 33], p[3 * 33]); o.z = pk2(p[4 * 33], p[5 * 33]); o.w = pk2(p[6 * 33], p[7 * 33]);
        *(v4u*)(s.WT + (size_t)(n0 + n) * s.K + k0 + 8 * c) = o; }
    LDS_WAIT(); asm volatile("" ::: "memory");
}
__device__ __forceinline__ float wave_sum(float v) {
#pragma unroll
    for (int o = 1; o < 64; o <<= 1) v += __shfl_xor(v, o);
    return v;
}
__device__ __forceinline__ void p0_prologue(const Params& p, LAS unsigned char* lds, int tid) {
    const int lane = tid & 63, wave = __builtin_amdgcn_readfirstlane(tid >> 6);
    LAS float* scr = (LAS float*)(lds + wave * 8448);
    LAS float* GL = (LAS float*)(lds + 69632);
    for (int i = tid; i < 4 * 4096; i += NTHR) GL[i] = p.in[1][i];
    __syncthreads();
    const int gw = blockIdx.x * NWAVES + wave, NGW = gridDim.x * NWAVES;
    unsigned char* ws = p.ws;
    const LAS float* ng = GL;
    int rot_ = 0;
#define SEG(Wp, ldn_, col0_, ncols, dst, K_, gain_) do { TrSeg sg_; sg_.W = (Wp); sg_.ldn = (ldn_); sg_.col0 = (col0_); sg_.ncb = (ncols) / 32; sg_.WT = (dst); sg_.K = (K_); sg_.gain = (gain_); \
        const int nit_ = ((K_) / 64) * sg_.ncb; float va_[32], vb_[32]; int it = gw - rot_; if (it < 0) it += NGW; rot_ = (rot_ + nit_) % NGW;     \
        if (it < nit_) tr_load(sg_, it, lane, va_); \
        for (; it < nit_; it += 2 * NGW) { const bool nx_ = it + NGW < nit_, nx2_ = it + 2 * NGW < nit_; \
            if (nx_) tr_load(sg_, it + NGW, lane, vb_); \
            tr_store(sg_, it, lane, va_, scr); \
            if (nx2_) tr_load(sg_, it + 2 * NGW, lane, va_); \
            if (nx_) tr_store(sg_, it + NGW, lane, vb_, scr); } } while (0)
    SEG(p.in[2], 16416, 16384, 32, (bf16*)(ws + WS_WFF0), 4096, ng + 0 * 4096);
    SEG(p.in[2] + (size_t)4096 * 16416, 16416, 0, 16384, (bf16*)(ws + WS_WFI1), 4096, ng + 3 * 4096);
    SEG(p.in[2] + (size_t)4096 * 16416, 16416, 16384, 32, (bf16*)(ws + WS_WFF1), 4096, ng + 3 * 4096);
    SEG(p.in[4], 4096, 0, 4096, (bf16*)(ws + WS_WFO0), 4096, (const LAS float*)nullptr);
    SEG(p.in[4] + (size_t)4096 * 4096, 4096, 0, 4096, (bf16*)(ws + WS_WFO1), 4096, (const LAS float*)nullptr);
    SEG(p.in[5], 8192, 0, 8192, (bf16*)(ws + WS_WLI), 4096, ng + 1 * 4096);
    SEG(p.in[13], 4096, 0, 4096, (bf16*)(ws + WS_WLO), 4096, (const LAS float*)nullptr);
    for (int n = 0; n < 16; ++n) {
        SEG(p.in[8] + (size_t)n * 65536, 256, 0, 256, (bf16*)(ws + WS_WLA) + (size_t)n * 65536, 256, (const LAS float*)nullptr);
        SEG(p.in[10] + (size_t)n * 65536, 256, 0, 256, (bf16*)(ws + WS_WLX) + (size_t)n * 65536, 256, (const LAS float*)nullptr);
    }
    SEG(p.in[14], 16400, 0, 12288, (bf16*)(ws + WS_WMI), 4096, ng + 2 * 4096);
    SEG(p.in[14], 16400, 12288, 32, (bf16*)(ws + WS_WMG), 4096, ng + 2 * 4096);
    SEG(p.in[14], 16400, 12304, 4096, (bf16*)(ws + WS_WMI) + (size_t)12288 * 4096, 4096, ng + 2 * 4096);
    SEG(p.in[17], 4096, 0, 4096, (bf16*)(ws + WS_WMO), 4096, (const LAS float*)nullptr);
    SEG(p.in[2], 16416, 0, 16384, (bf16*)(ws + WS_WFI0), 4096, ng + 0 * 4096);
#undef SEG
    const float* x = p.in[0]; bf16* hb = (bf16*)(ws + WS_HB); unsigned long long* ss0 = (unsigned long long*)(ws + WS_ROWSS);
    for (int m = gw; m < SEQ; m += NGW) {
        const f32x4* xr = (const f32x4*)(x + (size_t)m * DM) + lane; unsigned long long* o8 = (unsigned long long*)(hb + (size_t)m * DM) + lane; float s = 0.f;
#pragma unroll
        for (int j = 0; j < 16; ++j) { const f32x4 v = xr[64 * j]; const unsigned w0 = pk2(v.x, v.y), w1 = pk2(v.z, v.w);
            const float r0 = __uint_as_float(w0 << 16), r1 = __uint_as_float(w0 & 0xffff0000u), r2 = __uint_as_float(w1 << 16), r3 = __uint_as_float(w1 & 0xffff0000u);
            s += (r0 * r0 + r1 * r1) + (r2 * r2 + r3 * r3);
            o8[64 * j] = (unsigned long long)w0 | ((unsigned long long)w1 << 32); }
        s = wave_sum(s);
        if (lane == 0) ss0[m] = (unsigned long long)(s * 1048576.0f + 0.5f);
    }
}

template <int NT>
__device__ __forceinline__ void side_gate_tile(const bf16* hb, const bf16* Wg, int row0, int lane, f32x4 (&acc)[NT]) {
    const int fr = lane & 15, fq = lane >> 4;
    const bf16* ap = hb + (size_t)(row0 + fr) * DM + 8 * fq;
    const bf16* bp = Wg + (size_t)fr * DM + 8 * fq;
#pragma unroll
    for (int nt = 0; nt < NT; ++nt) acc[nt] = (f32x4){0.f, 0.f, 0.f, 0.f};
    bf16x8 a0[4], b0[NT][4], a1[4], b1[NT][4];
#define SG_LOAD(a, b, k0_) do { _Pragma("unroll") for (int j = 0; j < 4; ++j) a[j] = *(const bf16x8*)(ap + (k0_) + 32 * j); \
        _Pragma("unroll") for (int nt = 0; nt < NT; ++nt) _Pragma("unroll") for (int j = 0; j < 4; ++j) b[nt][j] = *(const bf16x8*)(bp + (size_t)nt * 16 * DM + (k0_) + 32 * j); } while (0)
#define SG_MMA(a, b) do { _Pragma("unroll") for (int j = 0; j < 4; ++j) _Pragma("unroll") for (int nt = 0; nt < NT; ++nt) acc[nt] = MFMA16(a[j], b[nt][j], acc[nt]); } while (0)
    SG_LOAD(a0, b0, 0);
#pragma unroll 1
    for (int k0 = 0; k0 < DM; k0 += 256) { SG_LOAD(a1, b1, k0 + 128); SG_MMA(a0, b0); SG_LOAD(a0, b0, (k0 + 256) & (DM - 1)); SG_MMA(a1, b1); }
#undef SG_LOAD
#undef SG_MMA
}
__device__ __forceinline__ void fox_gates(const bf16* hb, const bf16* Wf, const unsigned long long* rowss, const float* b_f, float* FLOC, float* FTOT, int tid) {
    const int lane = tid & 63, wave = tid >> 6, fr = lane & 15, fq = lane >> 4;
    if (wave >= 4) return;
    for (int tile = blockIdx.x * 4 + wave; tile < SEQ / 16; tile += gridDim.x * 4) {
        const int row0 = tile * 16;
        f32x4 acc[2]; side_gate_tile<2>(hb, Wf, row0, lane, acc);
        float rs[4];
#pragma unroll
        for (int j = 0; j < 4; ++j) rs[j] = rsqrtf((float)rowss[row0 + 4 * fq + j] * (1.0f / (1048576.0f * 4096.0f)) + 1e-6f);
#pragma unroll
        for (int nt = 0; nt < 2; ++nt) { const int h = 16 * nt + fr; const float bb = b_f[h];
            float c[4]; float run = 0.f;
#pragma unroll
            for (int j = 0; j < 4; ++j) { run += logsigmoidf_(acc[nt][j] * rs[j] + bb); c[j] = run; }
            float inc = run; float u = __shfl_up(inc, 16); if (fq >= 1) inc += u; u = __shfl_up(inc, 32); if (fq >= 2) inc += u;
            const float exc = inc - run;
#pragma unroll
            for (int j = 0; j < 4; ++j) FLOC[(size_t)h * SEQ + row0 + 4 * fq + j] = exc + c[j];
            if (fq == 3) FTOT[h * 1024 + tile] = inc; }
    }
}
__device__ __forceinline__ void mlstm_gates(const bf16* hb, const bf16* Wg, const unsigned long long* rowss, const float* b_i, const float* b_f, float* IG, float* LF, int tid) {
    const int lane = tid & 63, wave = tid >> 6, fr = lane & 15, fq = lane >> 4;
    if (wave >= 4) return;
    for (int tile = blockIdx.x * 4 + wave; tile < SEQ / 16; tile += gridDim.x * 4) {
        const int row0 = tile * 16;
        f32x4 acc[1]; side_gate_tile<1>(hb, Wg, row0, lane, acc);
        const int h = fr & 7; const float bb = (fr < 8) ? b_i[h] : b_f[h];
#pragma unroll
        for (int j = 0; j < 4; ++j) { const int row = row0 + 4 * fq + j; const float rs = rsqrtf((float)rowss[row] * (1.0f / (1048576.0f * 4096.0f)) + 1e-6f);
            const float v = acc[0][j] * rs + bb;
            if (fr < 8) IG[(size_t)h * SEQ + row] = v; else LF[(size_t)h * SEQ + row] = logsigmoidf_(v); }
    }
}

__device__ __forceinline__ float fox_setup_fabs(char* lds, const float* FLOC, const float* FTOT, const unsigned* nrm, int h, int tid) {
    float* PH = (float*)(lds + fa::LDS_BODY); float* FABS = PH + 1024;
    asm volatile("" : "+v"(tid));
    const int lane = tid & 63;
    if (tid < 64) {
        const f32x4* src = (const f32x4*)(FTOT + h * 1024 + lane * 16);
        const f32x4 a = src[0], b = src[1], c = src[2], d = src[3];
        const float v[16] = {a[0], a[1], a[2], a[3], b[0], b[1], b[2], b[3], c[0], c[1], c[2], c[3], d[0], d[1], d[2], d[3]};
        float ex[16]; float run = 0.f;
#pragma unroll
        for (int i = 0; i < 16; ++i) { ex[i] = run; run += v[i]; }
        float inc = run;
#pragma unroll
        for (int o = 1; o < 64; o <<= 1) { const float u = __shfl_up(inc, o); if (lane >= o) inc += u; }
        const float base = inc - run;
#pragma unroll
        for (int i = 0; i < 16; ++i) PH[lane * 16 + i] = base + ex[i];
    }
    __syncthreads();
#pragma unroll
    for (int k = 0; k < SEQ / 4 / NTHR; ++k) { const int i = tid + NTHR * k; const f32x4 f = ((const f32x4*)(FLOC + (size_t)h * SEQ))[i]; const float ph = PH[i >> 2];
        ((f32x4*)FABS)[i] = (f + ph) * fa::INV_SCALE; }
    __syncthreads();
    float B = 0.f;
#pragma unroll
    for (int c = 0; c < 4; ++c) B += sqrtf(__uint_as_float(nrm[h * 4 + c])) * sqrtf(__uint_as_float(nrm[(32 + h) * 4 + c]));
    B *= 1.02f * fa::SCALE;
    return (105.0f + 2.0f * B) * fa::INV_SCALE;
}
__device__ __forceinline__ int fox_jlo(const float* FABS, int P0, float thp, int lane) {
    asm volatile("" : "+v"(lane));
    const float f0 = FABS[P0]; int cnt = 0;
#pragma unroll
    for (int c = 0; c < 4; ++c) { const int s = 64 * (64 * c + lane) + 63; const bool skip = (s < P0) && (FABS[s] - f0 >= thp); cnt += __popcll(__ballot(skip)); }
    return cnt;
}
__device__ __forceinline__ int fox_grab(unsigned* qcnt, volatile LAS unsigned* slot, int tid) {
    if (tid == 0) { const unsigned i = __hip_atomic_fetch_add(qcnt, 1u, __ATOMIC_RELAXED, __HIP_MEMORY_SCOPE_AGENT); *slot = i < 1024u ? i : 0xffffffffu; }
    __syncthreads();
    const int r = (int)*slot;
    __syncthreads();
    return r;
}
__device__ __forceinline__ void fox_attn_phase(char* lds, const bf16* Q, const bf16* K, const float* FLOC, const float* FTOT, const unsigned* nrm, unsigned* qcnt, int tid) {
    static_assert(WS_PSTRIDE / 2 == fa::V_OFF && (WS_Y - WS_P0) / 2 == fa::O_OFF, "attention tensor offsets");
    const int lane = tid & 63;
    volatile LAS unsigned* slot = (volatile LAS unsigned*)((LAS unsigned char*)lds + LDS_CTL) + 8;
    const float* FABS = (const float*)(lds + fa::LDS_BODY) + 1024;
    typedef fa::BlockRef<bf16, bf16> Ref;
#define FOX_REF(r, h_, qb_, jlo_) do { r.Q = Q + (size_t)(qb_) * fa::QB * fa::LD + (size_t)(h_) * fa::D; r.K = K + (size_t)(h_) * fa::D; r.P0 = (qb_) * fa::QB; r.JLO = (jlo_); } while (0)
#define FOX_ITEM(it_, h_, x_) do { h_ = 31 - ((it_) >> 5); x_ = 31 - ((it_) & 31); } while (0)
    int it = fox_grab(qcnt, slot, tid); if (it < 0) return;
    fa::Seam<bf16> S;
    int h, x, pass = 0, jl1; bool fresh = true; FOX_ITEM(it, h, x);
    float thp = fox_setup_fabs(lds, FLOC, FTOT, nrm, h, tid);
    Ref cur; FOX_REF(cur, h, x, fox_jlo(FABS, x * fa::QB, thp, lane)); jl1 = fox_jlo(FABS, (63 - x) * fa::QB, thp, lane);
    for (;;) {
        if (fresh) { fa::causal_swa_prime<bf16, bf16>(cur, SEQ, lds, S); fresh = false; }
        Ref nxt; if (pass == 0) { FOX_REF(nxt, h, 63 - x, jl1); } else nxt = cur;
        fa::causal_swa_block<bf16, bf16>(cur, nxt, SEQ, SEQ, lds, S, (const LAS float*)FABS);
        if (pass == 0) { pass = 1; cur = nxt; continue; }
        it = fox_grab(qcnt, slot, tid); if (it < 0) break;
        int hn, xn; FOX_ITEM(it, hn, xn);
        if (hn != h) thp = fox_setup_fabs(lds, FLOC, FTOT, nrm, hn, tid);
        h = hn; x = xn; pass = 0; fresh = true;
        FOX_REF(cur, h, x, fox_jlo(FABS, x * fa::QB, thp, lane)); jl1 = fox_jlo(FABS, (63 - x) * fa::QB, thp, lane);
    }
#undef FOX_REF
#undef FOX_ITEM
}

__device__ __forceinline__ void lru_scan_phase(char* ldsg, const Params& p, int tid) {
    unsigned char* ws = p.ws;
    const bf16* XB = (const bf16*)(ws + WS_P0); const bf16* Zt = (const bf16*)(ws + WS_P0 + WS_PSTRIDE);
    bf16* HZ = (bf16*)(ws + WS_P0 + 2 * WS_PSTRIDE); bf16* PZ = (bf16*)(ws + WS_P0 + 3 * WS_PSTRIDE);
    const bf16* WLA = (const bf16*)(ws + WS_WLA); const bf16* WLX = (const bf16*)(ws + WS_WLX);
    float* CA = (float*)(ws + WS_CA); float* CB = (float*)(ws + WS_CB);
    const float* conv_w = late_in(6); const float* conv_b = late_in(7); const float* b_a = late_in(9); const float* b_x = late_in(11); const float* lam = late_in(12);
    constexpr int XS = 264;
    bf16* XC = (bf16*)ldsg; bf16* PT = XC + 128 * XS; float* CW = (float*)(ldsg + 2 * 128 * XS * 2); float* CBs = CW + 1024;
    const int lane = tid & 63, wid = __builtin_amdgcn_readfirstlane(tid >> 6), fr = lane & 15, fq = lane >> 4;
    for (int u = blockIdx.x; u < 256; u += gridDim.x) {
        const int n = u & 15, sc = u >> 4;
        for (int i = tid; i < 1024; i += NTHR) CW[i] = conv_w[(i >> 8) * 4096 + n * 256 + (i & 255)];
        if (tid < 256) CBs[tid] = conv_b[n * 256 + tid];
        float ba[2], bx[2], nl[2], hc[2], pc[2];
#pragma unroll
        for (int nt = 0; nt < 2; ++nt) { const int c = n * 256 + 32 * wid + 16 * nt + fr; ba[nt] = b_a[c]; bx[nt] = b_x[c]; nl[nt] = -8.0f * log1pf(__expf(-lam[c])); hc[nt] = 0.f; pc[nt] = 1.f; }
        __syncthreads();
        for (int tile = 0; tile < 8; ++tile) {
            const int T0 = sc * 1024 + tile * 128;
            int tidq = tid; asm volatile("" : "+v"(tidq));
            { const int c0 = (tidq & 31) * 8, tq = tidq >> 5;
                float wv[4][8], bv[8];
#pragma unroll
                for (int e = 0; e < 8; ++e) bv[e] = CBs[c0 + e];
#pragma unroll
                for (int j = 0; j < 4; ++j)
#pragma unroll
                    for (int e = 0; e < 8; ++e) wv[j][e] = CW[j * 256 + c0 + e];
                const bf16* xrow = XB + (size_t)T0 * DM + n * 256 + c0;
                bf16x8 xv[8][4];
#pragma unroll
                for (int i = 0; i < 8; ++i)
#pragma unroll
                    for (int j = 0; j < 4; ++j) { const int dt = tq + 16 * i - 3 + j;
                        if (i == 0) { const bool neg = T0 + dt < 0; xv[i][j] = *(const bf16x8*)(xrow + (ptrdiff_t)(neg ? -T0 : dt) * DM); }
                        else xv[i][j] = *(const bf16x8*)(xrow + (ptrdiff_t)dt * DM); }
                __builtin_amdgcn_sched_barrier(0);
#pragma unroll
                for (int i = 0; i < 8; ++i) { const int t = tq + 16 * i;
                    if (i == 0) {
#pragma unroll
                        for (int j = 0; j < 3; ++j) if (T0 + t - 3 + j < 0) xv[0][j] = (bf16x8){0, 0, 0, 0, 0, 0, 0, 0}; }
                    float a[8];
#pragma unroll
                    for (int e = 0; e < 8; ++e) a[e] = bv[e];
#pragma unroll
                    for (int j = 0; j < 4; ++j)
#pragma unroll
                        for (int e = 0; e < 8; ++e) a[e] = __builtin_fmaf(wv[j][e], bf2f((unsigned short)xv[i][j][e]), a[e]);
                    v4u o; o.x = pk2(a[0], a[1]); o.y = pk2(a[2], a[3]); o.z = pk2(a[4], a[5]); o.w = pk2(a[6], a[7]);
                    *(v4u*)(XC + t * XS + c0) = o; } }
            __syncthreads();
            f32x4 acc[2][8][2];
#pragma unroll
            for (int g = 0; g < 2; ++g)
#pragma unroll
                for (int rt = 0; rt < 8; ++rt)
#pragma unroll
                    for (int nt = 0; nt < 2; ++nt) acc[g][rt][nt] = (f32x4){0.f, 0.f, 0.f, 0.f};
#pragma unroll 2
            for (int kk = 0; kk < 8; ++kk) {
                bf16x8 bfr[2][2];
#pragma unroll
                for (int nt = 0; nt < 2; ++nt) { const size_t wo = (size_t)n * 65536 + (size_t)(32 * wid + 16 * nt + fr) * 256 + 32 * kk + 8 * fq;
                    bfr[0][nt] = *(const bf16x8*)(WLA + wo); bfr[1][nt] = *(const bf16x8*)(WLX + wo); }
#pragma unroll
                for (int rt = 0; rt < 8; ++rt) { const bf16x8 a = *(const bf16x8*)(XC + (16 * rt + fr) * XS + 32 * kk + 8 * fq);
#pragma unroll
                    for (int g = 0; g < 2; ++g)
#pragma unroll
                        for (int nt = 0; nt < 2; ++nt) acc[g][rt][nt] = MFMA16(a, bfr[g][nt], acc[g][rt][nt]); }
            }
            __syncthreads();
            LAS bf16* xcb = (LAS bf16*)XC + (4 * fq) * XS + 32 * wid + fr; LAS bf16* ptb = xcb + 128 * XS; asm volatile("" : "+v"(xcb), "+v"(ptb));
#pragma unroll
            for (int nt = 0; nt < 2; ++nt) {
#pragma unroll
                for (int rt = 0; rt < 8; ++rt) {
                    float A[4], B[4];
#pragma unroll
                    for (int j = 0; j < 4; ++j) {
                        const float r = sigmoidf_(acc[0][rt][nt][j] + ba[nt]), ig = sigmoidf_(acc[1][rt][nt][j] + bx[nt]);
                        const float la = r * nl[nt], av = __expf(la), x2 = 2.0f * la;
                        const float es = -x2 * (1.0f + x2 * 0.5f * (1.0f + x2 * (1.0f / 3.0f) * (1.0f + x2 * 0.25f))), ed = 1.0f - av * av;
                        const float em = (x2 > -0.0625f) ? es : ed;
                        const float mult = __builtin_amdgcn_sqrtf(em);
                        const float xcv = bf2f(xcb[(16 * rt + j) * XS + 16 * nt]);
                        A[j] = av; B[j] = mult * ig * xcv; }
#pragma unroll
                    for (int j = 1; j < 4; ++j) { B[j] = B[j - 1] * A[j] + B[j]; A[j] = A[j - 1] * A[j]; }
                    float At = A[3], Bt = B[3];
                    { const float Au = __shfl_up(At, 16), Bu = __shfl_up(Bt, 16); if (fq >= 1) { Bt = At * Bu + Bt; At = At * Au; } }
                    { const float Au = __shfl_up(At, 32), Bu = __shfl_up(Bt, 32); if (fq >= 2) { Bt = At * Bu + Bt; At = At * Au; } }
                    float Ae = __shfl_up(At, 16), Be = __shfl_up(Bt, 16); if (fq == 0) { Ae = 1.f; Be = 0.f; }
                    const float At3 = __shfl(At, 48 + fr), Bt3 = __shfl(Bt, 48 + fr);
                    const float h0 = Ae * hc[nt] + Be, P0 = Ae * pc[nt];
#pragma unroll
                    for (int j = 0; j < 4; ++j) {
                        const float hj = A[j] * h0 + B[j], Pj = A[j] * P0;
                        xcb[(16 * rt + j) * XS + 16 * nt] = (bf16)(pk2(hj, 0.f) & 0xffffu); ptb[(16 * rt + j) * XS + 16 * nt] = (bf16)(pk2(Pj, 0.f) & 0xffffu); }
                    hc[nt] = At3 * hc[nt] + Bt3; pc[nt] = At3 * pc[nt];
                }
            }
            __syncthreads();
            int tidp = tid; asm volatile("" : "+v"(tidp));
            bf16x8 zq[8];
#pragma unroll
            for (int i = 0; i < 8; ++i) { const int task = tidp + NTHR * i; zq[i] = *(const bf16x8*)(Zt + (size_t)(T0 + (task >> 5)) * DM + n * 256 + (task & 31) * 8); }
#pragma unroll
            for (int i = 0; i < 8; ++i) { const int task = tidp + NTHR * i, t = task >> 5, c0 = (task & 31) * 8; const size_t go = (size_t)(T0 + t) * DM + n * 256 + c0;
                const bf16x8 z8 = zq[i], h8 = *(const bf16x8*)(XC + t * XS + c0), p8 = *(const bf16x8*)(PT + t * XS + c0);
                float hz[8], pz[8];
#pragma unroll
                for (int e = 0; e < 8; ++e) { const float z = bf2f((unsigned short)z8[e]), sz = z * sigmoidf_(z); hz[e] = bf2f((unsigned short)h8[e]) * sz; pz[e] = bf2f((unsigned short)p8[e]) * sz; }
                v4u w; w.x = pk2(hz[0], hz[1]); w.y = pk2(hz[2], hz[3]); w.z = pk2(hz[4], hz[5]); w.w = pk2(hz[6], hz[7]); *(v4u*)(HZ + go) = w;
                w.x = pk2(pz[0], pz[1]); w.y = pk2(pz[2], pz[3]); w.z = pk2(pz[4], pz[5]); w.w = pk2(pz[6], pz[7]); *(v4u*)(PZ + go) = w; }
            __syncthreads();
        }
        if (fq == 0) {
#pragma unroll
            for (int nt = 0; nt < 2; ++nt) { const size_t c = (size_t)sc * DM + n * 256 + 32 * wid + 16 * nt + fr; CA[c] = pc[nt]; CB[c] = hc[nt]; } }
    }
}
__device__ __forceinline__ void lru_fix_phase(const Params& p, int tid) {
    unsigned char* ws = p.ws;
    const bf16* HZ = (const bf16*)(ws + WS_P0 + 2 * WS_PSTRIDE); const bf16* PZ = (const bf16*)(ws + WS_P0 + 3 * WS_PSTRIDE); bf16* Y = (bf16*)(ws + WS_Y);
    const float* CA = (const float*)(ws + WS_CA); const float* CB = (const float*)(ws + WS_CB);
    const int c0 = tid * 8;
    for (int b = blockIdx.x; b < 256; b += gridDim.x) {
        const int sc = b >> 4;
        float hin[8];
#pragma unroll
        for (int e = 0; e < 8; ++e) hin[e] = 0.f;
#pragma unroll 4
        for (int s = 0; s < sc; ++s) { const f32x4 a0 = *(const f32x4*)(CA + (size_t)s * DM + c0), a1 = *(const f32x4*)(CA + (size_t)s * DM + c0 + 4);
            const f32x4 b0 = *(const f32x4*)(CB + (size_t)s * DM + c0), b1 = *(const f32x4*)(CB + (size_t)s * DM + c0 + 4);
#pragma unroll
            for (int e = 0; e < 4; ++e) { hin[e] = b0[e] + a0[e] * hin[e]; hin[4 + e] = b1[e] + a1[e] * hin[4 + e]; } }
#pragma unroll 8
        for (int r = 0; r < 64; ++r) { const size_t o = (size_t)(b * 64 + r) * DM + c0;
            const bf16x8 hz = *(const bf16x8*)(HZ + o), pz = *(const bf16x8*)(PZ + o);
            float y[8];
#pragma unroll
            for (int e = 0; e < 8; ++e) y[e] = bf2f((unsigned short)hz[e]) + bf2f((unsigned short)pz[e]) * hin[e];
            v4u w; w.x = pk2(y[0], y[1]); w.y = pk2(y[2], y[3]); w.z = pk2(y[4], y[5]); w.w = pk2(y[6], y[7]);
            *(v4u*)(Y + o) = w; }
    }
}

__device__ __forceinline__ void mlstm_scalars_phase(char* ldsg, const Params& p, int tid) {
    if (blockIdx.x >= 8) return;
    unsigned char* ws = p.ws; const int h = blockIdx.x, lane = tid & 63, wid = tid >> 6;
    const float* IG = (const float*)(ws + WS_IG) + (size_t)h * SEQ; const float* LF = (const float*)(ws + WS_LF) + (size_t)h * SEQ;
    float* G = (float*)ldsg; float* AM = G + 256; float* M0 = AM + 256; float* MN = M0 + 256;
    float lfv[32], igv[32];
#pragma unroll
    for (int k = 0; k < 32; ++k) { const int tok = (wid + NWAVES * k) * 64 + lane; lfv[k] = LF[tok]; igv[k] = IG[tok]; }
#pragma unroll
    for (int k = 0; k < 32; ++k) { const int c = wid + NWAVES * k; const float ig = igv[k];
        float bc = lfv[k];
#pragma unroll
        for (int o = 1; o < 64; o <<= 1) { const float u = __shfl_up(bc, o); if (lane >= o) bc += u; }
        lfv[k] = bc;
        const float g = __shfl(bc, 63); float pm = ig - bc;
#pragma unroll
        for (int o = 1; o < 64; o <<= 1) pm = fmaxf(pm, __shfl_xor(pm, o));
        if (lane == 0) { G[c] = g; AM[c] = g + pm; } }
    __syncthreads();
    if (tid < 64) { float* DEC = (float*)(ws + WS_DEC) + h * 256;
        float g[4], am[4];
#pragma unroll
        for (int j = 0; j < 4; ++j) { g[j] = G[4 * lane + j]; am[j] = AM[4 * lane + j]; }
        float A = g[0], B = am[0];
#pragma unroll
        for (int j = 1; j < 4; ++j) { B = fmaxf(B + g[j], am[j]); A += g[j]; }
#pragma unroll
        for (int o = 1; o < 64; o <<= 1) { const float Au = __shfl_up(A, o), Bu = __shfl_up(B, o); if (lane >= o) { B = fmaxf(Bu + A, B); A = Au + A; } }
        float Ae = __shfl_up(A, 1), Be = __shfl_up(B, 1); if (lane == 0) { Ae = 0.f; Be = -__builtin_inff(); }
        float m = fmaxf(Ae, Be);
#pragma unroll
        for (int j = 0; j < 4; ++j) { const int c = 4 * lane + j; M0[c] = m; const float mn = fmaxf(g[j] + m, am[j]); DEC[c] = __expf(g[j] + m - mn); MN[c] = mn; m = mn; } }
    __syncthreads();
    float* W1 = (float*)(ws + WS_W1) + (size_t)h * SEQ; float* W2 = (float*)(ws + WS_W2) + (size_t)h * SEQ; float* WK = (float*)(ws + WS_WK) + (size_t)h * SEQ;
    float* ER = (float*)(ws + WS_EROW) + (size_t)h * SEQ; float* BC = (float*)(ws + WS_BC) + (size_t)h * SEQ; float* IGB = (float*)(ws + WS_IGB) + (size_t)h * SEQ;
    float* DMX = (float*)(ws + WS_DMAX) + (size_t)h * SEQ;
#pragma unroll
    for (int k = 0; k < 32; ++k) { const int c = wid + NWAVES * k, tok = c * 64 + lane; const float ig = igv[k], bc = lfv[k];
        const float g = __shfl(bc, 63); const float xs = ig - bc; float pm = xs;
#pragma unroll
        for (int o = 1; o < 64; o <<= 1) { const float u = __shfl_up(pm, o); if (lane >= o) pm = fmaxf(pm, u); }
        const float dmax = bc + pm, m = M0[c], mrow = fmaxf(bc + m, dmax);
        BC[tok] = bc; IGB[tok] = xs; DMX[tok] = dmax;
        W1[tok] = __expf(dmax - mrow); W2[tok] = __expf(bc + m - mrow) * 0.0625f; ER[tok] = __expf(-mrow); WK[tok] = __expf(g + xs - MN[c]); }
}
__device__ __forceinline__ u16x4 tr_read(unsigned lds_addr) { u16x4 r; asm volatile("ds_read_b64_tr_b16 %0, %1\n\ts_waitcnt lgkmcnt(0)" : "=&v"(r) : "v"(lds_addr) : "memory"); return r; }
__device__ __forceinline__ void mlstm_pre_phase(char* ldsg, const Params& p, int tid) {
    unsigned char* ws = p.ws;
    const bf16* QK = (const bf16*)(ws + WS_P0); const bf16* Vt = (const bf16*)(ws + WS_P0 + WS_PSTRIDE);
    bf16* QP = (bf16*)(ws + WS_QP); bf16* KT = (bf16*)(ws + WS_KT); bf16* VT = (bf16*)(ws + WS_VT); bf16* NINT = (bf16*)(ws + WS_NINT);
    constexpr int TS = 264, SS = 72;
    bf16* QL = (bf16*)ldsg; bf16* KL = QL + 64 * TS; bf16* VL = KL + 64 * TS; bf16* SCL = VL + 64 * TS;
    float* W1s = (float*)(SCL + 64 * SS); float* BCs = W1s + 64; float* IGBs = BCs + 64; float* DMs = IGBs + 64; float* DENP = DMs + 64; float* WKs = DENP + 256;
    const int lane = tid & 63, wid = __builtin_amdgcn_readfirstlane(tid >> 6), fr = lane & 15, fq = lane >> 4;
    const unsigned vl_addr = (unsigned)(uintptr_t)VL;
    for (int u = blockIdx.x; u < 2048; u += gridDim.x) {
        const int h = u >> 8, c = u & 255, tok0 = c * 64; const size_t hs = (size_t)h * SEQ + tok0;
        if (tid < 64) { W1s[tid] = ((const float*)(ws + WS_W1))[hs + tid]; BCs[tid] = ((const float*)(ws + WS_BC))[hs + tid]; IGBs[tid] = ((const float*)(ws + WS_IGB))[hs + tid];
            DMs[tid] = ((const float*)(ws + WS_DMAX))[hs + tid]; WKs[tid] = ((const float*)(ws + WS_WK))[hs + tid]; }
#pragma unroll
        for (int i = 0; i < 4; ++i) { const int task = tid + NTHR * i, t = task >> 5, d0 = (task & 31) * 8;
            const bf16x8 q8 = *(const bf16x8*)(QK + (size_t)(tok0 + t) * DM + h * 256 + d0), k8 = *(const bf16x8*)(QK + (size_t)(tok0 + t) * DM + 2048 + h * 256 + d0);
            *(bf16x8*)(QL + t * TS + d0) = q8; *(bf16x8*)(KL + t * TS + d0) = k8;
            const float w2 = ((const float*)(ws + WS_W2))[hs + t];
            v2u lo, hi; lo.x = pk2(bf2f((unsigned short)q8[0]) * w2, bf2f((unsigned short)q8[1]) * w2); lo.y = pk2(bf2f((unsigned short)q8[2]) * w2, bf2f((unsigned short)q8[3]) * w2);
            hi.x = pk2(bf2f((unsigned short)q8[4]) * w2, bf2f((unsigned short)q8[5]) * w2); hi.y = pk2(bf2f((unsigned short)q8[6]) * w2, bf2f((unsigned short)q8[7]) * w2);
            const int r = d0 & 31, g0 = (r >> 2) & 3, dtq = r >> 4;
            bf16* qf = QP + ((((size_t)(h * 256 + c) * 8 + (d0 >> 5)) * 4 + (t >> 4)) * 512) + ((t & 15) + 16 * g0) * 8 + 4 * dtq;
            *(v2u*)qf = lo; *(v2u*)(qf + 128) = hi; }
        __syncthreads();
#pragma unroll
        for (int i = 0; i < 4; ++i) { const int task = tid + NTHR * i, d = task & 255, sg = task >> 8;
            float v[8];
#pragma unroll
            for (int e = 0; e < 8; ++e) v[e] = bf2f(KL[(8 * sg + e) * TS + d]) * WKs[8 * sg + e];
            v4u w; w.x = pk2(v[0], v[1]); w.y = pk2(v[2], v[3]); w.z = pk2(v[4], v[5]); w.w = pk2(v[6], v[7]);
            *(v4u*)(KT + ((((size_t)(h * 256 + c) * 8 + (d >> 5)) * 2 + ((d >> 4) & 1)) * 2 + (sg >> 2)) * 512 + ((d & 15) + 16 * (sg & 3)) * 8) = w; }
        { const int tr = wid >> 1;
#pragma unroll
          for (int tci = 0; tci < 2; ++tci) { const int tc = (wid & 1) * 2 + tci;
            if (tc <= tr) { f32x4 acc = (f32x4){0.f, 0.f, 0.f, 0.f};
#pragma unroll
                for (int kk = 0; kk < 8; ++kk) { const bf16x8 a = *(const bf16x8*)(QL + (16 * tr + fr) * TS + 32 * kk + 8 * fq), b = *(const bf16x8*)(KL + (16 * tc + fr) * TS + 32 * kk + 8 * fq);
                    acc = MFMA16(a, b, acc); }
                const int s = 16 * tc + fr; const float igb = IGBs[s];
#pragma unroll
                for (int j = 0; j < 4; ++j) { const int t = 16 * tr + 4 * fq + j;
                    float val = (s <= t) ? acc[j] * 0.0625f * __expf(BCs[t] + igb - DMs[t]) : 0.f;
                    SCL[t * SS + s] = (bf16)(pk2(val, 0.f) & 0xffffu);
                    val += __shfl_xor(val, 1); val += __shfl_xor(val, 2); val += __shfl_xor(val, 4); val += __shfl_xor(val, 8);
                    if (fr == 0) DENP[tc * 64 + t] = val; } }
            else {
#pragma unroll
                for (int j = 0; j < 4; ++j) { SCL[(16 * tr + 4 * fq + j) * SS + 16 * tc + fr] = (bf16)0; if (fr == 0) DENP[tc * 64 + 16 * tr + 4 * fq + j] = 0.f; } } } }
        __syncthreads();
        for (int vh = 0; vh < 2; ++vh) {
#pragma unroll
            for (int i = 0; i < 4; ++i) { const int task = tid + NTHR * i, s = task >> 5, c0 = (task & 31) * 8;
                *(bf16x8*)(VL + s * TS + c0) = *(const bf16x8*)(Vt + (size_t)(tok0 + s) * DM + h * 512 + 256 * vh + c0); }
            __syncthreads();
#pragma unroll
            for (int i = 0; i < 4; ++i) { const int task = tid + NTHR * i, v = task & 255, sg = task >> 8;
                v4u w; w.x = (unsigned)VL[(8 * sg + 0) * TS + v] | ((unsigned)VL[(8 * sg + 1) * TS + v] << 16); w.y = (unsigned)VL[(8 * sg + 2) * TS + v] | ((unsigned)VL[(8 * sg + 3) * TS + v] << 16);
                w.z = (unsigned)VL[(8 * sg + 4) * TS + v] | ((unsigned)VL[(8 * sg + 5) * TS + v] << 16); w.w = (unsigned)VL[(8 * sg + 6) * TS + v] | ((unsigned)VL[(8 * sg + 7) * TS + v] << 16);
                *(v4u*)(VT + (((size_t)(h * 256 + c) * 32 + ((256 * vh + v) >> 4)) * 2 + (sg >> 2)) * 512 + ((v & 15) + 16 * (sg & 3)) * 8) = w; }
            f32x4 acc[4][2];
#pragma unroll
            for (int tt = 0; tt < 4; ++tt)
#pragma unroll
                for (int nt = 0; nt < 2; ++nt) acc[tt][nt] = (f32x4){0.f, 0.f, 0.f, 0.f};
#pragma unroll
            for (int ks = 0; ks < 2; ++ks) {
                bf16x8 bfr[2];
#pragma unroll
                for (int nt = 0; nt < 2; ++nt) { const unsigned a0 = vl_addr + (unsigned)((32 * ks + 8 * fq + (fr >> 2)) * TS + 16 * (2 * wid + nt) + 4 * (fr & 3)) * 2u;
                    const u16x4 lo = tr_read(a0), hi = tr_read(a0 + 4u * TS * 2u);
                    bfr[nt] = (bf16x8){(short)lo[0], (short)lo[1], (short)lo[2], (short)lo[3], (short)hi[0], (short)hi[1], (short)hi[2], (short)hi[3]}; }
#pragma unroll
                for (int tt = 0; tt < 4; ++tt) { const bf16x8 a = *(const bf16x8*)(SCL + (16 * tt + fr) * SS + 32 * ks + 8 * fq);
#pragma unroll
                    for (int nt = 0; nt < 2; ++nt) acc[tt][nt] = MFMA16(a, bfr[nt], acc[tt][nt]); }
            }
#pragma unroll
            for (int tt = 0; tt < 4; ++tt)
#pragma unroll
                for (int j = 0; j < 4; ++j) { const int t = 16 * tt + 4 * fq + j; const float w1 = W1s[t];
#pragma unroll
                    for (int nt = 0; nt < 2; ++nt) NINT[(size_t)(tok0 + t) * DM + h * 512 + 256 * vh + 16 * (2 * wid + nt) + fr] = (bf16)(pk2(acc[tt][nt][j] * w1, 0.f) & 0xffffu); }
            __syncthreads();
        }
        if (tid < 64) ((float*)(ws + WS_DENI))[hs + tid] = W1s[tid] * (((DENP[tid] + DENP[64 + tid]) + DENP[128 + tid]) + DENP[192 + tid]);
        __syncthreads();
    }
}
template <int VAR>
__device__ __forceinline__ void mlstm_seq_phase(char* ldsg, const Params& p, int tid) {
    unsigned char* ws = p.ws;
    const bf16* QP = (const bf16*)(ws + WS_QP); const bf16* KT = (const bf16*)(ws + WS_KT); const bf16* VT = (const bf16*)(ws + WS_VT); const bf16* NINT = (const bf16*)(ws + WS_NINT);
    const bf16* Ot = (const bf16*)(ws + WS_P0 + 2 * WS_PSTRIDE); const bf16* Zt = (const bf16*)(ws + WS_P0 + 3 * WS_PSTRIDE); bf16* Y = (bf16*)(ws + (VAR ? WS_END : WS_Y));
    const float* DENI = (const float*)(ws + WS_DENI); const float* ER = (const float*)(ws + WS_EROW); const float* DEC = (const float*)(ws + WS_DEC);
    constexpr int PW = 20;
    float* PART = (float*)ldsg;
    unsigned* vtl = (unsigned*)(ldsg + 2 * 8 * 64 * PW * 4);
    const int lane = tid & 63, wid = __builtin_amdgcn_readfirstlane(tid >> 6), fr = lane & 15, fq = lane >> 4;
    const short one = (fr == 0) ? (short)0x3F80 : (short)0;
    const bf16x8 ones = (bf16x8){one, one, one, one, one, one, one, one};
    for (int u = blockIdx.x; u < 256; u += gridDim.x) {
        const int h = u & 7, vs = u >> 3;
        f32x4 st[2][2];
#pragma unroll
        for (int dt = 0; dt < 2; ++dt)
#pragma unroll
            for (int nt = 0; nt < 2; ++nt) st[dt][nt] = (f32x4){0.f, 0.f, 0.f, 0.f};
        const bf16* qp = QP + ((size_t)h * 256 * 8 + wid) * 2048 + lane * 8;
        const bf16* kt = KT + ((size_t)h * 256 * 8 + wid) * 2048 + lane * 8;
        const bf16* vt = VT + ((size_t)h * 256 * 32 + vs) * 1024 + lane * 8;
        const bf16* vtp = VT + ((size_t)h * 256 * 32 + vs) * 1024 + tid * 2;
        const int et = tid >> 3, ev = (tid & 7) * 2; const size_t ecol = (size_t)h * 512 + vs * 16 + ev;
        bf16x8 aQ0[4], aK0[2][2], bV0[2], aQ1[4], aK1[2][2], bV1[2];
        unsigned vp; unsigned ni0, oi0, zi0, ni1, oi1, zi1; float di0, ei0, di1, ei1, dec0, dec1;
#define SEQ_LOAD(c_, aQ, aK, ni, oi, zi, di, ei, dec) do { vp = *(const unsigned*)(vtp + (size_t)(c_) * 32768);     \
            dec = DEC[h * 256 + (c_)]; _Pragma("unroll") for (int tt = 0; tt < 4; ++tt) aQ[tt] = *(const bf16x8*)(qp + (size_t)(c_) * 16384 + tt * 512); \
            _Pragma("unroll") for (int dt = 0; dt < 2; ++dt) _Pragma("unroll") for (int ks = 0; ks < 2; ++ks) aK[dt][ks] = *(const bf16x8*)(kt + (size_t)(c_) * 16384 + (dt * 2 + ks) * 512); \
            { const size_t tok = (size_t)(c_) * 64 + et; \
                ni = *(const unsigned*)(NINT + tok * DM + ecol); oi = *(const unsigned*)(Ot + tok * DM + ecol); zi = *(const unsigned*)(Zt + tok * DM + ecol); di = DENI[(size_t)h * SEQ + tok]; ei = ER[(size_t)h * SEQ + tok]; } } while (0)
#define SEQ_STEP(c_, aQ, aK, bV, bVn, ni, oi, zi, di, ei, dec) do { \
            float* part = PART + ((c_) & 1) * (8 * 64 * PW) + wid * (64 * PW); \
            const float decay = dec; \
            bf16x8 bs[2]; \
            _Pragma("unroll") for (int nt = 0; nt < 2; ++nt) { v4u w; w.x = pk2(st[0][nt][0], st[0][nt][1]); w.y = pk2(st[0][nt][2], st[0][nt][3]); w.z = pk2(st[1][nt][0], st[1][nt][1]); w.w = pk2(st[1][nt][2], st[1][nt][3]); \
                bs[nt] = __builtin_bit_cast(bf16x8, w); } \
            _Pragma("unroll") for (int tt = 0; tt < 4; ++tt) { const f32x4 z4 = (f32x4){0.f, 0.f, 0.f, 0.f}; \
                  \
                const f32x4 p0 = MFMA16(bs[0], aQ[tt], z4), p1 = MFMA16(bs[1], aQ[tt], z4); \
                *(f32x4*)(part + (16 * tt + fr) * PW + 4 * fq) = p0; part[(16 * tt + fr) * PW + 16 + fq] = p1[0]; }     \
              \
            const float nn0 = __uint_as_float(ni << 16), nn1 = __uint_as_float(ni & 0xffff0000u); \
            float gg0, gg1; { const float o0 = __uint_as_float(oi << 16), o1 = __uint_as_float(oi & 0xffff0000u), z0 = __uint_as_float(zi << 16), z1 = __uint_as_float(zi & 0xffff0000u); \
                gg0 = sigmoidf_(o0) * z0 * sigmoidf_(z0); gg1 = sigmoidf_(o1) * z1 * sigmoidf_(z1); } \
            float dd, ee; asm volatile("v_mov_b32 %0, %2\n\tv_mov_b32 %1, %3" : "=&v"(dd), "=&v"(ee) : "v"(di), "v"(ei)); \
            vtl[(((c_) + 1) & 1) * 512 + tid] = vp;     \
            if (VAR != 2) __syncthreads(); \
              \
            const float* pall = PART + ((c_) & 1) * (8 * 64 * PW) + et * PW; \
            f32x2v pv[8]; float dn[8]; \
            if (VAR != 2) { _Pragma("unroll") for (int w = 0; w < 8; ++w) { pv[w] = *(const f32x2v*)(pall + w * (64 * PW) + ev); dn[w] = pall[w * (64 * PW) + 16]; } } \
            _Pragma("unroll") for (int ks = 0; ks < 2; ++ks) bVn[ks] = *(const bf16x8*)((const bf16*)vtl + (((c_) + 1) & 1) * 1024 + ks * 512 + lane * 8);     \
            _Pragma("unroll") for (int dt = 0; dt < 2; ++dt) _Pragma("unroll") for (int nt = 0; nt < 2; ++nt) { st[dt][nt] = st[dt][nt] * decay; \
                    _Pragma("unroll") for (int ks = 0; ks < 2; ++ks) st[dt][nt] = MFMA16(aK[dt][ks], nt == 0 ? bV[ks] : ones, st[dt][nt]); } \
            __builtin_amdgcn_sched_barrier(0); \
            if (VAR != 1) { const int cn_ = (c_) + 2 < 256 ? (c_) + 2 : 255; SEQ_LOAD(cn_, aQ, aK, ni, oi, zi, di, ei, dec); }     \
            __builtin_amdgcn_sched_barrier(0);     \
            if (VAR != 2) { f32x2v num; num.x = nn0; num.y = nn1; float den = dd; \
                _Pragma("unroll") for (int w = 0; w < 8; ++w) { num += pv[w]; den += dn[w]; } \
                const float rd = __builtin_amdgcn_rcpf(fmaxf(fabsf(den), ee)); \
                const float y0 = num.x * rd * gg0, y1 = num.y * rd * gg1; \
                *(unsigned*)(Y + ((size_t)(c_) * 64 + et) * DM + ecol) = pk2(y0, y1); } } while (0)
        __builtin_amdgcn_sched_barrier(0);
        _Pragma("unroll") for (int ks = 0; ks < 2; ++ks) bV0[ks] = *(const bf16x8*)(vt + ks * 512);
        SEQ_LOAD(0, aQ0, aK0, ni0, oi0, zi0, di0, ei0, dec0);
        __builtin_amdgcn_sched_barrier(0);
        SEQ_LOAD(1, aQ1, aK1, ni1, oi1, zi1, di1, ei1, dec1);
        __builtin_amdgcn_sched_barrier(0);
        asm volatile(".p2align 6");
        for (int c = 0; c < 256; c += 2) {
            SEQ_STEP(c, aQ0, aK0, bV0, bV1, ni0, oi0, zi0, di0, ei0, dec0);
            SEQ_STEP(c + 1, aQ1, aK1, bV1, bV0, ni1, oi1, zi1, di1, ei1, dec1);
        }
#undef SEQ_LOAD
#undef SEQ_STEP
        __syncthreads();
    }
}

__device__ __forceinline__ void final_norm_phase(const bf16* hsrc, const unsigned long long* ss, const float* g, float* out, int tid) {
    const int lane = tid & 63, wave = tid >> 6;
    const int gw = blockIdx.x * NWAVES + wave, NGW = gridDim.x * NWAVES;
    f32x4 gr[8][2];
#pragma unroll
    for (int j = 0; j < 8; ++j) { gr[j][0] = ((const f32x4*)g)[2 * lane + 128 * j]; gr[j][1] = ((const f32x4*)g)[2 * lane + 128 * j + 1]; }
    for (int m = gw; m < SEQ; m += NGW) { const float rs = rsqrtf((float)ss[m] * (1.0f / (1048576.0f * 4096.0f)) + 1e-6f);
        const v4u* xr = (const v4u*)(hsrc + (size_t)m * DM) + lane; f32x4* orow = (f32x4*)(out + (size_t)m * DM) + 2 * lane;
#pragma unroll
        for (int j = 0; j < 8; ++j) { const v4u c = xr[64 * j]; const f32x4 g0 = gr[j][0], g1 = gr[j][1];
            f32x4 a, b; a[0] = __uint_as_float(c.x << 16); a[1] = __uint_as_float(c.x & 0xffff0000u); a[2] = __uint_as_float(c.y << 16); a[3] = __uint_as_float(c.y & 0xffff0000u);
            b[0] = __uint_as_float(c.z << 16); b[1] = __uint_as_float(c.z & 0xffff0000u); b[2] = __uint_as_float(c.w << 16); b[3] = __uint_as_float(c.w & 0xffff0000u);
            orow[128 * j] = a * rs * g0; orow[128 * j + 1] = b * rs * g1; } }
}

constexpr int NPH = 17;
__global__ void __launch_bounds__(NTHR, 2) mk_fwd(Params p) {
    extern __shared__ __attribute__((aligned(16))) unsigned char lds[];
    const int tid = threadIdx.x;
    LAS unsigned char* ldsl = (LAS unsigned char*)lds;
    unsigned char* ws = p.ws;
    if (tid < 64) ((LAS unsigned*)(ldsl + LDS_CTL))[tid] = 0u;
    __syncthreads();
    XcdBarrier bar = xcd_barrier_post((unsigned*)(ws + WS_CTL), (volatile LAS unsigned*)(ldsl + LDS_CTL));
    const int lo = p.ph_lo, hi = p.ph_hi;
#ifdef DBG_ONLY
#define IN(k) ((k) == DBG_ONLY && lo <= (k) && (k) < hi)
#else
#define IN(k) (lo <= (k) && (k) < hi)
#endif
#define SEAM(k) do { if (IN(k) && IN((k) + 1)) xcd_barrier(bar); } while (0)
    unsigned long long* rowss = (unsigned long long*)(ws + WS_ROWSS);
    bf16* HB = (bf16*)(ws + WS_HB); bf16* P0t = (bf16*)(ws + WS_P0); bf16* Yt = (bf16*)(ws + WS_Y);
    const int G = gridDim.x;

    if (IN(0)) { p0_prologue(p, ldsl, tid); } SEAM(0);

    if (NLAYERS > 0) {
    if (IN(1)) { fox_gates(HB, (const bf16*)(ws + WS_WFF0), rowss, late_in(3), (float*)(ws + WS_FLOC), (float*)(ws + WS_FTOT), tid);
        pg8::Gemm g{HB, (const bf16*)(ws + WS_WFI0), SEQ, 16384, DM}; pg8::StaticOrder S; S.init(SEQ, 16384, G, (int)blockIdx.x);
        pg8::EpiIn<true> E{P0t, (size_t)SEQ * DM, rowss, (unsigned*)(ws + WS_NRM)};
        pg8::gemm_phase<pg8::EpiIn<true>, pg8::StaticOrder, true, true>(ldsl, g, S, E); } SEAM(1);
    if (IN(2)) { fox_attn_phase((char*)lds, P0t, P0t + (size_t)SEQ * DM, (const float*)(ws + WS_FLOC), (const float*)(ws + WS_FTOT), (const unsigned*)(ws + WS_NRM), (unsigned*)(ws + WS_QCNT), tid); } SEAM(2);
    if (IN(3)) { pg8::Gemm g{Yt, (const bf16*)(ws + WS_WFO0), SEQ, DM, DM}; pg8::StaticOrder S; S.init(SEQ, DM, G, (int)blockIdx.x);
        pg8::EpiOut E{HB, rowss + SEQ};
        pg8::gemm_phase<pg8::EpiOut, pg8::StaticOrder, true, true>(ldsl, g, S, E); } SEAM(3);
    }
    if (NLAYERS > 1) {
    if (IN(4)) { pg8::Gemm g{HB, (const bf16*)(ws + WS_WLI), SEQ, 8192, DM}; pg8::StaticOrder S; S.init(SEQ, 8192, G, (int)blockIdx.x);
        pg8::EpiIn<false> E{P0t, (size_t)SEQ * DM, rowss + SEQ, (unsigned*)nullptr};
        pg8::gemm_phase<pg8::EpiIn<false>, pg8::StaticOrder, true, true>(ldsl, g, S, E); } SEAM(4);
    if (IN(5)) { lru_scan_phase((char*)lds, p, tid); } SEAM(5);
    if (IN(6)) { lru_fix_phase(p, tid); } SEAM(6);
    if (IN(7)) { pg8::Gemm g{Yt, (const bf16*)(ws + WS_WLO), SEQ, DM, DM}; pg8::StaticOrder S; S.init(SEQ, DM, G, (int)blockIdx.x);
        pg8::EpiOut E{HB, rowss + 2 * SEQ};
        pg8::gemm_phase<pg8::EpiOut, pg8::StaticOrder, true, true>(ldsl, g, S, E); } SEAM(7);
    }
    if (NLAYERS > 2) {
    if (IN(8)) { mlstm_gates(HB, (const bf16*)(ws + WS_WMG), rowss + 2 * SEQ, late_in(15), late_in(16), (float*)(ws + WS_IG), (float*)(ws + WS_LF), tid);
        pg8::Gemm g{HB, (const bf16*)(ws + WS_WMI), SEQ, 16384, DM}; pg8::StaticOrder S; S.init(SEQ, 16384, G, (int)blockIdx.x);
        pg8::EpiIn<false> E{P0t, (size_t)SEQ * DM, rowss + 2 * SEQ, (unsigned*)nullptr};
        pg8::gemm_phase<pg8::EpiIn<false>, pg8::StaticOrder, true, true>(ldsl, g, S, E); } SEAM(8);
    if (IN(9)) { mlstm_scalars_phase((char*)lds, p, tid); } SEAM(9);
    if (IN(10)) { mlstm_pre_phase((char*)lds, p, tid); } SEAM(10);
    if (IN(11)) { mlstm_seq_phase<0>((char*)lds, p, tid); } SEAM(11);
    if (IN(12)) { pg8::Gemm g{Yt, (const bf16*)(ws + WS_WMO), SEQ, DM, DM}; pg8::StaticOrder S; S.init(SEQ, DM, G, (int)blockIdx.x);
        pg8::EpiOut E{HB, rowss + 3 * SEQ};
        pg8::gemm_phase<pg8::EpiOut, pg8::StaticOrder, true, true>(ldsl, g, S, E); } SEAM(12);
    }
    if (NLAYERS > 3) {
    if (IN(13)) { fox_gates(HB, (const bf16*)(ws + WS_WFF1), rowss + 3 * SEQ, late_in(3) + 32, (float*)(ws + WS_FLOC), (float*)(ws + WS_FTOT), tid);
        pg8::Gemm g{HB, (const bf16*)(ws + WS_WFI1), SEQ, 16384, DM}; pg8::StaticOrder S; S.init(SEQ, 16384, G, (int)blockIdx.x);
        pg8::EpiIn<true> E{P0t, (size_t)SEQ * DM, rowss + 3 * SEQ, (unsigned*)(ws + WS_NRM) + 256};
        pg8::gemm_phase<pg8::EpiIn<true>, pg8::StaticOrder, true, true>(ldsl, g, S, E); } SEAM(13);
    if (IN(14)) { fox_attn_phase((char*)lds, P0t, P0t + (size_t)SEQ * DM, (const float*)(ws + WS_FLOC), (const float*)(ws + WS_FTOT), (const unsigned*)(ws + WS_NRM) + 256, (unsigned*)(ws + WS_QCNT) + 512, tid); } SEAM(14);
    if (IN(15)) { pg8::Gemm g{Yt, (const bf16*)(ws + WS_WFO1), SEQ, DM, DM}; pg8::StaticOrder S; S.init(SEQ, DM, G, (int)blockIdx.x);
        pg8::EpiOut E{HB, rowss + 4 * SEQ};
        pg8::gemm_phase<pg8::EpiOut, pg8::StaticOrder, true, true>(ldsl, g, S, E); } SEAM(15);
    }
    if (IN(16)) { final_norm_phase(HB, rowss + NLAYERS * SEQ, late_in(18), late_out(), tid); }
#undef IN
#undef SEAM
}

#ifndef MK_N_LAUNCHES
#define MK_N_LAUNCHES 1
#endif
extern "C" void kernel_launch(void* const* d_in, const int* in_sizes, int n_in, void* d_out, int out_size, void* d_ws, size_t ws_size, hipStream_t stream) {
    static int grid = 0;
    if (grid == 0) {
        if (n_in != 19 || out_size != SEQ * DM || ws_size < WS_END) { fprintf(stderr, "kernel_launch: unexpected shapes (n_in %d out %d ws %zu, need ws >= %zu)\n", n_in, out_size, ws_size, (size_t)WS_END); grid = -1; return; }
        int dev = 0, cus = 0, per_cu = 0;
        if (hipGetDevice(&dev) != hipSuccess || hipDeviceGetAttribute(&cus, hipDeviceAttributeMultiprocessorCount, dev) != hipSuccess) { grid = -1; return; }
        if (hipFuncSetAttribute((const void*)mk_fwd, hipFuncAttributeMaxDynamicSharedMemorySize, LDS_BYTES) != hipSuccess) { fprintf(stderr, "kernel_launch: hipFuncSetAttribute failed\n"); grid = -1; return; }
        if (hipOccupancyMaxActiveBlocksPerMultiprocessor(&per_cu, (const void*)mk_fwd, NTHR, LDS_BYTES) != hipSuccess || per_cu < 1) { fprintf(stderr, "kernel_launch: occupancy query says %d\n", per_cu); }
        (void)hipGetLastError();
        grid = cus;
    }
    if (grid < 0) return;
    (void)hipMemsetAsync((char*)d_ws + WS_CTL, 0, CTL_ZERO_BYTES, stream);
    Params p{};
    for (int i = 0; i < 19; ++i) p.in[i] = (const float*)d_in[i];
    p.out = (float*)d_out; p.ws = (unsigned char*)d_ws;
#if MK_N_LAUNCHES == 1
    p.ph_lo = 0; p.ph_hi = NPH;
    hipLaunchKernelGGL(mk_fwd, dim3(grid), dim3(NTHR), LDS_BYTES, stream, p);
#else
    for (int k = 0; k < NPH; ++k) { p.ph_lo = k; p.ph_hi = k + 1; hipLaunchKernelGGL(mk_fwd, dim3(grid), dim3(NTHR), LDS_BYTES, stream, p); }
#endif
}
```
